# Optimizing an MI355X kernel written in HIP

```python
import jax, jax.numpy as jnp
from jax import lax
import numpy as np

D_MODEL = 1024
BATCH = 8
SEQ = 2048
DEPTH = 2
DEC_BATCH = 128
DEC_SEQ = 8
PAST_LEN = 16384
PAGE_SIZE = 128

N_BRANCH = 4
W_BR = D_MODEL // 2
POOL_WINDOWS = (2, 4, 8, 16)
N_POOL_GROUPS = 4
POOL_GW = W_BR // N_POOL_GROUPS
POOL_PREV = max(POOL_WINDOWS) - 1
SCONV_K = 3
CCONV_K = 31
CHUNK = 128
N_SGU_GROUPS = 4
SGU_GW = W_BR // N_SGU_GROUPS
N_MEM = 256
N_XHEADS = 4
XHEAD_DIM = D_MODEL // N_XHEADS
D_FF = 4 * D_MODEL
EPS = 1e-6
SPLIT_POINTS = (W_BR, 2 * W_BR, 3 * W_BR, 4 * W_BR, 6 * W_BR, 8 * W_BR)
PROJ_W = 8 * W_BR + N_BRANCH * D_MODEL

kernel_name = 'gated_parallel_pool_conv_sgu_conformer_decoder_step'


def rmsnorm(x, g):
    xf = x.astype(jnp.float32)
    y = xf * lax.rsqrt(jnp.mean(xf * xf, axis=-1, keepdims=True) + EPS)
    return (y * g.astype(jnp.float32)).astype(x.dtype)


def layernorm(x, g, b):
    xf = x.astype(jnp.float32)
    xc = xf - jnp.mean(xf, axis=-1, keepdims=True)
    var = jnp.mean(xc * xc, axis=-1, keepdims=True)
    y = xc * lax.rsqrt(var + EPS) * g.astype(jnp.float32) + b.astype(jnp.float32)
    return y.astype(x.dtype)


def pool_mix(ext, pos0, pool_w, pool_scale):
    L = ext.shape[1] - POOL_PREV
    ef = ext.astype(jnp.float32)
    c = jnp.cumsum(ef, axis=1)
    c = jnp.concatenate([jnp.zeros_like(c[:, :1]), c], axis=1)
    pos = pos0 + jnp.arange(L)
    outs = []
    for g, w in enumerate(POOL_WINDOWS):
        sl = slice(g * POOL_GW, (g + 1) * POOL_GW)
        win_sum = c[:, POOL_PREV + 1:, sl] - c[:, POOL_PREV + 1 - w:POOL_PREV + 1 - w + L, sl]
        cnt = jnp.minimum(pos + 1, w).astype(jnp.float32)[None, :, None]
        p = win_sum / cnt - ef[:, POOL_PREV:, sl]
        outs.append(p.astype(pool_w.dtype) @ pool_w[g])
    return jnp.concatenate(outs, axis=-1) * pool_scale


def causal_dwconv(ext, w):
    C = ext.shape[-1]
    return lax.conv_general_dilated(ext, w[:, None, :].astype(ext.dtype), window_strides=(1,), padding='VALID',
                                    dimension_numbers=('NWC', 'WIO', 'NWC'), feature_group_count=C)


def chunk_spatial_mix(v, w_s, b_s):
    Bn, L, _ = v.shape
    Lp = -(-L // CHUNK) * CHUNK
    vp = jnp.pad(v, ((0, 0), (0, Lp - L), (0, 0))).reshape(Bn, Lp // CHUNK, CHUNK, N_SGU_GROUPS, SGU_GW)
    causal = jnp.tril(jnp.ones((CHUNK, CHUNK), dtype=bool))
    ws = jnp.where(causal[None], w_s, jnp.zeros_like(w_s))
    s = jnp.einsum('gts,bnsgc->bntgc', ws, vp) + jnp.transpose(b_s)[None, None, :, :, None]
    return s.reshape(Bn, Lp, W_BR)[:, :L]


def mixer_block(h, pool_prev, sconv_prev, cconv_prev, pos0, w_in, pool_w, pool_scale, sconv_w,
                sgu_ln_g, sgu_ln_b, sgu_w, sgu_b, cconv_w, cconv_b, cconv_ln_g, cconv_ln_b,
                w_branch, b_gate, w_mix_out):
    Bn, L, _ = h.shape
    z = h @ w_in
    a_u, b_h, b_b, b_c, c_uv, d_in, g_in = jnp.split(z, SPLIT_POINTS, axis=-1)
    pool_ext = jnp.concatenate([pool_prev, a_u], axis=1)
    a_out = pool_mix(pool_ext, pos0, pool_w, pool_scale)
    new_pool = pool_ext[:, -POOL_PREV:]
    sc_ext = jnp.concatenate([sconv_prev, b_c * b_h], axis=1)
    b_out = b_b * causal_dwconv(sc_ext, sconv_w)
    new_sconv = sc_ext[:, -(SCONV_K - 1):]
    c_u, c_v = jnp.split(jax.nn.gelu(c_uv), 2, axis=-1)
    c_vn = layernorm(c_v, sgu_ln_g, sgu_ln_b)
    c_out = c_u * chunk_spatial_mix(c_vn, sgu_w, sgu_b)
    d_a, d_b = jnp.split(d_in, 2, axis=-1)
    cc_ext = jnp.concatenate([cconv_prev, d_a * jax.nn.sigmoid(d_b)], axis=1)
    d_c = causal_dwconv(cc_ext, cconv_w) + cconv_b
    d_out = jax.nn.silu(layernorm(d_c, cconv_ln_g, cconv_ln_b))
    new_cconv = cc_ext[:, -(CCONV_K - 1):]
    branches = jnp.stack([a_out, b_out, c_out, d_out], axis=2)
    proj = jnp.einsum('blkw,kwd->blkd', branches, w_branch)
    gates = jax.nn.sigmoid(g_in.reshape(Bn, L, N_BRANCH, D_MODEL) + b_gate)
    merged = jnp.sum(gates * proj, axis=2)
    return merged @ w_mix_out, new_pool, new_sconv, new_cconv, c_vn


def mem_kv(mem, g, w_k, w_v):
    Bn = mem.shape[0]
    m = rmsnorm(mem, g)
    k = (m @ w_k).reshape(Bn, N_MEM, N_XHEADS, XHEAD_DIM)
    v = (m @ w_v).reshape(Bn, N_MEM, N_XHEADS, XHEAD_DIM)
    return k, v


def cross_attend(h, k, v, w_q, w_o):
    Bn, L, _ = h.shape
    q = (h @ w_q).reshape(Bn, L, N_XHEADS, XHEAD_DIM)
    s = jnp.einsum('blhd,bmhd->bhlm', q, k).astype(jnp.float32) * (XHEAD_DIM ** -0.5)
    p = jax.nn.softmax(s, axis=-1).astype(v.dtype)
    o = jnp.einsum('bhlm,bmhd->blhd', p, v).reshape(Bn, L, D_MODEL)
    return o @ w_o


def sq_relu_mlp(h, w1, w2):
    return jnp.square(jax.nn.relu(h @ w1)) @ w2


def run_trunk(x, pool_prev, sconv_prev, cconv_prev, mem_k, mem_v, pos0, P):
    pools, sconvs, cconvs, vs = [], [], [], []
    for l in range(DEPTH):
        h = rmsnorm(x, P['norm_mix_g'][l])
        m, npool, nsc, ncc, vn = mixer_block(
            h, pool_prev[l], sconv_prev[l], cconv_prev[l], pos0,
            P['w_in'][l], P['pool_w'][l], P['pool_scale'][l], P['sconv_w'][l],
            P['sgu_ln_g'][l], P['sgu_ln_b'][l], P['sgu_w'][l], P['sgu_b'][l],
            P['cconv_w'][l], P['cconv_b'][l], P['cconv_ln_g'][l], P['cconv_ln_b'][l],
            P['w_branch'][l], P['b_gate'][l], P['w_mix_out'][l])
        x = x + m
        x = x + cross_attend(rmsnorm(x, P['norm_x_g'][l]), mem_k[l], mem_v[l], P['w_xq'][l], P['w_xo'][l])
        x = x + sq_relu_mlp(rmsnorm(x, P['norm_ffn_g'][l]), P['w_ff1'][l], P['w_ff2'][l])
        pools.append(npool)
        sconvs.append(nsc)
        cconvs.append(ncc)
        vs.append(vn)
    return rmsnorm(x, P['norm_f_g']), pools, sconvs, cconvs, vs


def setup_inputs(seed: int = 0) -> dict:
    key = jax.random.key(seed)
    ks = iter(jax.random.split(key, 48))
    def nrm(shape, scale):
        return scale * jax.random.normal(next(ks), shape, jnp.float32)
    def gain(shape):
        return 1.0 + 0.05 * jax.random.normal(next(ks), shape, jnp.float32)
    dD = D_MODEL ** -0.5
    return {
        'x_prompt': nrm((BATCH, SEQ, D_MODEL), 1.0),
        'x_sample': nrm((DEC_BATCH, DEC_SEQ, D_MODEL), 1.0),
        'state_pool': nrm((DEPTH, DEC_BATCH, POOL_PREV, W_BR), 1.0),
        'state_sconv': nrm((DEPTH, DEC_BATCH, SCONV_K - 1, W_BR), 1.0),
        'state_cconv': nrm((DEPTH, DEC_BATCH, CCONV_K - 1, W_BR), 0.5),
        'cache_mem_k': nrm((DEPTH, DEC_BATCH, N_MEM, N_XHEADS, XHEAD_DIM), 1.0),
        'cache_mem_v': nrm((DEPTH, DEC_BATCH, N_MEM, N_XHEADS, XHEAD_DIM), 1.0),
        'mem_prompt': nrm((BATCH, N_MEM, D_MODEL), 1.0),
        'norm_mix_g': gain((DEPTH, D_MODEL)),
        'w_in': nrm((DEPTH, D_MODEL, PROJ_W), dD),
        'pool_w': nrm((DEPTH, N_POOL_GROUPS, POOL_GW, POOL_GW), POOL_GW ** -0.5),
        'pool_scale': 1.0 + 0.1 * jax.random.normal(next(ks), (DEPTH, W_BR), jnp.float32),
        'sconv_w': nrm((DEPTH, SCONV_K, W_BR), SCONV_K ** -0.5),
        'sgu_ln_g': gain((DEPTH, W_BR)),
        'sgu_ln_b': nrm((DEPTH, W_BR), 0.02),
        'sgu_w': nrm((DEPTH, N_SGU_GROUPS, CHUNK, CHUNK), CHUNK ** -0.5),
        'sgu_b': 1.0 + 0.02 * jax.random.normal(next(ks), (DEPTH, N_SGU_GROUPS, CHUNK), jnp.float32),
        'cconv_w': nrm((DEPTH, CCONV_K, W_BR), CCONV_K ** -0.5),
        'cconv_b': nrm((DEPTH, W_BR), 0.02),
        'cconv_ln_g': gain((DEPTH, W_BR)),
        'cconv_ln_b': nrm((DEPTH, W_BR), 0.02),
        'w_branch': nrm((DEPTH, N_BRANCH, W_BR, D_MODEL), W_BR ** -0.5),
        'b_gate': nrm((DEPTH, N_BRANCH, D_MODEL), 0.02),
        'w_mix_out': nrm((DEPTH, D_MODEL, D_MODEL), dD),
        'norm_x_g': gain((DEPTH, D_MODEL)),
        'norm_mem_g': gain((DEPTH, D_MODEL)),
        'w_xq': nrm((DEPTH, D_MODEL, D_MODEL), dD),
        'w_xk': nrm((DEPTH, D_MODEL, D_MODEL), dD),
        'w_xv': nrm((DEPTH, D_MODEL, D_MODEL), dD),
        'w_xo': nrm((DEPTH, D_MODEL, D_MODEL), dD),
        'norm_ffn_g': gain((DEPTH, D_MODEL)),
        'w_ff1': nrm((DEPTH, D_MODEL, D_FF), dD),
        'w_ff2': nrm((DEPTH, D_FF, D_MODEL), D_FF ** -0.5),
        'norm_f_g': gain((D_MODEL,)),
    }


def reference(x_prompt, x_sample, state_pool, state_sconv, state_cconv, cache_mem_k, cache_mem_v, mem_prompt,
              norm_mix_g, w_in, pool_w, pool_scale, sconv_w, sgu_ln_g, sgu_ln_b, sgu_w, sgu_b,
              cconv_w, cconv_b, cconv_ln_g, cconv_ln_b, w_branch, b_gate, w_mix_out,
              norm_x_g, norm_mem_g, w_xq, w_xk, w_xv, w_xo, norm_ffn_g, w_ff1, w_ff2, norm_f_g):
    P = {'norm_mix_g': norm_mix_g, 'w_in': w_in, 'pool_w': pool_w, 'pool_scale': pool_scale,
         'sconv_w': sconv_w, 'sgu_ln_g': sgu_ln_g, 'sgu_ln_b': sgu_ln_b, 'sgu_w': sgu_w, 'sgu_b': sgu_b,
         'cconv_w': cconv_w, 'cconv_b': cconv_b, 'cconv_ln_g': cconv_ln_g, 'cconv_ln_b': cconv_ln_b,
         'w_branch': w_branch, 'b_gate': b_gate, 'w_mix_out': w_mix_out, 'norm_x_g': norm_x_g,
         'w_xq': w_xq, 'w_xo': w_xo, 'norm_ffn_g': norm_ffn_g, 'w_ff1': w_ff1, 'w_ff2': w_ff2,
         'norm_f_g': norm_f_g}
    dt = x_prompt.dtype
    kv = [mem_kv(mem_prompt, norm_mem_g[l], w_xk[l], w_xv[l]) for l in range(DEPTH)]
    mem_k_prompt = jnp.stack([k for k, _ in kv])
    mem_v_prompt = jnp.stack([v for _, v in kv])
    zp = jnp.zeros((DEPTH, BATCH, POOL_PREV, W_BR), dt)
    zs = jnp.zeros((DEPTH, BATCH, SCONV_K - 1, W_BR), dt)
    zc = jnp.zeros((DEPTH, BATCH, CCONV_K - 1, W_BR), dt)
    y_prompt, pool_p, sconv_p, cconv_p, _ = run_trunk(x_prompt, zp, zs, zc, mem_k_prompt, mem_v_prompt, 0, P)
    y_sample, pool_s, sconv_s, cconv_s, v_s = run_trunk(x_sample, state_pool, state_sconv, state_cconv,
                                                        cache_mem_k, cache_mem_v, PAST_LEN, P)
    new_pool_prompt = jnp.stack(pool_p)
    new_sconv_prompt = jnp.stack(sconv_p)
    new_cconv_prompt = jnp.stack(cconv_p)
    new_pool_sample = jnp.stack(pool_s)
    new_sconv_sample = jnp.stack(sconv_s)
    new_cconv_sample = jnp.stack(cconv_s)
    sgu_v_sample = jnp.stack(v_s)
    return (y_prompt, y_sample, new_pool_prompt, new_sconv_prompt, new_cconv_prompt, mem_k_prompt, mem_v_prompt,
            new_pool_sample, new_sconv_sample, new_cconv_sample, sgu_v_sample)
```

```cpp
#include <hip/hip_runtime.h>
#include <hip/hip_cooperative_groups.h>
#include <cstdio>
#include <cstdint>
namespace cg = cooperative_groups;
#ifndef PROBE_G
#define PROBE_G -1
#endif
#ifndef PROBE_C
#define PROBE_C 0
#endif
#ifndef PROBE_S
#define PROBE_S 0
#endif
#ifndef PROBE_A
#define PROBE_A 0
#endif
#ifndef PROBE_B
#define PROBE_B 0
#endif
#ifndef EN_SGU
#define EN_SGU 1
#endif
#ifndef EN_CP
#define EN_CP 1
#endif
#ifndef EN_CS
#define EN_CS 1
#endif
#ifndef EN_PRO
#define EN_PRO 1
#endif
#ifndef EN_BR
#define EN_BR 1
#endif
#ifndef EN_AT
#define EN_AT 1
#endif
#ifndef EN_GEMM
#define EN_GEMM 1
#endif

#define DI __device__ __forceinline__
#define LAS __attribute__((address_space(3)))
typedef unsigned short bf16_t;
typedef short bf16x8 __attribute__((ext_vector_type(8)));
typedef short s16x4 __attribute__((ext_vector_type(4)));
typedef float f32x4 __attribute__((ext_vector_type(4)));
typedef float f32x2 __attribute__((ext_vector_type(2)));
typedef unsigned u32x4 __attribute__((ext_vector_type(4)));
typedef unsigned u32x2 __attribute__((ext_vector_type(2)));
typedef __bf16 bf16x2_t __attribute__((ext_vector_type(2)));

constexpr int DM = 1024, MP = 16384, MS = 1024, MT = MP + MS, SEQ = 2048, NB = 8, NSB = 128, NSQ = 8, WBR = 512, ZP = 7168, DFF = 4096;
constexpr float EPS = 1e-6f;
constexpr float LOG2E = 1.4426950408889634f;
constexpr int NPH = 20;
constexpr size_t O_YP = 0, O_YS = 16777216, O_POOLP = 17825792, O_SCP = 17948672, O_CCP = 17965056, O_MK = 18210816, O_MV = 22405120,
                 O_POOLS = 26599424, O_SCS = 28565504, O_CCS = 28827648, O_SGUV = 32759808, O_END = 33808384;
constexpr size_t MiB = 1u << 20;
constexpr size_t WS_WIN = 0, WS_WB = 32 * MiB, WS_WMIX = 40 * MiB, WS_WQ = 44 * MiB, WS_WKV = 48 * MiB, WS_WO = 56 * MiB, WS_W1 = 60 * MiB, WS_W2 = 76 * MiB,
                 WS_SGUW = 92 * MiB, WS_SS = 93 * MiB, WS_SSM = 95 * MiB, WS_MB = 96 * MiB, WS_KP = 100 * MiB, WS_VTP = 108 * MiB, WS_X = 116 * MiB,
                 WS_XB = 184 * MiB, WS_MG = 218 * MiB, WS_Q = 252 * MiB, WS_O = 286 * MiB, WS_BR = 320 * MiB, WS_Z = 388 * MiB, WS_CTL = 627 * MiB, WS_END = 628 * MiB;
constexpr size_t BR_STRIDE = (size_t)MT * WBR * 2;
constexpr int LDS_BYTES = 147456, LDS_MISC = 139264;

DI unsigned pk_bf16(float lo, float hi) { f32x2 v = {lo, hi}; bf16x2_t b = __builtin_convertvector(v, bf16x2_t); return __builtin_bit_cast(unsigned, b); }
DI float bf_lo(unsigned v) { return __uint_as_float(v << 16); }
DI float bf_hi(unsigned v) { return __uint_as_float(v & 0xffff0000u); }
DI float sigmoidf_(float x) { return __builtin_amdgcn_rcpf(1.f + __builtin_amdgcn_exp2f(-x * LOG2E)); }
DI float gelu_tanh(float x) { const float u = 1.5957691216057308f * (x + 0.044715f * x * x * x); return x * sigmoidf_(u); }
DI float wave_sum(float v) {
#pragma unroll
    for (int o = 1; o < 64; o <<= 1) v += __shfl_xor(v, o);
    return v;
}
DI float wave_max(float v) {
#pragma unroll
    for (int o = 1; o < 64; o <<= 1) v = fmaxf(v, __shfl_xor(v, o));
    return v;
}

DI int opaque_tid() { int t = threadIdx.x; asm volatile("" : "+v"(t)); return t; }
DI int opaque_bid() { int b = blockIdx.x; asm volatile("" : "+s"(b)); return b; }
template <int N, int D> struct XReduce {
    static DI void run(float* v, int lane) {
        const bool up = (lane & D) != 0;
#pragma unroll
        for (int i = 0; i < N / 2; ++i) { const float send = up ? v[i] : v[i + N / 2], keep = up ? v[i + N / 2] : v[i]; v[i] = keep + __shfl_xor(send, D); }
        XReduce<N / 2, D / 2>::run(v, lane);
    }
};
template <int D> struct XReduce<1, D> {
    static DI void run(float* v, int lane) {
#pragma unroll
        for (int d = D; d >= 1; d >>= 1) v[0] += __shfl_xor(v[0], d);
    }
};
struct Params { const float* in[34]; float* out; unsigned char* ws; int ph_lo, ph_hi; };
DI unsigned char* ws_of(const Params& p) { unsigned char* w = p.ws; asm volatile("" : "+s"(w)); return w; }
DI float* out_of(const Params& p) { float* o = p.out; asm volatile("" : "+s"(o)); return o; }

namespace pg8 {
constexpr int BM = 256, BK = 64, HALF = 128, HTB = HALF * BK * 2, STAGE_BYTES = 8 * HTB;
DI int lds_byte(int r, int c) { const int st = (r >> 4) * 2 + (c >> 5), rr = r & 15, cc = c & 31, ob = rr * 64 + cc * 2; return st * 1024 + (ob ^ (((ob >> 9) & 1) << 5)); }
DI void stage_rc(int b, int& R, int& C) { const int st = b / 1024, sb = b % 1024, swz = sb ^ (((sb >> 9) & 1) << 5); R = (st >> 1) * 16 + swz / 64; C = (st & 1) * 32 + (swz % 64) / 2; }
DI int perm32(int rho) { const int n = rho >> 4, i = rho & 15; return 8 * (i >> 2) + 4 * n + (i & 3); }

struct Unit { int pm, pn, kind, zc; const char* a; const char* b; };

DI void tile_of(int L, int nM, int nN, int& pm, int& pn) {
    const int nwg = nM * nN; int wgid = L;
    { const int q = nwg / 8, r = nwg % 8, xcd = wgid % 8, off = wgid / 8; wgid = (xcd < r ? xcd * (q + 1) : r * (q + 1) + (xcd - r) * q) + off; }
    const int nig = 8 * nN, gid = wgid / nig, fm = gid * 8, gsz = (nM - fm) < 8 ? (nM - fm) : 8;
    pm = fm + ((wgid % nig) % gsz); pn = (wgid % nig) / gsz;
}

typedef const volatile LAS int* DescP;
DI int dsc_i(DescP d, int i) { return __builtin_amdgcn_readfirstlane(d[i]); }
DI const char* dsc_p(DescP d, int i) { const unsigned lo = (unsigned)__builtin_amdgcn_readfirstlane(d[i]), hi = (unsigned)__builtin_amdgcn_readfirstlane(d[i + 1]); return (const char*)(((unsigned long long)hi << 32) | lo); }
struct SchedU {
    DescP d; int G, c;
    DI bool next(int i, Unit& u) const {
        const int mode = dsc_i(d, 0); const char* A = dsc_p(d, 8); const char* B = dsc_p(d, 10);
        if (mode == 2) {
            const int ti = i * G + c; if (ti >= 64 * 4) return false;
            tile_of(ti, 64, 4, u.pm, u.pn); u.kind = 9; u.zc = 0;
            u.a = A + (size_t)u.pm * (256 * 2048 * 2); u.b = B + (size_t)u.pn * (256 * 2048 * 2); return true;
        }
        const int L = i * G + c;
        if (mode == 1) {
            const int nN = dsc_i(d, 1), K = dsc_i(d, 2);
            const int nM = 64;
            if (L >= nM * nN) return false;
            tile_of(L, nM, nN, u.pm, u.pn); u.kind = dsc_i(d, 3); u.zc = u.pn * 256;
            u.a = A + (size_t)u.pm * ((size_t)512 * K); u.b = B + (size_t)u.pn * ((size_t)512 * K); return true;
        }
        if (L < 68 * 32) {
            tile_of(L, 68, 32, u.pm, u.pn); u.a = A + (size_t)u.pm * (512 * 1024); u.b = B + (size_t)u.pn * (512 * 1024);
            const int pn = u.pn;
            if (pn < 2) { u.kind = 0; u.zc = pn * 256; }
            else if (pn < 6) { u.kind = 3; u.zc = 512 + (pn - 2) * 128; }
            else if (pn < 8) { u.kind = 0; u.zc = 1024 + (pn - 6) * 256; }
            else if (pn < 12) { u.kind = 1; u.zc = 1536 + (pn - 8) * 256; }
            else if (pn < 16) { u.kind = 4; u.zc = 2560 + (pn - 12) * 128; }
            else { u.kind = 2; u.zc = 3072 + (pn - 16) * 256; }
            return true;
        }
        const int j = L - 68 * 32; if (j >= dsc_i(d, 4)) return false;
        const int l = j >> 6, rem = j & 63; u.pm = rem >> 3; u.pn = rem & 7; u.kind = 5; u.zc = l;
        u.a = dsc_p(d, 12) + (size_t)u.pm * (512 * 1024); u.b = dsc_p(d, 14) + (size_t)l * (4 * MiB) + (size_t)u.pn * (512 * 1024); return true;
    }
};

struct EpiU {
    DescP d; unsigned char* ws; float* out;
    template <int ACT> DI void plain(const f32x4 (&acc)[2][2][4][2], const Unit& u, const float (&rs)[2][4], int rloc, int cloc) const {
        const float* bias = (const float*)dsc_p(d, 20); bf16_t* Zout = (bf16_t*)dsc_p(d, 22); const int ldz = dsc_i(d, 5);
        f32x4 bv[2][2];
#pragma unroll
        for (int bj = 0; bj < 2; ++bj)
#pragma unroll
            for (int n = 0; n < 2; ++n) bv[bj][n] = (ACT == 2) ? *(const f32x4*)(bias + (u.zc - 3072) + cloc + bj * 128 + 4 * n) : (f32x4){0.f, 0.f, 0.f, 0.f};
#pragma unroll
        for (int ai = 0; ai < 2; ++ai)
#pragma unroll
            for (int m = 0; m < 4; ++m) {
                const int row = u.pm * 256 + rloc + ai * 128 + m * 16; bf16_t* rowp = Zout + (size_t)row * ldz + u.zc + cloc; const float r = rs[ai][m];
#pragma unroll
                for (int bj = 0; bj < 2; ++bj) {
                    float v[8];
#pragma unroll
                    for (int n = 0; n < 2; ++n)
#pragma unroll
                        for (int j = 0; j < 4; ++j) {
                            float x = acc[ai][bj][m][n][j] * r;
                            if (ACT == 1) x = gelu_tanh(x);
                            if (ACT == 2) x = sigmoidf_(x + bv[bj][n][j]);
                            if (ACT == 7) { x = fmaxf(x, 0.f); x = x * x; }
                            v[n * 4 + j] = x;
                        }
                    u32x4 w; w.x = pk_bf16(v[0], v[1]); w.y = pk_bf16(v[2], v[3]); w.z = pk_bf16(v[4], v[5]); w.w = pk_bf16(v[6], v[7]);
                    *(u32x4*)(rowp + bj * 128) = w;
                }
            }
    }
    template <int ACT> DI void merge2(const f32x4 (&acc)[2][2][4][2], const Unit& u, const float (&rs)[2][4], int rloc, int cloc) const {
        bf16_t* Zout = (bf16_t*)dsc_p(d, 22); const int ldz = dsc_i(d, 5);
#pragma unroll
        for (int ai = 0; ai < 2; ++ai)
#pragma unroll
            for (int m = 0; m < 4; ++m) {
                const int row = u.pm * 256 + rloc + ai * 128 + m * 16; bf16_t* rowp = Zout + (size_t)row * ldz + u.zc + cloc; const float r = rs[ai][m];
                float v[8];
#pragma unroll
                for (int n = 0; n < 2; ++n)
#pragma unroll
                    for (int j = 0; j < 4; ++j) {
                        const float a = acc[ai][0][m][n][j] * r, b = acc[ai][1][m][n][j] * r;
                        v[n * 4 + j] = (ACT == 3) ? a * b : a * sigmoidf_(b);
                    }
                u32x4 w; w.x = pk_bf16(v[0], v[1]); w.y = pk_bf16(v[2], v[3]); w.z = pk_bf16(v[4], v[5]); w.w = pk_bf16(v[6], v[7]);
                *(u32x4*)rowp = w;
            }
    }
    static DI float gclamp(float g) { return fmaxf(g, 1e-20f); }
    DI void rescale(f32x4 (&acc)[2][2][4][2], const Unit& u, int k, int wr, int wc, int fr, int fq) const {
        int rloc = wr * 64 + fr, cloc = wc * 32 + 8 * fq;
        asm volatile("" : "+v"(rloc), "+v"(cloc));
        const bf16_t* Zg = (const bf16_t*)(ws + WS_Z) + 3072 + 1024 * (k - 1) + u.pn * 256 + cloc;
#pragma unroll
        for (int ai = 0; ai < 2; ++ai) {
            u32x4 gp_[4][2], gn_[4][2];
#pragma unroll
            for (int m = 0; m < 4; ++m) { const int row = u.pm * 256 + rloc + ai * 128 + m * 16; const bf16_t* gp = Zg + (size_t)row * ZP;
#pragma unroll
                for (int bj = 0; bj < 2; ++bj) { gp_[m][bj] = *(const u32x4*)(gp + bj * 128); gn_[m][bj] = *(const u32x4*)(gp + 1024 + bj * 128); } }
#pragma unroll
            for (int m = 0; m < 4; ++m) {
#pragma unroll
                for (int bj = 0; bj < 2; ++bj) {
                    const u32x4 a = gp_[m][bj], b = gn_[m][bj];
                    acc[ai][bj][m][0][0] *= gclamp(bf_lo(a.x)) * __builtin_amdgcn_rcpf(gclamp(bf_lo(b.x))); acc[ai][bj][m][0][1] *= gclamp(bf_hi(a.x)) * __builtin_amdgcn_rcpf(gclamp(bf_hi(b.x)));
                    acc[ai][bj][m][0][2] *= gclamp(bf_lo(a.y)) * __builtin_amdgcn_rcpf(gclamp(bf_lo(b.y))); acc[ai][bj][m][0][3] *= gclamp(bf_hi(a.y)) * __builtin_amdgcn_rcpf(gclamp(bf_hi(b.y)));
                    acc[ai][bj][m][1][0] *= gclamp(bf_lo(a.z)) * __builtin_amdgcn_rcpf(gclamp(bf_lo(b.z))); acc[ai][bj][m][1][1] *= gclamp(bf_hi(a.z)) * __builtin_amdgcn_rcpf(gclamp(bf_hi(b.z)));
                    acc[ai][bj][m][1][2] *= gclamp(bf_lo(a.w)) * __builtin_amdgcn_rcpf(gclamp(bf_lo(b.w))); acc[ai][bj][m][1][3] *= gclamp(bf_hi(a.w)) * __builtin_amdgcn_rcpf(gclamp(bf_hi(b.w)));
                }
            }
            asm volatile("" ::: "memory");
        }
    }
    DI void operator()(const f32x4 (&acc)[2][2][4][2], const Unit& u, int wr, int wc, int fr, int fq) const {
        const int kind = u.kind; int rloc = wr * 64 + fr, cloc = wc * 32 + 8 * fq;
        asm volatile("" : "+v"(rloc), "+v"(cloc));
        if (kind == 8) {
            const int xf32 = dsc_i(d, 7);
            const float* xin = (u.pm < 64) ? (const float*)dsc_p(d, 16) : (const float*)dsc_p(d, 18) - (size_t)MP * DM;
            bf16_t* XB = (bf16_t*)(ws + WS_XB); float* SS = (float*)(ws + WS_SS);
#pragma unroll
            for (int ai = 0; ai < 2; ++ai) {
                u32x4 xv[4][2];
                if (!xf32) {
#pragma unroll
                    for (int m = 0; m < 4; ++m) { const size_t off = (size_t)(u.pm * 256 + rloc + ai * 128 + m * 16) * DM + u.pn * 256 + cloc;
#pragma unroll
                        for (int bj = 0; bj < 2; ++bj) xv[m][bj] = *(const u32x4*)(XB + off + bj * 128); }
                }
#pragma unroll
                for (int m = 0; m < 4; ++m) {
                    const int row = u.pm * 256 + rloc + ai * 128 + m * 16; const size_t off = (size_t)row * DM + u.pn * 256 + cloc; float ss = 0.f;
#pragma unroll
                    for (int bj = 0; bj < 2; ++bj) {
                        f32x4 x0, x1;
                        if (xf32) { x0 = *(const f32x4*)(xin + off + bj * 128); x1 = *(const f32x4*)(xin + off + bj * 128 + 4); }
                        else { const u32x4 v = xv[m][bj]; x0 = (f32x4){bf_lo(v.x), bf_hi(v.x), bf_lo(v.y), bf_hi(v.y)}; x1 = (f32x4){bf_lo(v.z), bf_hi(v.z), bf_lo(v.w), bf_hi(v.w)}; }
                        x0 += acc[ai][bj][m][0]; x1 += acc[ai][bj][m][1];
                        u32x4 w; w.x = pk_bf16(x0[0], x0[1]); w.y = pk_bf16(x0[2], x0[3]); w.z = pk_bf16(x1[0], x1[1]); w.w = pk_bf16(x1[2], x1[3]);
                        *(u32x4*)(XB + off + bj * 128) = w;
                        const f32x4 y0 = (f32x4){bf_lo(w.x), bf_hi(w.x), bf_lo(w.y), bf_hi(w.y)}, y1 = (f32x4){bf_lo(w.z), bf_hi(w.z), bf_lo(w.w), bf_hi(w.w)};
                        ss += (y0[0] * y0[0] + y0[1] * y0[1]) + (y0[2] * y0[2] + y0[3] * y0[3]) + (y1[0] * y1[0] + y1[1] * y1[1]) + (y1[2] * y1[2] + y1[3] * y1[3]);
                    }
                    ss += __shfl_xor(ss, 16); ss += __shfl_xor(ss, 32);
                    if (fq == 0) SS[(size_t)row * 16 + u.pn * 4 + wc] = ss;
                    if (xf32 && (m & 1)) asm volatile("" ::: "memory");
                }
                asm volatile("" ::: "memory");
            }
            return;
        }
        if (kind == 9) {
            const bf16_t* Zg = (const bf16_t*)(ws + WS_Z) + 3072 + 1024 * 3 + u.pn * 256 + cloc; bf16_t* MG = (bf16_t*)(ws + WS_MG);
#pragma unroll
            for (int ai = 0; ai < 2; ++ai) {
                u32x4 g[4][2];
#pragma unroll
                for (int m = 0; m < 4; ++m) { const int row = u.pm * 256 + rloc + ai * 128 + m * 16; const bf16_t* gp = Zg + (size_t)row * ZP;
#pragma unroll
                    for (int bj = 0; bj < 2; ++bj) g[m][bj] = *(const u32x4*)(gp + bj * 128); }
#pragma unroll
                for (int m = 0; m < 4; ++m) {
                    const int row = u.pm * 256 + rloc + ai * 128 + m * 16; bf16_t* mp = MG + (size_t)row * DM + u.pn * 256 + cloc;
#pragma unroll
                    for (int bj = 0; bj < 2; ++bj) {
                        const u32x4 gg = g[m][bj]; const f32x4 a0 = acc[ai][bj][m][0], a1 = acc[ai][bj][m][1]; u32x4 w;
                        w.x = pk_bf16(gclamp(bf_lo(gg.x)) * a0[0], gclamp(bf_hi(gg.x)) * a0[1]); w.y = pk_bf16(gclamp(bf_lo(gg.y)) * a0[2], gclamp(bf_hi(gg.y)) * a0[3]);
                        w.z = pk_bf16(gclamp(bf_lo(gg.z)) * a1[0], gclamp(bf_hi(gg.z)) * a1[1]); w.w = pk_bf16(gclamp(bf_lo(gg.w)) * a1[2], gclamp(bf_hi(gg.w)) * a1[3]);
                        *(u32x4*)(mp + bj * 128) = w;
                    }
                }
                asm volatile("" ::: "memory");
            }
            return;
        }
        if (kind == 5) {
            const float* SSM = (const float*)(ws + WS_SSM); const int l = u.zc, b = u.pm;
#pragma unroll
            for (int ai = 0; ai < 2; ++ai)
#pragma unroll
                for (int m = 0; m < 4; ++m) {
                    const int key = rloc + ai * 128 + m * 16, row = b * 256 + key; const float r = __builtin_amdgcn_rsqf(SSM[row] * (1.f / 1024.f) + EPS);
#pragma unroll
                    for (int bj = 0; bj < 2; ++bj) {
                        const int col = u.pn * 256 + bj * 128 + cloc;
                        const f32x4 v0 = acc[ai][bj][m][0] * r, v1 = acc[ai][bj][m][1] * r;
                        float* op = out + (col < 1024 ? O_MK : O_MV) + (size_t)l * 2097152 + (size_t)row * 1024 + (col & 1023);
                        *(f32x4*)op = v0; *(f32x4*)(op + 4) = v1;
                        const int h = (col & 1023) >> 8, d = col & 255; const size_t hb = ((size_t)(l * 8 + b) * 4 + h) * 65536;
                        if (col < 1024) {
                            u32x4 w; w.x = pk_bf16(v0[0], v0[1]); w.y = pk_bf16(v0[2], v0[3]); w.z = pk_bf16(v1[0], v1[1]); w.w = pk_bf16(v1[2], v1[3]);
                            *(u32x4*)((bf16_t*)(ws + WS_KP) + hb + (size_t)key * 256 + d) = w;
                        } else {
                            bf16_t* vt = (bf16_t*)(ws + WS_VTP) + hb + (size_t)d * 256 + key;
#pragma unroll
                            for (int j = 0; j < 4; ++j) { vt[j * 256] = (bf16_t)(pk_bf16(v0[j], 0.f) & 0xffffu); vt[(4 + j) * 256] = (bf16_t)(pk_bf16(v1[j], 0.f) & 0xffffu); }
                        }
                    }
                    asm volatile("" ::: "memory");
                }
            return;
        }
        float rs[2][4]; const float* SS = (const float*)(ws + WS_SS); const float scale = __int_as_float(dsc_i(d, 6));
#pragma unroll
        for (int ai = 0; ai < 2; ++ai)
#pragma unroll
            for (int m = 0; m < 4; ++m) {
                const f32x4 s4 = *(const f32x4*)(SS + (size_t)(u.pm * 256 + rloc + ai * 128 + m * 16) * 16 + fq * 4);
                float t = (s4[0] + s4[1]) + (s4[2] + s4[3]); t += __shfl_xor(t, 16); t += __shfl_xor(t, 32);
                rs[ai][m] = __builtin_amdgcn_rsqf(t * (1.f / 1024.f) + EPS) * scale;
            }
        switch (kind) {
            case 0: plain<0>(acc, u, rs, rloc, cloc); break;
            case 1: plain<1>(acc, u, rs, rloc, cloc); break;
            case 2: plain<2>(acc, u, rs, rloc, cloc); break;
            case 7: plain<7>(acc, u, rs, rloc, cloc); break;
            case 3: merge2<3>(acc, u, rs, rloc, cloc); break;
            default: merge2<4>(acc, u, rs, rloc, cloc); break;
        }
    }
};

DI void gemm_phase(LAS unsigned char* lds, const int K, const bool hook, const SchedU& S, const EpiU& E) {
    const int tid = opaque_tid(), wid = __builtin_amdgcn_readfirstlane(tid >> 6), lane = tid & 63, wr = wid >> 2, wc = wid & 3, fr = lane & 15, fq = lane >> 4;
    const int nt = K / BK;
    unsigned voffA[2], voffB[2];
#pragma unroll
    for (int i = 0; i < 2; ++i) { int R, C; stage_rc(tid * 16 + i * 8192, R, C); const int Rb = (R & ~31) + perm32(R & 31);
        voffA[i] = (unsigned)(R * K + C) * 2u; voffB[i] = (unsigned)(Rb * K + C) * 2u; }
    const size_t kstep = (size_t)(BK * 2);
    const size_t hstep = (size_t)HALF * K * 2;
    const unsigned ldsw = (unsigned)wid * 1024u;
    const int aoff = lds_byte(wr * 64 + fr, fq * 8), boff = lds_byte(wc * 32 + fr, fq * 8);
#define PG8_SA(b, h) (((b) * 2 + (h)) * HTB)
#define PG8_SB(b, h) ((4 + (b) * 2 + (h)) * HTB)
#define PG8_STAGE(bufoff, gbase, voff) do { _Pragma("unroll") for (int _i = 0; _i < 2; ++_i) \
        __builtin_amdgcn_global_load_lds((const unsigned*)((const char*)(gbase) + (voff)[_i]), (LAS unsigned*)(lds + (bufoff) + ldsw + _i * 8192), 16, 0, 0); } while (0)
#define PG8_LDA(dst, b, h) do { _Pragma("unroll") for (int m = 0; m < 4; ++m) _Pragma("unroll") for (int k = 0; k < 2; ++k) dst[m][k] = *(const LAS bf16x8*)(lds + PG8_SA(b, h) + aoff + m * 2048 + k * 1024); } while (0)
#define PG8_LDB(dst, b, h) do { _Pragma("unroll") for (int n = 0; n < 2; ++n) _Pragma("unroll") for (int k = 0; k < 2; ++k) dst[n][k] = *(const LAS bf16x8*)(lds + PG8_SB(b, h) + boff + n * 2048 + k * 1024); } while (0)
#define PG8_MMA(ai, bj, At, Bt) do { __builtin_amdgcn_s_setprio(1); _Pragma("unroll") for (int m = 0; m < 4; ++m) _Pragma("unroll") for (int n = 0; n < 2; ++n) _Pragma("unroll") for (int k = 0; k < 2; ++k) \
        acc[ai][bj][m][n] = __builtin_amdgcn_mfma_f32_16x16x32_bf16(Bt[n][k], At[m][k], acc[ai][bj][m][n], 0, 0, 0); __builtin_amdgcn_s_setprio(0); } while (0)
#define PG8_WAIT_V(n) asm volatile("s_waitcnt vmcnt(" #n ")" ::: "memory")
#define PG8_WAIT_L(n) asm volatile("s_waitcnt lgkmcnt(" #n ")" ::: "memory")
#define PG8_BAR __builtin_amdgcn_s_barrier()
#define PG8_SCHED __builtin_amdgcn_sched_barrier(0)
    Unit cur, nxt; int ui = 0;
    if (!S.next(0, cur)) return;
    f32x4 acc[2][2][4][2];
#pragma unroll
    for (int a = 0; a < 2; ++a)
#pragma unroll
        for (int b = 0; b < 2; ++b)
#pragma unroll
            for (int m = 0; m < 4; ++m)
#pragma unroll
                for (int n = 0; n < 2; ++n) acc[a][b][m][n] = (f32x4){0.f, 0.f, 0.f, 0.f};
    bf16x8 At[4][2], B0[2][2], B1[2][2];
    const char* cA = cur.a; const char* cB = cur.b;
    PG8_STAGE(PG8_SB(0, 0), cB, voffB); PG8_STAGE(PG8_SB(0, 1), cB + hstep, voffB); PG8_STAGE(PG8_SA(0, 0), cA, voffA); PG8_STAGE(PG8_SA(0, 1), cA + hstep, voffA);
    if (wr == 1) PG8_BAR;
    PG8_WAIT_V(2); PG8_BAR;
    PG8_STAGE(PG8_SB(1, 0), cB + kstep, voffB); PG8_STAGE(PG8_SA(1, 0), cA + kstep, voffA); PG8_STAGE(PG8_SB(1, 1), cB + hstep + kstep, voffB);
    PG8_WAIT_V(6); PG8_BAR;
    for (;;) {
        const bool has_next = S.next(ui + 1, nxt);
        const char* nA = has_next ? nxt.a : cA; const char* nB = has_next ? nxt.b : cB;
        for (int t = 0; t < nt; t += 2) {
            const bool last = (t == nt - 2);
            if (hook && t != 0 && (t & 7) == 0) E.rescale(acc, cur, t >> 3, wr, wc, fr, fq);
            asm volatile("" : "+v"(voffA[0]), "+v"(voffA[1]), "+v"(voffB[0]), "+v"(voffB[1]));
            const char* a1 = cA + (size_t)(t + 1) * kstep;
            const char* a2 = last ? nA : cA + (size_t)(t + 2) * kstep; const char* b2 = last ? nB : cB + (size_t)(t + 2) * kstep;
            const char* a3 = a2 + kstep; const char* b3 = b2 + kstep;
            PG8_LDB(B0, 0, 0); PG8_LDB(B1, 0, 1); PG8_SCHED; PG8_LDA(At, 0, 0); PG8_STAGE(PG8_SA(1, 1), a1 + hstep, voffA);
            PG8_WAIT_V(8); PG8_WAIT_L(0); PG8_BAR; PG8_MMA(0, 0, At, B0); PG8_MMA(0, 1, At, B1); PG8_BAR; PG8_SCHED;
            PG8_LDA(At, 0, 1); PG8_STAGE(PG8_SB(0, 0), b2, voffB); PG8_STAGE(PG8_SB(0, 1), b2 + hstep, voffB); PG8_STAGE(PG8_SA(0, 0), a2, voffA);
            PG8_WAIT_V(8); PG8_WAIT_L(0); PG8_BAR; PG8_MMA(1, 0, At, B0); PG8_MMA(1, 1, At, B1); PG8_BAR; PG8_SCHED;
            PG8_LDB(B0, 1, 0); PG8_LDB(B1, 1, 1); PG8_SCHED; PG8_LDA(At, 1, 0); PG8_STAGE(PG8_SA(0, 1), a2 + hstep, voffA);
            PG8_WAIT_V(8); PG8_WAIT_L(0); PG8_BAR; PG8_MMA(0, 0, At, B0); PG8_MMA(0, 1, At, B1); PG8_BAR; PG8_SCHED;
            PG8_LDA(At, 1, 1); PG8_STAGE(PG8_SB(1, 0), b3, voffB); PG8_STAGE(PG8_SB(1, 1), b3 + hstep, voffB); PG8_STAGE(PG8_SA(1, 0), a3, voffA);
            PG8_WAIT_V(8); PG8_WAIT_L(0); PG8_BAR; PG8_MMA(1, 0, At, B0); PG8_MMA(1, 1, At, B1); PG8_BAR; PG8_SCHED;
        }
        if (wr == 0) PG8_BAR;
        E(acc, cur, wr, wc, fr, fq);
        if (!has_next) break;
#pragma unroll
        for (int a = 0; a < 2; ++a)
#pragma unroll
            for (int b = 0; b < 2; ++b)
#pragma unroll
                for (int m = 0; m < 4; ++m)
#pragma unroll
                    for (int n = 0; n < 2; ++n) acc[a][b][m][n] = (f32x4){0.f, 0.f, 0.f, 0.f};
        cur = nxt; cA = nA; cB = nB; ++ui;
        if (wr == 1) PG8_BAR;
    }
    PG8_WAIT_V(0);
    PG8_BAR;
#undef PG8_SA
#undef PG8_SB
#undef PG8_STAGE
#undef PG8_LDA
#undef PG8_LDB
#undef PG8_MMA
#undef PG8_WAIT_V
#undef PG8_WAIT_L
#undef PG8_BAR
#undef PG8_SCHED
}
}

DI void transpose_item(const float* W, int K, int N, bf16_t* WT, int pitch, int k0, int n0, int drow0, const float* gk, float* scr, int lane) {
#pragma unroll
    for (int i = 0; i < 32; ++i) { const int kk = 2 * i + (lane >> 5); float v = W[(size_t)(k0 + kk) * N + n0 + (lane & 31)]; if (gk) v *= gk[k0 + kk]; scr[kk * 33 + (lane & 31)] = v; }
    asm volatile("s_waitcnt lgkmcnt(0)" ::: "memory");
    const int c = lane & 7;
#pragma unroll
    for (int j = 0; j < 4; ++j) { const int n = (lane >> 3) + 8 * j; const float* s = scr + (8 * c) * 33 + n;
        u32x4 o; o.x = pk_bf16(s[0 * 33], s[1 * 33]); o.y = pk_bf16(s[2 * 33], s[3 * 33]); o.z = pk_bf16(s[4 * 33], s[5 * 33]); o.w = pk_bf16(s[6 * 33], s[7 * 33]);
        *(u32x4*)(WT + (size_t)(drow0 + n) * pitch + k0 + 8 * c) = o; }
    asm volatile("s_waitcnt lgkmcnt(0)" ::: "memory");
}
DI int win_block_map(int sb) {
    if (sb < 4) return sb;
    if (sb < 8) return 4 + 2 * (sb - 4);
    if (sb < 12) return 12 + (sb - 8);
    if (sb < 16) return 5 + 2 * (sb - 12);
    if (sb < 24) return sb;
    if (sb < 28) return 24 + 2 * (sb - 24);
    if (sb < 32) return 25 + 2 * (sb - 28);
    return sb;
}
DI float row_to_bf16(const float* xrow, bf16_t* orow, int lane) {
    const f32x4* xr = (const f32x4*)xrow + lane; float s = 0.f; f32x4 v[4];
#pragma unroll
    for (int j = 0; j < 4; ++j) { v[j] = xr[64 * j]; s += (v[j].x * v[j].x + v[j].y * v[j].y) + (v[j].z * v[j].z + v[j].w * v[j].w); }
    u32x2* o = (u32x2*)orow + lane;
#pragma unroll
    for (int j = 0; j < 4; ++j) { u32x2 w; w.x = pk_bf16(v[j].x, v[j].y); w.y = pk_bf16(v[j].z, v[j].w); o[64 * j] = w; }
    return wave_sum(s);
}

DI void prologue(const Params& p, unsigned char* lds, int G, int mask) {
    const int tid = opaque_tid(), lane = tid & 63, wave = __builtin_amdgcn_readfirstlane(tid >> 6);
    float* scr = (float*)(lds + wave * 16384);
    const int gw = opaque_bid() * 8 + wave, NGW = G * 8;
    unsigned char* ws = ws_of(p);
    {
        constexpr int T_IN = 16 * 64, T_BR = 8 * 8, T_SQ = 16 * 8, T_F1 = 16 * 32, T_F2 = 64 * 8;
        constexpr int T_L = T_IN + 3 * T_BR + 5 * T_SQ + T_F1 + T_F2;
        unsigned* Tl = (unsigned*)lds;
        const int lr = tid >> 5, lc = (tid & 31) * 4;
        f32x4 cur[4], nxt[4]; const float* gk_c = nullptr; const float* gk_n = nullptr;
        bf16_t* WT_c = nullptr; bf16_t* WT_n = nullptr; int pitch_c = 0, pitch_n = 0, k0_c = 0, k0_n = 0, dr_c = 0, dr_n = 0;
#define TR_SETUP(it_, W_, N_, WT_, pitch_, gk_, k0_, n0_, dr_) do { \
            const int l_ = (it_) / T_L; int r_ = (it_) % T_L; bool is_in_ = false; int K_; (gk_) = nullptr; (pitch_) = 0; \
            if (r_ < T_IN) { W_ = p.in[9] + (size_t)l_ * 1024 * 8192; K_ = 1024; N_ = 8192; WT_ = (bf16_t*)(ws + WS_WIN) + (size_t)l_ * 8192 * 1024; gk_ = p.in[8] + l_ * 1024; is_in_ = true; } \
            else if ((r_ -= T_IN) < 3 * T_BR) { const int k_ = 1 + r_ / T_BR; r_ %= T_BR; W_ = p.in[21] + ((size_t)l_ * 4 + k_) * 512 * 1024; K_ = 512; N_ = 1024; WT_ = (bf16_t*)(ws + WS_WB) + (size_t)l_ * 2097152 + k_ * 512; pitch_ = 2048; } \
            else if ((r_ -= 3 * T_BR) < 5 * T_SQ) { const int w_ = r_ / T_SQ; r_ %= T_SQ; K_ = 1024; N_ = 1024; \
                if (w_ == 0) { W_ = p.in[23] + (size_t)l_ * 1048576; WT_ = (bf16_t*)(ws + WS_WMIX) + (size_t)l_ * 1048576; } \
                else if (w_ == 1) { W_ = p.in[26] + (size_t)l_ * 1048576; WT_ = (bf16_t*)(ws + WS_WQ) + (size_t)l_ * 1048576; gk_ = p.in[24] + l_ * 1024; } \
                else if (w_ == 2) { W_ = p.in[27] + (size_t)l_ * 1048576; WT_ = (bf16_t*)(ws + WS_WKV) + (size_t)l_ * 2097152; gk_ = p.in[25] + l_ * 1024; } \
                else if (w_ == 3) { W_ = p.in[28] + (size_t)l_ * 1048576; WT_ = (bf16_t*)(ws + WS_WKV) + (size_t)l_ * 2097152 + 1048576; gk_ = p.in[25] + l_ * 1024; } \
                else { W_ = p.in[29] + (size_t)l_ * 1048576; WT_ = (bf16_t*)(ws + WS_WO) + (size_t)l_ * 1048576; } } \
            else if ((r_ -= 5 * T_SQ) < T_F1) { W_ = p.in[31] + (size_t)l_ * 4194304; K_ = 1024; N_ = 4096; WT_ = (bf16_t*)(ws + WS_W1) + (size_t)l_ * 4194304; gk_ = p.in[30] + l_ * 1024; } \
            else { r_ -= T_F1; W_ = p.in[32] + (size_t)l_ * 4194304; K_ = 4096; N_ = 1024; WT_ = (bf16_t*)(ws + WS_W2) + (size_t)l_ * 4194304; } \
            if (!(pitch_)) (pitch_) = K_; \
            const int nblk_ = N_ / 128; (k0_) = 64 * (r_ / nblk_); (n0_) = 128 * (r_ % nblk_); (dr_) = is_in_ ? win_block_map((n0_) >> 7) * 128 : (n0_); } while (0)
        int it = opaque_bid();
        if ((mask & 1) && it < 2 * T_L) {
            { const float* W; int N, n0; TR_SETUP(it, W, N, WT_c, pitch_c, gk_c, k0_c, n0, dr_c);
#pragma unroll
              for (int i = 0; i < 4; ++i) cur[i] = *(const f32x4*)(W + (size_t)(k0_c + lr + 16 * i) * N + n0 + lc); }
            for (; it < 2 * T_L; it += G) {
                const int itn = it + G; const bool has_n = itn < 2 * T_L;
                if (has_n) { const float* W; int N, n0; TR_SETUP(itn, W, N, WT_n, pitch_n, gk_n, k0_n, n0, dr_n);
#pragma unroll
                    for (int i = 0; i < 4; ++i) nxt[i] = *(const f32x4*)(W + (size_t)(k0_n + lr + 16 * i) * N + n0 + lc); }
                unsigned short* Th = (unsigned short*)Tl;
#pragma unroll
                for (int i = 0; i < 4; ++i) {
                    const int kk = lr + 16 * i; const float g = gk_c ? gk_c[k0_c + kk] : 1.f; const f32x4 v = cur[i] * g;
#pragma unroll
                    for (int j = 0; j < 4; ++j) Th[(lc + j) * 66 + kk] = (unsigned short)(pk_bf16(v[j], 0.f) & 0xffffu);
                }
                __syncthreads();
#pragma unroll
                for (int q = 0; q < 2; ++q) {
                    const int idx = tid + 512 * q, n = idx >> 3, c = idx & 7; const unsigned* src = Tl + n * 33 + c * 4;
                    u32x4 o; o.x = src[0]; o.y = src[1]; o.z = src[2]; o.w = src[3];
                    *(u32x4*)(WT_c + (size_t)(dr_c + n) * pitch_c + k0_c + 8 * c) = o;
                }
                __syncthreads();
#pragma unroll
                for (int i = 0; i < 4; ++i) cur[i] = nxt[i];
                gk_c = gk_n; WT_c = WT_n; pitch_c = pitch_n; k0_c = k0_n; dr_c = dr_n;
            }
        }
#undef TR_SETUP
        __syncthreads();
    }
    if (mask & 2)
    for (int it = opaque_bid(); it < 2 * 4 * 32; it += G) {
        const int l = it >> 7, g = (it >> 5) & 3, db = it & 31;
        float* pwT = (float*)lds;
        __syncthreads();
        {
            const float* pw = p.in[10] + ((size_t)l * 4 + g) * 16384; const float* sc = p.in[11] + l * 512 + g * 128;
#pragma unroll 8
            for (int e = tid; e < 16384; e += 512) { const int i = e >> 7, j = e & 127; pwT[j * 132 + i] = pw[e] * sc[j]; }
        }
        __syncthreads();
        const int d = db * 32 + (tid & 31), i0 = (tid >> 5) * 8;
        const float* wb = p.in[21] + ((size_t)l * 4) * 512 * 1024 + (size_t)(g * 128) * 1024 + d;
        float a[8];
#pragma unroll
        for (int r = 0; r < 8; ++r) a[r] = 0.f;
#pragma unroll 16
        for (int j = 0; j < 128; ++j) {
            const float w = wb[(size_t)j * 1024];
            const f32x4 p0 = *(const f32x4*)(pwT + j * 132 + i0), p1 = *(const f32x4*)(pwT + j * 132 + i0 + 4);
            a[0] += p0[0] * w; a[1] += p0[1] * w; a[2] += p0[2] * w; a[3] += p0[3] * w; a[4] += p1[0] * w; a[5] += p1[1] * w; a[6] += p1[2] * w; a[7] += p1[3] * w;
        }
        bf16_t* o = (bf16_t*)(ws + WS_WB) + (size_t)l * 2097152 + (size_t)d * 2048 + g * 128 + i0;
        u32x4 w0; w0.x = pk_bf16(a[0], a[1]); w0.y = pk_bf16(a[2], a[3]); w0.z = pk_bf16(a[4], a[5]); w0.w = pk_bf16(a[6], a[7]);
        *(u32x4*)o = w0;
    }
    __syncthreads();
    if (mask & 4) {
    for (int e = opaque_bid() * 512 + tid; e < 2 * 4 * 128 * 128; e += G * 512) {
        const int t = (e >> 7) & 127, s = e & 127; const float v = (s <= t) ? p.in[15][e] : 0.f;
        ((bf16_t*)(ws + WS_SGUW))[e] = (bf16_t)(pk_bf16(v, 0.f) & 0xffffu);
    }
    float* SS = (float*)(ws + WS_SS);
    for (int m0 = gw; m0 < MT; m0 += 2 * NGW) {
        const int m1 = m0 + NGW; const bool two = m1 < MT;
        const float* x0 = (m0 < MP) ? p.in[0] + (size_t)m0 * DM : p.in[1] + (size_t)(m0 - MP) * DM;
        const float* x1 = two ? ((m1 < MP) ? p.in[0] + (size_t)m1 * DM : p.in[1] + (size_t)(m1 - MP) * DM) : x0;
        f32x4 v0[4], v1[4];
#pragma unroll
        for (int j = 0; j < 4; ++j) { v0[j] = ((const f32x4*)x0)[lane + 64 * j]; v1[j] = ((const f32x4*)x1)[lane + 64 * j]; }
        float s0 = 0.f, s1 = 0.f;
#pragma unroll
        for (int j = 0; j < 4; ++j) { s0 += (v0[j].x * v0[j].x + v0[j].y * v0[j].y) + (v0[j].z * v0[j].z + v0[j].w * v0[j].w); s1 += (v1[j].x * v1[j].x + v1[j].y * v1[j].y) + (v1[j].z * v1[j].z + v1[j].w * v1[j].w); }
        u32x2* o0 = (u32x2*)((bf16_t*)(ws + WS_XB) + (size_t)m0 * DM) + lane;
#pragma unroll
        for (int j = 0; j < 4; ++j) { u32x2 w; w.x = pk_bf16(v0[j].x, v0[j].y); w.y = pk_bf16(v0[j].z, v0[j].w); o0[64 * j] = w; }
        s0 = wave_sum(s0);
        if (lane < 16) SS[(size_t)m0 * 16 + lane] = (lane == 0) ? s0 : 0.f;
        if (two) {
            u32x2* o1 = (u32x2*)((bf16_t*)(ws + WS_XB) + (size_t)m1 * DM) + lane;
#pragma unroll
            for (int j = 0; j < 4; ++j) { u32x2 w; w.x = pk_bf16(v1[j].x, v1[j].y); w.y = pk_bf16(v1[j].z, v1[j].w); o1[64 * j] = w; }
            s1 = wave_sum(s1);
            if (lane < 16) SS[(size_t)m1 * 16 + lane] = (lane == 0) ? s1 : 0.f;
        }
    }
    for (int m = gw; m < 2048; m += NGW) {
        const float s = row_to_bf16(p.in[7] + (size_t)m * DM, (bf16_t*)(ws + WS_MB) + (size_t)m * DM, lane);
        if (lane == 0) ((float*)(ws + WS_SSM))[m] = s;
    }
    }
}

template <bool SAMPLE, int NROWS>
DI void stage_rows(float* tile, int hist, const float* state, const bf16_t* Zcol, int rowbase, int tt0, float* outp, int ncarry, bool write_carry, int tid) {
    constexpr int ITER = (NROWS * 64 + 511) / 512;
    u32x4 vb[ITER]; f32x4 slo[ITER], shi[ITER];
#pragma unroll
    for (int i = 0; i < ITER; ++i) {
        const int c = tid + 512 * i, k = c >> 6, cc = (c & 63) * 8;
        vb[i] = (u32x4){0u, 0u, 0u, 0u}; slo[i] = (f32x4){0.f, 0.f, 0.f, 0.f}; shi[i] = (f32x4){0.f, 0.f, 0.f, 0.f};
        if (c < NROWS * 64) {
            if (SAMPLE) {
                if (k < hist) { slo[i] = *(const f32x4*)(state + (size_t)k * WBR + cc); shi[i] = *(const f32x4*)(state + (size_t)k * WBR + cc + 4); }
                else vb[i] = *(const u32x4*)(Zcol + (size_t)(rowbase + k - hist) * ZP + cc);
            } else {
                const int t = tt0 - hist + k;
                if (t >= 0) vb[i] = *(const u32x4*)(Zcol + (size_t)(rowbase + t) * ZP + cc);
            }
        }
    }
#pragma unroll
    for (int i = 0; i < ITER; ++i) {
        const int c = tid + 512 * i, k = c >> 6, cc = (c & 63) * 8;
        if (c < NROWS * 64) {
            f32x4 lo, hi; int ci;
            const u32x4 v = vb[i];
            lo = (f32x4){bf_lo(v.x), bf_hi(v.x), bf_lo(v.y), bf_hi(v.y)}; hi = (f32x4){bf_lo(v.z), bf_hi(v.z), bf_lo(v.w), bf_hi(v.w)};
            if (SAMPLE) { if (k < hist) { lo = slo[i]; hi = shi[i]; } ci = k - (NROWS - ncarry); }
            else ci = (tt0 - hist + k) - (SEQ - ncarry);
            *(f32x4*)(tile + k * WBR + cc) = lo; *(f32x4*)(tile + k * WBR + cc + 4) = hi;
            if (write_carry && ci >= 0) { *(f32x4*)(outp + (size_t)ci * WBR + cc) = lo; *(f32x4*)(outp + (size_t)ci * WBR + cc + 4) = hi; }
        }
    }
}
template <int NT, int W> DI void pool_compute(const float* tile, int ch, int tt0, bool sample, float (&o)[NT]) {
    float e[NT + 15];
#pragma unroll
    for (int k = 0; k < NT + 15; ++k) e[k] = tile[k * WBR + ch];
#pragma unroll
    for (int j = 0; j < NT; ++j) {
        float s = 0.f;
#pragma unroll
        for (int i = 0; i < W; ++i) s += e[j + 15 - i];
        const int pos = tt0 + j; const float inv = (sample || pos + 1 >= W) ? 1.f / (float)W : 1.f / (float)(pos + 1);
        o[j] = s * inv - e[j + 15];
    }
}
struct ConvConst { float cw[31]; float cb, lng, lnb, sw0, sw1, sw2, sg, sb; };
template <int NT, bool SAMPLE>
DI void conv_item(const Params& p, int l, int b, int tt0, const ConvConst& cc, float* tile, float* red, int tid, int lane, int wave) {
    const bf16_t* Z = (const bf16_t*)(ws_of(p) + WS_Z); const int ch = tid;
    const int rowbase = SAMPLE ? MP + b * NSQ : b * SEQ; const int row0 = SAMPLE ? rowbase : rowbase + tt0;
    const bool lastp = SAMPLE || (tt0 + NT == SEQ);
    stage_rows<SAMPLE, NT + 15>(tile, 15, SAMPLE ? p.in[2] + ((size_t)l * NSB + b) * 15 * WBR : nullptr, Z, rowbase, tt0,
                       SAMPLE ? out_of(p) + O_POOLS + ((size_t)l * NSB + b) * 15 * WBR : out_of(p) + O_POOLP + ((size_t)l * NB + b) * 15 * WBR, 15, lastp, tid);
    __syncthreads();
    {
        float o[NT];
        switch (wave >> 1) {
            case 0: pool_compute<NT, 2>(tile, ch, tt0, SAMPLE, o); break;
            case 1: pool_compute<NT, 4>(tile, ch, tt0, SAMPLE, o); break;
            case 2: pool_compute<NT, 8>(tile, ch, tt0, SAMPLE, o); break;
            default: pool_compute<NT, 16>(tile, ch, tt0, SAMPLE, o); break;
        }
        bf16_t* BR0 = (bf16_t*)(ws_of(p) + WS_BR) + (size_t)row0 * 2048 + ch;
#pragma unroll
        for (int j = 0; j < NT; ++j) BR0[j * 2048] = (bf16_t)(pk_bf16(o[j], 0.f) & 0xffffu);
    }
    __syncthreads();
    stage_rows<SAMPLE, NT + 2>(tile, 2, SAMPLE ? p.in[3] + ((size_t)l * NSB + b) * 2 * WBR : nullptr, Z + 512, rowbase, tt0,
                       SAMPLE ? out_of(p) + O_SCS + ((size_t)l * NSB + b) * 2 * WBR : out_of(p) + O_SCP + ((size_t)l * NB + b) * 2 * WBR, 2, lastp, tid);
    stage_rows<false, NT>(tile + (NT + 2) * WBR, 0, nullptr, Z + 1024, row0, 0, nullptr, 0, false, tid);
    __syncthreads();
    {
        bf16_t* BR1 = (bf16_t*)(ws_of(p) + WS_BR) + (size_t)row0 * 2048 + 512 + ch;
#pragma unroll
        for (int j = 0; j < NT; ++j) {
            const float c = cc.sw0 * tile[j * WBR + ch] + cc.sw1 * tile[(j + 1) * WBR + ch] + cc.sw2 * tile[(j + 2) * WBR + ch];
            BR1[j * 2048] = (bf16_t)(pk_bf16(tile[(NT + 2 + j) * WBR + ch] * c, 0.f) & 0xffffu);
        }
    }
    __syncthreads();
    stage_rows<SAMPLE, NT + 30>(tile, 30, SAMPLE ? p.in[4] + ((size_t)l * NSB + b) * 30 * WBR : nullptr, Z + 2560, rowbase, tt0,
                       SAMPLE ? out_of(p) + O_CCS + ((size_t)l * NSB + b) * 30 * WBR : out_of(p) + O_CCP + ((size_t)l * NB + b) * 30 * WBR, 30, lastp, tid);
    __syncthreads();
    float a[NT];
#pragma unroll
    for (int j = 0; j < NT; ++j) a[j] = cc.cb;
#pragma unroll
    for (int k = 0; k < NT + 30; ++k) {
        const float v = tile[k * WBR + ch];
#pragma unroll
        for (int j = 0; j < NT; ++j) { const int tap = k - j; if (tap >= 0 && tap <= 30) a[j] += cc.cw[tap] * v; }
    }
#pragma unroll
    for (int j = 0; j < NT; ++j) {
        const float s1 = wave_sum(a[j]), s2 = wave_sum(a[j] * a[j]);
        if (lane == 0) { red[(wave * NT + j) * 2] = s1; red[(wave * NT + j) * 2 + 1] = s2; }
    }
    __syncthreads();
    {
        bf16_t* BR3 = (bf16_t*)(ws_of(p) + WS_BR) + (size_t)row0 * 2048 + 1536 + ch;
#pragma unroll
        for (int j = 0; j < NT; ++j) {
            float s1 = 0.f, s2 = 0.f;
#pragma unroll
            for (int w = 0; w < 8; ++w) { s1 += red[(w * NT + j) * 2]; s2 += red[(w * NT + j) * 2 + 1]; }
            const float mean = s1 * (1.f / 512.f), var = fmaxf(s2 * (1.f / 512.f) - mean * mean, 0.f), rstd = __builtin_amdgcn_rsqf(var + EPS);
            const float y = (a[j] - mean) * rstd * cc.lng + cc.lnb;
            BR3[j * 2048] = (bf16_t)(pk_bf16(y * sigmoidf_(y), 0.f) & 0xffffu);
        }
    }
    __syncthreads();
    if (SAMPLE) {
        stage_rows<false, NT>(tile, 0, nullptr, Z + 2048, row0, 0, nullptr, 0, false, tid);
        stage_rows<false, NT>(tile + NT * WBR, 0, nullptr, Z + 1536, row0, 0, nullptr, 0, false, tid);
        __syncthreads();
        float v[NT];
#pragma unroll
        for (int j = 0; j < NT; ++j) {
            v[j] = tile[j * WBR + ch];
            const float s1 = wave_sum(v[j]), s2 = wave_sum(v[j] * v[j]);
            if (lane == 0) { red[(wave * NT + j) * 2] = s1; red[(wave * NT + j) * 2 + 1] = s2; }
        }
        __syncthreads();
        float* ov = out_of(p) + O_SGUV + (((size_t)l * NSB + b) * NSQ) * WBR + ch;
#pragma unroll
        for (int j = 0; j < NT; ++j) {
            float s1 = 0.f, s2 = 0.f;
#pragma unroll
            for (int w = 0; w < 8; ++w) { s1 += red[(w * NT + j) * 2]; s2 += red[(w * NT + j) * 2 + 1]; }
            const float mean = s1 * (1.f / 512.f), var = fmaxf(s2 * (1.f / 512.f) - mean * mean, 0.f), rstd = __builtin_amdgcn_rsqf(var + EPS);
            v[j] = (v[j] - mean) * rstd * cc.sg + cc.sb;
            ov[j * WBR] = v[j];
        }
        const int g = wave >> 1;
        const float* Wg = p.in[15] + ((size_t)l * 4 + g) * 128 * 128; const float* bs = p.in[16] + ((size_t)l * 4 + g) * 128;
        bf16_t* BR2 = (bf16_t*)(ws_of(p) + WS_BR) + (size_t)row0 * 2048 + 1024 + ch;
#pragma unroll
        for (int t = 0; t < NT; ++t) {
            float s0 = bs[t];
#pragma unroll
            for (int s = 0; s <= t; ++s) s0 += Wg[t * 128 + s] * v[s];
            BR2[t * 2048] = (bf16_t)(pk_bf16(tile[(NT + t) * WBR + ch] * s0, 0.f) & 0xffffu);
        }
        __syncthreads();
    }
}

DI float ldh(const bf16_t* t, int idx) { return __uint_as_float((unsigned)t[idx] << 16); }
template <int W> DI void pool_compute_h(const bf16_t* tile, int ch, int tt0, float (&o)[16]) {
    float e[31];
#pragma unroll
    for (int k = 0; k < 31; ++k) e[k] = ldh(tile, k * WBR + ch);
#pragma unroll
    for (int j = 0; j < 16; ++j) {
        float s = 0.f;
#pragma unroll
        for (int i = 0; i < W; ++i) s += e[j + 15 - i];
        const int pos = tt0 + j; const float inv = (pos + 1 >= W) ? 1.f / (float)W : 1.f / (float)(pos + 1);
        o[j] = s * inv - e[j + 15];
    }
}
DI void conv_item_p(const Params& p, int l, int b, int tt0, const ConvConst& cc, unsigned char* lds, float* red, int tid, int lane, int wave) {
    constexpr int NT = 16, RA = 0, RB = 31, RBB = 49, RD = 65, NR = 111;
    const bf16_t* Z = (const bf16_t*)(ws_of(p) + WS_Z); const int ch = tid;
    const int rowbase = b * SEQ, row0 = rowbase + tt0; const bool lastp = (tt0 + NT == SEQ);
    bf16_t* tile = (bf16_t*)lds;
    {
        constexpr int ITER = (NR * 64 + 511) / 512, HB = ITER / 2;
#pragma unroll 1
        for (int h = 0; h < 2; ++h) {
            u32x4 vb[HB];
#pragma unroll
            for (int i = 0; i < HB; ++i) {
                const int c = tid + 512 * (h * HB + i), r = c >> 6, cc8 = (c & 63) * 8; vb[i] = (u32x4){0u, 0u, 0u, 0u};
                if (c < NR * 64) {
                    int hist, col, kk;
                    if (r < RB) { hist = 15; col = 0; kk = r; } else if (r < RBB) { hist = 2; col = 512; kk = r - RB; } else if (r < RD) { hist = 0; col = 1024; kk = r - RBB; } else { hist = 30; col = 2560; kk = r - RD; }
                    const int t = tt0 - hist + kk;
                    if (t >= 0) vb[i] = *(const u32x4*)(Z + (size_t)(rowbase + t) * ZP + col + cc8);
                }
            }
#pragma unroll
            for (int i = 0; i < HB; ++i) {
                const int c = tid + 512 * (h * HB + i), r = c >> 6, cc8 = (c & 63) * 8;
                if (c < NR * 64) *(u32x4*)(tile + r * WBR + cc8) = vb[i];
            }
        }
    }
    __syncthreads();
    if (lastp) {
#pragma unroll 1
        for (int c = tid; c < NR * 64; c += 512) {
            const int r = c >> 6, cc8 = (c & 63) * 8;
            if (r < RBB || r >= RD) {
                int hist, kk, nc; size_t ob;
                if (r < RB) { hist = 15; kk = r; nc = 15; ob = O_POOLP + ((size_t)l * NB + b) * 15 * WBR; }
                else if (r < RBB) { hist = 2; kk = r - RB; nc = 2; ob = O_SCP + ((size_t)l * NB + b) * 2 * WBR; }
                else { hist = 30; kk = r - RD; nc = 30; ob = O_CCP + ((size_t)l * NB + b) * 30 * WBR; }
                const int ci = (tt0 - hist + kk) - (SEQ - nc);
                if (ci >= 0) { const u32x4 v = *(const u32x4*)(tile + r * WBR + cc8); float* o = out_of(p) + ob + (size_t)ci * WBR + cc8;
                    *(f32x4*)o = (f32x4){bf_lo(v.x), bf_hi(v.x), bf_lo(v.y), bf_hi(v.y)}; *(f32x4*)(o + 4) = (f32x4){bf_lo(v.z), bf_hi(v.z), bf_lo(v.w), bf_hi(v.w)}; }
            }
        }
    }
    float oA[NT], oB[NT];
    switch (wave >> 1) {
        case 0: pool_compute_h<2>(tile + RA * WBR, ch, tt0, oA); break;
        case 1: pool_compute_h<4>(tile + RA * WBR, ch, tt0, oA); break;
        case 2: pool_compute_h<8>(tile + RA * WBR, ch, tt0, oA); break;
        default: pool_compute_h<16>(tile + RA * WBR, ch, tt0, oA); break;
    }
    {
        const bf16_t* tb = tile + RB * WBR; const bf16_t* tbb = tile + RBB * WBR;
#pragma unroll
        for (int j = 0; j < NT; ++j) {
            const float c = cc.sw0 * ldh(tb, j * WBR + ch) + cc.sw1 * ldh(tb, (j + 1) * WBR + ch) + cc.sw2 * ldh(tb, (j + 2) * WBR + ch);
            oB[j] = ldh(tbb, j * WBR + ch) * c;
        }
    }
    float a[NT];
#pragma unroll
    for (int j = 0; j < NT; ++j) a[j] = cc.cb;
    {
        const bf16_t* td = tile + RD * WBR;
#pragma unroll
        for (int k = 0; k < NT + 30; ++k) {
            const float v = ldh(td, k * WBR + ch);
#pragma unroll
            for (int j = 0; j < NT; ++j) { const int tap = k - j; if (tap >= 0 && tap <= 30) a[j] += cc.cw[tap] * v; }
        }
    }
    {
        float v[2 * NT];
#pragma unroll
        for (int j = 0; j < NT; ++j) { v[2 * j] = a[j]; v[2 * j + 1] = a[j] * a[j]; }
        XReduce<2 * NT, 32>::run(v, lane);
        const int idx = lane >> 1;
        if ((lane & 1) == 0) red[((idx >> 1) * 8 + wave) * 2 + (idx & 1)] = v[0];
    }
    __syncthreads();
#pragma unroll
    for (int j = 0; j < NT; ++j) {
        const f32x4* rp = (const f32x4*)(red + j * 16); const f32x4 r0 = rp[0], r1 = rp[1], r2 = rp[2], r3 = rp[3];
        const float s1 = (r0[0] + r0[2]) + (r1[0] + r1[2]) + (r2[0] + r2[2]) + (r3[0] + r3[2]), s2 = (r0[1] + r0[3]) + (r1[1] + r1[3]) + (r2[1] + r2[3]) + (r3[1] + r3[3]);
        const float mean = s1 * (1.f / 512.f), var = fmaxf(s2 * (1.f / 512.f) - mean * mean, 0.f), rstd = __builtin_amdgcn_rsqf(var + EPS);
        const float y = (a[j] - mean) * rstd * cc.lng + cc.lnb;
        tile[(0 * NT + j) * WBR + ch] = (bf16_t)(pk_bf16(oA[j], 0.f) & 0xffffu);
        tile[(1 * NT + j) * WBR + ch] = (bf16_t)(pk_bf16(oB[j], 0.f) & 0xffffu);
        tile[(2 * NT + j) * WBR + ch] = (bf16_t)(pk_bf16(y * sigmoidf_(y), 0.f) & 0xffffu);
    }
    __syncthreads();
    {
        bf16_t* BRb = (bf16_t*)(ws_of(p) + WS_BR) + (size_t)row0 * 2048;
#pragma unroll
        for (int q = 0; q < 6; ++q) {
            const int idx = tid + 512 * q, br = idx >> 10, j = (idx >> 6) & 15, c8 = (idx & 63) * 8;
            const u32x4 v = *(const u32x4*)(tile + (br * NT + j) * WBR + c8);
            *(u32x4*)(BRb + (size_t)j * 2048 + (br == 2 ? 1536 : br * 512) + c8) = v;
        }
    }
    __syncthreads();
}

DI void sgu_item(const Params& p, int l, int it, unsigned char* lds) {
    const int tid = opaque_tid(), lane = tid & 63, wave = __builtin_amdgcn_readfirstlane(tid >> 6);
    const int g = it & 3, chunk = (it >> 2) & 15, b = it >> 6;
    const int rowbase = b * SEQ + chunk * 128;
    const bf16_t* Z = (const bf16_t*)(ws_of(p) + WS_Z);
    bf16_t* vnT = (bf16_t*)lds;
    float* Sb = (float*)(lds + 36864);
    {
        u32x4 v[16];
#pragma unroll
        for (int r = 0; r < 16; ++r) v[r] = *(const u32x4*)(Z + (size_t)(rowbase + wave * 16 + r) * ZP + 2048 + lane * 8);
        float s1[16], s2[16];
#pragma unroll
        for (int r = 0; r < 16; ++r) {
            const float x[8] = {bf_lo(v[r].x), bf_hi(v[r].x), bf_lo(v[r].y), bf_hi(v[r].y), bf_lo(v[r].z), bf_hi(v[r].z), bf_lo(v[r].w), bf_hi(v[r].w)};
            float a = 0.f, q = 0.f;
#pragma unroll
            for (int i = 0; i < 8; ++i) { a += x[i]; q += x[i] * x[i]; }
            s1[r] = a; s2[r] = q;
        }
        {
            float vv[32];
#pragma unroll
            for (int r = 0; r < 16; ++r) { vv[2 * r] = s1[r]; vv[2 * r + 1] = s2[r]; }
            XReduce<32, 32>::run(vv, lane);
            float* sb = (float*)(lds + LDS_MISC + 1024) + wave * 32;
            if ((lane & 1) == 0) sb[lane >> 1] = vv[0];
            asm volatile("s_waitcnt lgkmcnt(0)" ::: "memory");
#pragma unroll
            for (int r = 0; r < 16; ++r) { s1[r] = sb[2 * r]; s2[r] = sb[2 * r + 1]; }
            asm volatile("" ::: "memory");
        }
        if ((lane >> 4) == g) {
            const int c0 = (lane & 15) * 8;
            const f32x4 gA = *(const f32x4*)(p.in[13] + l * WBR + lane * 8), gB = *(const f32x4*)(p.in[13] + l * WBR + lane * 8 + 4);
            const f32x4 bA = *(const f32x4*)(p.in[14] + l * WBR + lane * 8), bB = *(const f32x4*)(p.in[14] + l * WBR + lane * 8 + 4);
            const float gg[8] = {gA.x, gA.y, gA.z, gA.w, gB.x, gB.y, gB.z, gB.w}, bb[8] = {bA.x, bA.y, bA.z, bA.w, bB.x, bB.y, bB.z, bB.w};
#pragma unroll
            for (int r = 0; r < 16; ++r) {
                const int s = wave * 16 + r;
                const float mean = s1[r] * (1.f / 512.f), var = fmaxf(s2[r] * (1.f / 512.f) - mean * mean, 0.f), rstd = __builtin_amdgcn_rsqf(var + EPS);
                const float x[8] = {bf_lo(v[r].x), bf_hi(v[r].x), bf_lo(v[r].y), bf_hi(v[r].y), bf_lo(v[r].z), bf_hi(v[r].z), bf_lo(v[r].w), bf_hi(v[r].w)};
#pragma unroll
                for (int i = 0; i < 8; ++i) { const float y = (x[i] - mean) * rstd * gg[i] + bb[i]; vnT[(c0 + i) * 136 + s] = (bf16_t)(pk_bf16(y, 0.f) & 0xffffu); }
            }
        }
    }
    __syncthreads();
    {
        const int fr = lane & 15, kq = lane >> 4;
        f32x4 acc[8];
#pragma unroll
        for (int cb = 0; cb < 8; ++cb) acc[cb] = (f32x4){0.f, 0.f, 0.f, 0.f};
        const bf16_t* Wt = (const bf16_t*)(ws_of(p) + WS_SGUW) + ((size_t)l * 4 + g) * 16384 + (size_t)(wave * 16 + fr) * 128 + kq * 8;
        const int nks = (wave >> 1) + 1;
        for (int ks = 0; ks < nks; ++ks) {
            const bf16x8 a = *(const bf16x8*)(Wt + ks * 32);
#pragma unroll
            for (int cb = 0; cb < 8; ++cb) {
                const bf16x8 bfr = *(const bf16x8*)(vnT + (cb * 16 + fr) * 136 + ks * 32 + kq * 8);
                acc[cb] = __builtin_amdgcn_mfma_f32_16x16x32_bf16(a, bfr, acc[cb], 0, 0, 0);
            }
        }
        const float* bs = p.in[16] + ((size_t)l * 4 + g) * 128;
#pragma unroll
        for (int j = 0; j < 4; ++j) {
            const int t = wave * 16 + kq * 4 + j; const float bt = bs[t];
#pragma unroll
            for (int cb = 0; cb < 8; ++cb) Sb[t * 132 + cb * 16 + fr] = acc[cb][j] + bt;
        }
    }
    __syncthreads();
    {
        bf16_t* BR2 = (bf16_t*)(ws_of(p) + WS_BR) + 1024 + g * 128;
        u32x4 cu[4];
#pragma unroll
        for (int q = 0; q < 4; ++q) { const int idx = tid + 512 * q, t = idx >> 4, c8 = (idx & 15) * 8; cu[q] = *(const u32x4*)(Z + (size_t)(rowbase + t) * ZP + 1536 + g * 128 + c8); }
#pragma unroll
        for (int q = 0; q < 4; ++q) {
            const int idx = tid + 512 * q, t = idx >> 4, c8 = (idx & 15) * 8;
            const f32x4 sa = *(const f32x4*)(Sb + t * 132 + c8), sb = *(const f32x4*)(Sb + t * 132 + c8 + 4); const u32x4 u = cu[q]; u32x4 w;
            w.x = pk_bf16(bf_lo(u.x) * sa[0], bf_hi(u.x) * sa[1]); w.y = pk_bf16(bf_lo(u.y) * sa[2], bf_hi(u.y) * sa[3]);
            w.z = pk_bf16(bf_lo(u.z) * sb[0], bf_hi(u.z) * sb[1]); w.w = pk_bf16(bf_lo(u.w) * sb[2], bf_hi(u.w) * sb[3]);
            *(u32x4*)(BR2 + (size_t)(rowbase + t) * 2048 + c8) = w;
        }
    }
    __syncthreads();
}

DI void branch_phase(const Params& p, int l, unsigned char* lds, int G, int mask) {
    const int tid = opaque_tid(), lane = tid & 63, wave = __builtin_amdgcn_readfirstlane(tid >> 6);
    float* red = (float*)(lds + LDS_MISC); float* tile = (float*)lds;
    if (mask & 1) {
        const int bid = opaque_bid();
        if (G == 256) {
            if (bid < 128) { if (EN_SGU) sgu_item(p, l, bid * 4, lds); }
            else for (int k = 0; k < 3; ++k) { if (EN_SGU) sgu_item(p, l, (bid - 128) * 4 + 1 + k, lds); }
        } else for (int it = bid; it < 512; it += G) { if (EN_SGU) sgu_item(p, l, it, lds); }
    }
    if (!(mask & 2)) return;
    ConvConst cc;
#pragma unroll
    for (int t = 0; t < 31; ++t) cc.cw[t] = p.in[17][((size_t)l * 31 + t) * WBR + tid];
    cc.cb = p.in[18][l * WBR + tid]; cc.lng = p.in[19][l * WBR + tid]; cc.lnb = p.in[20][l * WBR + tid];
    cc.sw0 = p.in[12][(size_t)l * 3 * WBR + tid]; cc.sw1 = p.in[12][(size_t)l * 3 * WBR + WBR + tid]; cc.sw2 = p.in[12][(size_t)l * 3 * WBR + 2 * WBR + tid];
    cc.sg = p.in[13][l * WBR + tid]; cc.sb = p.in[14][l * WBR + tid];
    if (G == 256) {
        const int bid = opaque_bid();
        for (int k = 0; k < 4; ++k) { const int it = bid * 4 + k; if (EN_CP) conv_item_p(p, l, it >> 7, (it & 127) * 16, cc, lds, red, tid, lane, wave); }
        if (bid < 128) { if (EN_CS) conv_item<8, true>(p, l, bid, 0, cc, tile, red, tid, lane, wave); }
    } else
    for (int it = opaque_bid(); it < 1152; it += G) {
        if (it < 1024) { if (EN_CP) conv_item_p(p, l, it >> 7, (it & 127) * 16, cc, lds, red, tid, lane, wave); }
        else { if (EN_CS) conv_item<8, true>(p, l, it - 1024, 0, cc, tile, red, tid, lane, wave); }
    }
}

constexpr int KPITCH = 264;
DI void attn_prompt_unit(const Params& p, int l, int u, unsigned char* lds) {
    const int tid = opaque_tid(), lane = tid & 63, wave = tid >> 6, fr = lane & 15, kq = lane >> 4;
    const int b = u >> 6, h = (u >> 4) & 3, qb = u & 15;
    const size_t hb = ((size_t)(l * 8 + b) * 4 + h) * 65536;
    const bf16_t* Kg = (const bf16_t*)(ws_of(p) + WS_KP) + hb; const bf16_t* Vg = (const bf16_t*)(ws_of(p) + WS_VTP) + hb;
    bf16_t* img = (bf16_t*)lds;
    const int qrow = b * SEQ + qb * 128 + wave * 16 + fr;
    const bf16_t* Qg = (const bf16_t*)(ws_of(p) + WS_Q) + (size_t)qrow * DM + h * 256 + kq * 8;
    bf16x8 qf[8];
#pragma unroll
    for (int ks = 0; ks < 8; ++ks) qf[ks] = *(const bf16x8*)(Qg + ks * 32);
    {
        u32x4 st[16];
#pragma unroll
        for (int i = 0; i < 16; ++i) { const int c = tid + 512 * i, r = c >> 5, c16 = c & 31; st[i] = *(const u32x4*)(Kg + r * 256 + c16 * 8); }
#pragma unroll
        for (int i = 0; i < 16; ++i) { const int c = tid + 512 * i, r = c >> 5, c16 = c & 31; *(u32x4*)(img + r * KPITCH + c16 * 8) = st[i]; }
    }
    __syncthreads();
    f32x4 s[16];
#pragma unroll
    for (int kb = 0; kb < 16; kb += 2) {
        bf16x8 kf0[8], kf1[8];
#pragma unroll
        for (int ks = 0; ks < 8; ++ks) { kf0[ks] = *(const bf16x8*)(img + (kb * 16 + fr) * KPITCH + ks * 32 + kq * 8); kf1[ks] = *(const bf16x8*)(img + ((kb + 1) * 16 + fr) * KPITCH + ks * 32 + kq * 8); }
        s[kb] = (f32x4){0.f, 0.f, 0.f, 0.f}; s[kb + 1] = (f32x4){0.f, 0.f, 0.f, 0.f};
#pragma unroll
        for (int ks = 0; ks < 8; ++ks) {
            s[kb] = __builtin_amdgcn_mfma_f32_16x16x32_bf16(kf0[ks], qf[ks], s[kb], 0, 0, 0);
            s[kb + 1] = __builtin_amdgcn_mfma_f32_16x16x32_bf16(kf1[ks], qf[ks], s[kb + 1], 0, 0, 0);
        }
    }
    u32x4 vst[16];
#pragma unroll
    for (int i = 0; i < 16; ++i) { const int c = tid + 512 * i, r = c >> 5, c16 = c & 31; vst[i] = *(const u32x4*)(Vg + r * 256 + c16 * 8); }
    float mx = -INFINITY;
#pragma unroll
    for (int kb = 0; kb < 16; ++kb) mx = fmaxf(fmaxf(fmaxf(mx, s[kb][0]), fmaxf(s[kb][1], s[kb][2])), s[kb][3]);
    mx = fmaxf(mx, __shfl_xor(mx, 16)); mx = fmaxf(mx, __shfl_xor(mx, 32));
    float sum = 0.f;
#pragma unroll
    for (int kb = 0; kb < 16; ++kb)
#pragma unroll
        for (int j = 0; j < 4; ++j) { const float e = __builtin_amdgcn_exp2f(s[kb][j] - mx); s[kb][j] = e; sum += e; }
    sum += __shfl_xor(sum, 16); sum += __shfl_xor(sum, 32);
    const float inv = __builtin_amdgcn_rcpf(sum);
    bf16x8 pb[8];
#pragma unroll
    for (int k2 = 0; k2 < 8; ++k2) {
        u32x4 w; w.x = pk_bf16(s[2 * k2][0], s[2 * k2][1]); w.y = pk_bf16(s[2 * k2][2], s[2 * k2][3]); w.z = pk_bf16(s[2 * k2 + 1][0], s[2 * k2 + 1][1]); w.w = pk_bf16(s[2 * k2 + 1][2], s[2 * k2 + 1][3]);
        pb[k2] = __builtin_bit_cast(bf16x8, w);
    }
    __syncthreads();
#pragma unroll
    for (int i = 0; i < 16; ++i) { const int c = tid + 512 * i, r = c >> 5, c16 = c & 31; *(u32x4*)(img + r * KPITCH + c16 * 8) = vst[i]; }
    __syncthreads();
    bf16_t* Og = (bf16_t*)(ws_of(p) + WS_O) + (size_t)qrow * DM + h * 256 + kq * 4;
#pragma unroll 2
    for (int db = 0; db < 16; db += 2) {
        f32x4 o0 = (f32x4){0.f, 0.f, 0.f, 0.f}, o1 = (f32x4){0.f, 0.f, 0.f, 0.f};
        bf16x8 vf0[8], vf1[8];
#pragma unroll
        for (int k2 = 0; k2 < 8; ++k2) {
            const bf16_t* vp = img + (db * 16 + fr) * KPITCH + k2 * 32 + kq * 4;
            const s16x4 lo = *(const s16x4*)vp, hi = *(const s16x4*)(vp + 16), lo1 = *(const s16x4*)(vp + 16 * KPITCH), hi1 = *(const s16x4*)(vp + 16 * KPITCH + 16);
            vf0[k2] = (bf16x8){lo[0], lo[1], lo[2], lo[3], hi[0], hi[1], hi[2], hi[3]};
            vf1[k2] = (bf16x8){lo1[0], lo1[1], lo1[2], lo1[3], hi1[0], hi1[1], hi1[2], hi1[3]};
        }
#pragma unroll
        for (int k2 = 0; k2 < 8; ++k2) {
            o0 = __builtin_amdgcn_mfma_f32_16x16x32_bf16(vf0[k2], pb[k2], o0, 0, 0, 0);
            o1 = __builtin_amdgcn_mfma_f32_16x16x32_bf16(vf1[k2], pb[k2], o1, 0, 0, 0);
        }
        u32x2 w; w.x = pk_bf16(o0[0] * inv, o0[1] * inv); w.y = pk_bf16(o0[2] * inv, o0[3] * inv);
        *(u32x2*)(Og + db * 16) = w;
        w.x = pk_bf16(o1[0] * inv, o1[1] * inv); w.y = pk_bf16(o1[2] * inv, o1[3] * inv);
        *(u32x2*)(Og + db * 16 + 16) = w;
    }
    __syncthreads();
}

DI void attn_sample_item(const Params& p, int l, int it, unsigned char* lds) {
    const int tid = opaque_tid(), lane = tid & 63, wave = tid >> 6, fr = lane & 15, kq = lane >> 4;
    const int b = it >> 2, h = it & 3;
    const float* Kc = p.in[5] + (((size_t)l * NSB + b) * 256) * 1024 + h * 256;
    const float* Vc = p.in[6] + (((size_t)l * NSB + b) * 256) * 1024 + h * 256;
    float* sS = (float*)lds;
    float* red = (float*)(lds + 8192);
    const int qrow = MP + b * NSQ + (fr & 7);
    const bf16_t* Qg = (const bf16_t*)(ws_of(p) + WS_Q) + (size_t)qrow * DM + h * 256 + kq * 8;
    bf16x8 qf[8];
#pragma unroll
    for (int ks = 0; ks < 8; ++ks) { qf[ks] = *(const bf16x8*)(Qg + ks * 32); if (fr >= 8) qf[ks] = (bf16x8){0, 0, 0, 0, 0, 0, 0, 0}; }
#pragma unroll
    for (int kb = 0; kb < 2; ++kb) {
        const float* kp = Kc + (size_t)(wave * 32 + kb * 16 + fr) * 1024 + kq * 8;
        f32x4 ka[8], kbv[8];
#pragma unroll
        for (int ks = 0; ks < 8; ++ks) { ka[ks] = __builtin_nontemporal_load((const f32x4*)(kp + ks * 32)); kbv[ks] = __builtin_nontemporal_load((const f32x4*)(kp + ks * 32 + 4)); }
        f32x4 s = (f32x4){0.f, 0.f, 0.f, 0.f};
#pragma unroll
        for (int ks = 0; ks < 8; ++ks) {
            u32x4 w; w.x = pk_bf16(ka[ks][0], ka[ks][1]); w.y = pk_bf16(ka[ks][2], ka[ks][3]); w.z = pk_bf16(kbv[ks][0], kbv[ks][1]); w.w = pk_bf16(kbv[ks][2], kbv[ks][3]);
            s = __builtin_amdgcn_mfma_f32_16x16x32_bf16(__builtin_bit_cast(bf16x8, w), qf[ks], s, 0, 0, 0);
        }
        if (fr < 8) {
#pragma unroll
            for (int j = 0; j < 4; ++j) sS[(wave * 32 + kb * 16 + kq * 4 + j) * 8 + fr] = s[j];
        }
    }
    __syncthreads();
    {
        float v[4]; float mx = -INFINITY;
#pragma unroll
        for (int i = 0; i < 4; ++i) { v[i] = sS[(lane + 64 * i) * 8 + wave]; mx = fmaxf(mx, v[i]); }
        mx = wave_max(mx); float sum = 0.f;
#pragma unroll
        for (int i = 0; i < 4; ++i) { v[i] = __builtin_amdgcn_exp2f(v[i] - mx); sum += v[i]; }
        sum = wave_sum(sum); const float inv = 1.f / sum;
#pragma unroll
        for (int i = 0; i < 4; ++i) sS[(lane + 64 * i) * 8 + wave] = v[i] * inv;
    }
    __syncthreads();
    {
        f32x4 o[8];
#pragma unroll
        for (int q = 0; q < 8; ++q) o[q] = (f32x4){0.f, 0.f, 0.f, 0.f};
        const float* vp = Vc + (size_t)(wave * 32) * 1024 + lane * 4;
#pragma unroll 8
        for (int k = 0; k < 32; ++k) {
            const f32x4 v = __builtin_nontemporal_load((const f32x4*)(vp + (size_t)k * 1024));
            const f32x4 p0 = *(const f32x4*)(sS + (wave * 32 + k) * 8), p1 = *(const f32x4*)(sS + (wave * 32 + k) * 8 + 4);
            o[0] += v * p0[0]; o[1] += v * p0[1]; o[2] += v * p0[2]; o[3] += v * p0[3];
            o[4] += v * p1[0]; o[5] += v * p1[1]; o[6] += v * p1[2]; o[7] += v * p1[3];
        }
#pragma unroll
        for (int q = 0; q < 8; ++q) *(f32x4*)(red + ((wave * 8 + q) * 256) + lane * 4) = o[q];
    }
    __syncthreads();
    {
        const int q = tid >> 6; f32x4 a = (f32x4){0.f, 0.f, 0.f, 0.f};
#pragma unroll
        for (int w = 0; w < 8; ++w) a += *(const f32x4*)(red + ((w * 8 + q) * 256) + lane * 4);
        bf16_t* Og = (bf16_t*)(ws_of(p) + WS_O) + (size_t)(MP + b * NSQ + q) * DM + h * 256 + lane * 4;
        u32x2 w; w.x = pk_bf16(a[0], a[1]); w.y = pk_bf16(a[2], a[3]); *(u32x2*)Og = w;
    }
    __syncthreads();
}

DI void attn_phase(const Params& p, int l, unsigned char* lds, int G, int mask) {
    for (int it = opaque_bid(); it < 1024; it += G) {
        if (it < 512) {
            int u = it;
            if (G == 256) { const int c = it & 255; u = (it & 256) + (c & 7) * 32 + (c >> 3); }
            if (mask & 1) attn_prompt_unit(p, l, u, lds);
        } else { if (mask & 2) attn_sample_item(p, l, it - 512, lds); }
    }
}

DI void final_phase(const Params& p, int G) {
    const int tid = opaque_tid(), lane = tid & 63, wave = tid >> 6;
    const bf16_t* XBf = (const bf16_t*)(ws_of(p) + WS_XB); const float* SS = (const float*)(ws_of(p) + WS_SS); const float* g = p.in[33];
    f32x4 gv[4];
#pragma unroll
    for (int j = 0; j < 4; ++j) gv[j] = ((const f32x4*)g)[lane + 64 * j];
    const int NW = G * 8;
    for (int m0 = opaque_bid() * 8 + wave; m0 < MT; m0 += 4 * NW) {
        u32x2 xv[4][4]; float sv[4];
#pragma unroll
        for (int r = 0; r < 4; ++r) {
            const int m = m0 + r * NW; const bool ok = m < MT; const int mm = ok ? m : m0;
            sv[r] = (lane < 16) ? SS[(size_t)mm * 16 + lane] : 0.f;
            const u32x2* xr = (const u32x2*)(XBf + (size_t)mm * DM) + lane;
#pragma unroll
            for (int j = 0; j < 4; ++j) xv[r][j] = xr[64 * j];
        }
#pragma unroll
        for (int r = 0; r < 4; ++r) {
            const int m = m0 + r * NW; if (m >= MT) break;
            const float rs = __builtin_amdgcn_rsqf(wave_sum(sv[r]) * (1.f / 1024.f) + EPS);
            f32x4* o = (f32x4*)(out_of(p) + (size_t)m * DM) + lane;
#pragma unroll
            for (int j = 0; j < 4; ++j) { const u32x2 v = xv[r][j]; o[64 * j] = (f32x4){bf_lo(v.x), bf_hi(v.x), bf_lo(v.y), bf_hi(v.y)} * rs * gv[j]; }
        }
    }
}

constexpr int MPITCH = 264, MOPB = 64 * MPITCH * 2;
DI void mini_unit(const Params& p, unsigned char* lds, int kind, const bf16_t* A, const bf16_t* Bt, int Kfull, int mu, int nct, float scale, const float* xin_s) {
    const int tid = opaque_tid(), lane = tid & 63, wave = __builtin_amdgcn_readfirstlane(tid >> 6), fr = lane & 15, kq = lane >> 4, rb = wave & 3, kh = wave >> 2;
    const int rt = mu / nct, ct = mu % nct, r0 = rt * 64 + rb * 16;
    unsigned char* ws = ws_of(p);
    f32x4 tot[4], acc[4];
#pragma unroll
    for (int cb = 0; cb < 4; ++cb) { tot[cb] = (f32x4){0.f, 0.f, 0.f, 0.f}; acc[cb] = (f32x4){0.f, 0.f, 0.f, 0.f}; }
    const int pitch = Kfull, nch = Kfull >> 8;
    const bf16_t* Ag = A + (size_t)(rt * 64 + (tid >> 5)) * pitch + (tid & 31) * 8;
    const bf16_t* Bg = Bt + (size_t)(ct * 64 + (tid >> 5)) * pitch + (tid & 31) * 8;
    const int sto = (tid >> 5) * MPITCH + (tid & 31) * 8;
    u32x4 ra[4], rbv[4];
#pragma unroll
    for (int i = 0; i < 4; ++i) { ra[i] = *(const u32x4*)(Ag + (size_t)(16 * i) * pitch); rbv[i] = *(const u32x4*)(Bg + (size_t)(16 * i) * pitch); }
    __syncthreads();
    {
        bf16_t* sa = (bf16_t*)lds; bf16_t* sb = (bf16_t*)(lds + MOPB);
#pragma unroll
        for (int i = 0; i < 4; ++i) { *(u32x4*)(sa + sto + 16 * i * MPITCH) = ra[i]; *(u32x4*)(sb + sto + 16 * i * MPITCH) = rbv[i]; }
    }
    __syncthreads();
    for (int c = 0; c < nch; ++c) {
        const bool more = (c + 1 < nch);
        if (more) {
#pragma unroll
            for (int i = 0; i < 4; ++i) { ra[i] = *(const u32x4*)(Ag + (size_t)(16 * i) * pitch + (c + 1) * 256); rbv[i] = *(const u32x4*)(Bg + (size_t)(16 * i) * pitch + (c + 1) * 256); }
        }
        const bf16_t* sa = (const bf16_t*)(lds + (c & 1) * 2 * MOPB) + (rb * 16 + fr) * MPITCH + kh * 128 + kq * 8;
        const bf16_t* sb = (const bf16_t*)(lds + (c & 1) * 2 * MOPB + MOPB) + fr * MPITCH + kh * 128 + kq * 8;
#pragma unroll
        for (int ks = 0; ks < 4; ++ks) {
            const bf16x8 a = *(const bf16x8*)(sa + ks * 32);
#pragma unroll
            for (int cb = 0; cb < 4; ++cb) { const bf16x8 bfr = *(const bf16x8*)(sb + cb * 16 * MPITCH + ks * 32); acc[cb] = __builtin_amdgcn_mfma_f32_16x16x32_bf16(bfr, a, acc[cb], 0, 0, 0); }
        }
        if (kind == 9) {
            if (c & 1) {
                const int sg = c >> 1;
                const bf16_t* gp = (const bf16_t*)(ws + WS_Z) + (size_t)(MP + r0 + fr) * ZP + 3072 + 1024 * sg + ct * 64 + 4 * kq;
#pragma unroll
                for (int cb = 0; cb < 4; ++cb) { const u32x2 g = *(const u32x2*)(gp + cb * 16);
                    tot[cb][0] += bf_lo(g.x) * acc[cb][0]; tot[cb][1] += bf_hi(g.x) * acc[cb][1]; tot[cb][2] += bf_lo(g.y) * acc[cb][2]; tot[cb][3] += bf_hi(g.y) * acc[cb][3];
                    acc[cb] = (f32x4){0.f, 0.f, 0.f, 0.f}; }
            }
        }
        if (more) {
            bf16_t* sa2 = (bf16_t*)(lds + ((c + 1) & 1) * 2 * MOPB); bf16_t* sb2 = (bf16_t*)(lds + ((c + 1) & 1) * 2 * MOPB + MOPB);
#pragma unroll
            for (int i = 0; i < 4; ++i) { *(u32x4*)(sa2 + sto + 16 * i * MPITCH) = ra[i]; *(u32x4*)(sb2 + sto + 16 * i * MPITCH) = rbv[i]; }
        }
        __syncthreads();
    }
    if (kind != 9) {
#pragma unroll
        for (int cb = 0; cb < 4; ++cb) tot[cb] = acc[cb];
    }
    float* red = (float*)lds;
    if (kh == 1) {
#pragma unroll
        for (int cb = 0; cb < 4; ++cb) *(f32x4*)(red + ((rb * 64 + lane) * 4 + cb) * 4) = tot[cb];
    }
    __syncthreads();
    if (kh == 0) {
#pragma unroll
        for (int cb = 0; cb < 4; ++cb) tot[cb] += *(const f32x4*)(red + ((rb * 64 + lane) * 4 + cb) * 4);
        const int row = MP + r0 + fr, col0 = ct * 64 + 4 * kq;
        if (kind == 8) {
            bf16_t* XB = (bf16_t*)(ws + WS_XB) + (size_t)row * DM + col0; const float* xi = xin_s ? xin_s + (size_t)(r0 + fr) * DM + col0 : nullptr;
            float ss = 0.f;
#pragma unroll
            for (int cb = 0; cb < 4; ++cb) {
                f32x4 x;
                if (xin_s) x = *(const f32x4*)(xi + cb * 16); else { const u32x2 v = *(const u32x2*)(XB + cb * 16); x = (f32x4){bf_lo(v.x), bf_hi(v.x), bf_lo(v.y), bf_hi(v.y)}; }
                x += tot[cb];
                u32x2 w; w.x = pk_bf16(x[0], x[1]); w.y = pk_bf16(x[2], x[3]); *(u32x2*)(XB + cb * 16) = w;
                const f32x4 y = (f32x4){bf_lo(w.x), bf_hi(w.x), bf_lo(w.y), bf_hi(w.y)};
                ss += (y[0] * y[0] + y[1] * y[1]) + (y[2] * y[2] + y[3] * y[3]);
            }
            ss += __shfl_xor(ss, 16); ss += __shfl_xor(ss, 32);
            if (kq == 0) ((float*)(ws + WS_SS))[(size_t)row * 16 + ct] = ss;
        } else if (kind == 0 || kind == 7) {
            const f32x4 s4 = *(const f32x4*)((const float*)(ws + WS_SS) + (size_t)row * 16 + kq * 4);
            float t = (s4[0] + s4[1]) + (s4[2] + s4[3]); t += __shfl_xor(t, 16); t += __shfl_xor(t, 32);
            const float r = __builtin_amdgcn_rsqf(t * (1.f / 1024.f) + EPS) * scale;
            bf16_t* Q = (kind == 0) ? (bf16_t*)(ws + WS_Q) + (size_t)row * DM + col0 : (bf16_t*)(ws + WS_Z) + (size_t)row * DFF + col0;
#pragma unroll
            for (int cb = 0; cb < 4; ++cb) {
                f32x4 v = tot[cb] * r;
                if (kind == 7) { v[0] = fmaxf(v[0], 0.f); v[1] = fmaxf(v[1], 0.f); v[2] = fmaxf(v[2], 0.f); v[3] = fmaxf(v[3], 0.f); v = v * v; }
                u32x2 w; w.x = pk_bf16(v[0], v[1]); w.y = pk_bf16(v[2], v[3]); *(u32x2*)(Q + cb * 16) = w; }
        } else {
            bf16_t* MG = (bf16_t*)(ws + WS_MG) + (size_t)row * DM + col0;
#pragma unroll
            for (int cb = 0; cb < 4; ++cb) { u32x2 w; w.x = pk_bf16(tot[cb][0], tot[cb][1]); w.y = pk_bf16(tot[cb][2], tot[cb][3]); *(u32x2*)(MG + cb * 16) = w; }
        }
    }
    __syncthreads();
}

#define XB_TMO      128
#define XB_XCNT(j)  (256  + 64 * (j))
#define XB_XSUB(j)  (1280 + 64 * (j))
#define XB_XGEN(j)  (2304 + 64 * (j))
#define XB_TOP      3328
#define XB_TOPGEN   3392
#define XCD_BAR_WORDS 3456
#define XB_SPIN_CAP (1u << 22)
DI unsigned xb_ld(unsigned* p)              { return __hip_atomic_load(p, __ATOMIC_RELAXED, __HIP_MEMORY_SCOPE_AGENT); }
DI unsigned xb_add(unsigned* p, unsigned v) { return __hip_atomic_fetch_add(p, v, __ATOMIC_RELAXED, __HIP_MEMORY_SCOPE_AGENT); }
DI unsigned xb_xcc_id() { return (unsigned)__builtin_amdgcn_s_getreg((3 << 11) | 20) & 0xFu; }
#define XB_SPIN(cond, bar) do { unsigned _sp = 0; while (cond) { __builtin_amdgcn_s_sleep(1); \
    if ((++_sp & 255u) == 0u) { if (xb_ld(&(bar)[XB_TMO])) break; if (_sp > XB_SPIN_CAP) { atomicAdd(&(bar)[XB_TMO], 1u); break; } } } } while (0)
struct XcdBarrier { unsigned* bar; unsigned x; volatile LAS unsigned* st; };
DI XcdBarrier xcd_barrier_post(unsigned* bar, volatile LAS unsigned* st) {
    XcdBarrier b; b.bar = bar; b.x = xb_xcc_id(); b.st = st;
    if (threadIdx.x == 0) (void)xb_add(&bar[XB_XCNT(b.x)], 1u);
    return b;
}
DI void xcd_barrier_complete(unsigned* bar, unsigned x, unsigned& nloc, unsigned& nx) {
    const unsigned G = gridDim.x * gridDim.y * gridDim.z;
    unsigned sum, cnt, mine, sp = 0u;
    for (;;) {
        sum = 0u; cnt = 0u; mine = 0u;
#pragma unroll
        for (unsigned j = 0; j < 16; ++j) { const unsigned c = xb_ld(&bar[XB_XCNT(j)]); sum += c; cnt += (c > 0u) ? 1u : 0u; mine = (j == x) ? c : mine; }
        if (sum == G) break;
        __builtin_amdgcn_s_sleep(1);
        if ((++sp & 255u) == 0u) { if (xb_ld(&bar[XB_TMO])) break; if (sp > XB_SPIN_CAP) { atomicAdd(&bar[XB_TMO], 1u); break; } }
    }
    nloc = mine > 0u ? mine : 1u; nx = cnt > 0u ? cnt : 1u;
}
DI void xcd_barrier(const XcdBarrier& b) {
    asm volatile("s_waitcnt vmcnt(0)" ::: "memory");
    __syncthreads();
    if (threadIdx.x == 0) {
        unsigned* bar = b.bar;
        __builtin_amdgcn_s_waitcnt(0);
        unsigned nloc = b.st[0], nx = b.st[1];
        if (nloc == 0u) { xcd_barrier_complete(bar, b.x, nloc, nx); b.st[0] = nloc; b.st[1] = nx; }
        const unsigned old = xb_add(&bar[XB_XSUB(b.x)], 1u);
        const unsigned gen = old / nloc;
        if (old + 1u == (gen + 1u) * nloc) {
            __builtin_amdgcn_fence(__ATOMIC_RELEASE, "agent");
            asm volatile("s_waitcnt vmcnt(0)" ::: "memory");
            const unsigned og = xb_add(&bar[XB_TOP], 1u);
            const unsigned tg = og / nx;
            if (og + 1u == (tg + 1u) * nx) xb_add(&bar[XB_TOPGEN], 1u);
            else XB_SPIN(xb_ld(&bar[XB_TOPGEN]) == tg, bar);
            __builtin_amdgcn_fence(__ATOMIC_ACQUIRE, "agent");
            xb_add(&bar[XB_XGEN(b.x)], 1u);
            asm volatile("s_waitcnt vmcnt(0)" ::: "memory");
        } else {
            XB_SPIN(xb_ld(&bar[XB_XGEN(b.x)]) == gen, bar);
            __builtin_amdgcn_fence(__ATOMIC_ACQUIRE, "agent");
            asm volatile("s_waitcnt vmcnt(0)" ::: "memory");
        }
    }
    __syncthreads();
}

__global__ void __launch_bounds__(512, 2) fwd_megakernel(Params p) {
    extern __shared__ __attribute__((aligned(16))) unsigned char lds[];
    cg::grid_group grid = cg::this_grid();
    const int G = gridDim.x;
    volatile LAS int* dsc = (volatile LAS int*)((LAS unsigned char*)lds + LDS_MISC + 2048);
    volatile LAS unsigned* bst = (volatile LAS unsigned*)((LAS unsigned char*)lds + LDS_MISC + 4096);
    if (threadIdx.x < 2) bst[threadIdx.x] = 0u;
    __syncthreads();
    const bool multi = (p.ph_hi - p.ph_lo) > 1;
    XcdBarrier xbar; xbar.bar = (unsigned*)(p.ws + WS_CTL); xbar.x = 0; xbar.st = bst;
    if (multi) xbar = xcd_barrier_post((unsigned*)(p.ws + WS_CTL), bst);
    for (int ph = p.ph_lo; ph < p.ph_hi; ++ph) {
        int is_gemm = 0, K = 1024;
        if (ph == 0) { int reps = PROBE_A ? 2 : 1; asm volatile("" : "+s"(reps)); for (int r = 0; r < reps; ++r) { if (EN_PRO) prologue(p, lds, G, r == 0 ? 7 : PROBE_A); __syncthreads(); } }
        else if (ph == NPH - 1) final_phase(p, G);
        else {
            const int l = (ph - 1) / 9, s = (ph - 1) % 9;
            if (s == 1) { int reps = PROBE_B ? 2 : 1; asm volatile("" : "+s"(reps)); for (int r = 0; r < reps; ++r) { if (EN_BR) branch_phase(p, l, lds, G, r == 0 ? 3 : PROBE_B); __syncthreads(); } }
            else if (s == 5) { int reps = PROBE_C ? 2 : 1; asm volatile("" : "+s"(reps)); for (int r = 0; r < reps; ++r) { if (EN_AT) attn_phase(p, l, lds, G, r == 0 ? 3 : PROBE_C); __syncthreads(); } }
            else {
                is_gemm = 1; K = (s == 2) ? 2048 : (s == 8) ? 4096 : 1024;
                if (threadIdx.x == 0) {
                    const float* X = (const float*)(ws_of(p) + WS_X);
                    int mode = 1, nN = 4, kind = 0, nkv = 0, ldz = 0; float scale = 1.f;
                    const void *A = nullptr, *B = nullptr, *xin_p = X, *xin_s = X + (size_t)MP * DM, *bias = nullptr, *Zout = nullptr;
                    switch (s) {
                        case 0: mode = 0; A = ws_of(p) + WS_XB; B = ws_of(p) + WS_WIN + (size_t)l * 16 * MiB; nkv = (l == 0) ? 128 : 0; Zout = ws_of(p) + WS_Z; ldz = ZP; bias = p.in[22] + (size_t)l * 4096; break;
                        case 2: mode = 2; A = ws_of(p) + WS_BR; B = ws_of(p) + WS_WB + (size_t)l * 4 * MiB; break;
                        case 3: kind = 8; A = ws_of(p) + WS_MG; B = ws_of(p) + WS_WMIX + (size_t)l * 2 * MiB; if (l == 0) { xin_p = p.in[0]; xin_s = p.in[1]; } break;
                        case 4: kind = 0; A = ws_of(p) + WS_XB; B = ws_of(p) + WS_WQ + (size_t)l * 2 * MiB; Zout = ws_of(p) + WS_Q; ldz = DM; scale = 0.0625f * LOG2E; break;
                        case 6: kind = 8; A = ws_of(p) + WS_O; B = ws_of(p) + WS_WO + (size_t)l * 2 * MiB; break;
                        case 7: kind = 7; nN = 16; A = ws_of(p) + WS_XB; B = ws_of(p) + WS_W1 + (size_t)l * 8 * MiB; Zout = ws_of(p) + WS_Z; ldz = DFF; break;
                        default: kind = 8; A = ws_of(p) + WS_Z; B = ws_of(p) + WS_W2 + (size_t)l * 8 * MiB; break;
                    }
                    dsc[0] = mode; dsc[1] = nN; dsc[2] = K; dsc[3] = kind; dsc[4] = nkv; dsc[5] = ldz; dsc[6] = __float_as_int(scale); dsc[7] = (s == 3 && l == 0) ? 1 : 0;
                    const unsigned long long pa[8] = {(unsigned long long)A, (unsigned long long)B, (unsigned long long)(ws_of(p) + WS_MB), (unsigned long long)(ws_of(p) + WS_WKV), (unsigned long long)xin_p, (unsigned long long)xin_s, (unsigned long long)bias, (unsigned long long)Zout};
#pragma unroll
                    for (int i = 0; i < 8; ++i) { dsc[8 + 2 * i] = (int)(unsigned)pa[i]; dsc[9 + 2 * i] = (int)(unsigned)(pa[i] >> 32); }
                }
                __syncthreads();
            }
        }
        int greps = 1; if (PROBE_G >= 0 && is_gemm && ((ph - 1) % 9) == PROBE_G) greps = 2; asm volatile("" : "+s"(greps));
        for (int gr = 0; gr < greps; ++gr)
        if (EN_GEMM && is_gemm) {
            pg8::SchedU S; S.d = (pg8::DescP)dsc; S.G = G; S.c = opaque_bid();
            pg8::EpiU E; E.d = (pg8::DescP)dsc; E.ws = ws_of(p); E.out = out_of(p);
            pg8::gemm_phase((LAS unsigned char*)lds, K, (ph - 1) % 9 == 2, S, E);
            const int l = (ph - 1) / 9, s = (ph - 1) % 9;
            if (s == 2 || s == 3 || s == 4 || s == 6 || s == 7 || s == 8) {
                unsigned char* ws = ws_of(p);
                int kind = 8; const bf16_t* A; const bf16_t* B; float scale = 1.f;
                const float* xin_s = (l == 0 && s == 3) ? p.in[1] : nullptr;
                if (s == 2) { kind = 9; A = (const bf16_t*)(ws + WS_BR) + (size_t)MP * 2048; B = (const bf16_t*)(ws + WS_WB + (size_t)l * 4 * MiB); }
                else if (s == 3) { A = (const bf16_t*)(ws + WS_MG) + (size_t)MP * DM; B = (const bf16_t*)(ws + WS_WMIX + (size_t)l * 2 * MiB); }
                else if (s == 4) { kind = 0; A = (const bf16_t*)(ws + WS_XB) + (size_t)MP * DM; B = (const bf16_t*)(ws + WS_WQ + (size_t)l * 2 * MiB); scale = 0.0625f * LOG2E; }
                else if (s == 6) { A = (const bf16_t*)(ws + WS_O) + (size_t)MP * DM; B = (const bf16_t*)(ws + WS_WO + (size_t)l * 2 * MiB); }
                else if (s == 7) { kind = 7; A = (const bf16_t*)(ws + WS_XB) + (size_t)MP * DM; B = (const bf16_t*)(ws + WS_W1 + (size_t)l * 8 * MiB); }
                else { A = (const bf16_t*)(ws + WS_Z) + (size_t)MP * DFF; B = (const bf16_t*)(ws + WS_W2 + (size_t)l * 8 * MiB); }
                const int nct = (s == 7) ? 64 : 16;
                for (int mu = opaque_bid(); mu < 16 * nct; mu += G) mini_unit(p, lds, kind, A, B, K, mu, nct, scale, xin_s);
            }
        }
        if (ph + 1 < p.ph_hi) {
            if (p.ph_lo < 0) grid.sync();
            else { int reps = 1 + PROBE_S; asm volatile("" : "+s"(reps)); for (int r = 0; r < reps; ++r) xcd_barrier(xbar); }
        }
    }
}

#ifndef MK_PER_PHASE
#define MK_PER_PHASE 0
#endif
extern "C" void kernel_launch(void* const* d_in, const int* in_sizes, int n_in, void* d_out, int out_size, void* d_ws, size_t ws_size, hipStream_t stream) {
    static int grid = 0;
    if (grid == 0) {
        if (n_in != 34 || out_size != (int)O_END || ws_size < WS_END) { fprintf(stderr, "kernel_launch: unexpected shapes: n_in %d out %d ws %zu\n", n_in, out_size, ws_size); grid = -1; return; }
        int dev = 0, cus = 0, per_cu = 0;
        (void)hipGetDevice(&dev); (void)hipDeviceGetAttribute(&cus, hipDeviceAttributeMultiprocessorCount, dev);
        if (hipFuncSetAttribute((const void*)fwd_megakernel, hipFuncAttributeMaxDynamicSharedMemorySize, LDS_BYTES) != hipSuccess) { fprintf(stderr, "kernel_launch: hipFuncSetAttribute failed\n"); grid = -1; return; }
        if (hipOccupancyMaxActiveBlocksPerMultiprocessor(&per_cu, (const void*)fwd_megakernel, 512, LDS_BYTES) != hipSuccess || per_cu < 1) { fprintf(stderr, "kernel_launch: occupancy query gave %d\n", per_cu); per_cu = 1; }
        (void)hipGetLastError();
        grid = cus * per_cu; if (grid > 256) grid = 256;
        if (grid <= 0) grid = 256;
    }
    if (grid < 0) return;
    Params p{};
    for (int i = 0; i < 34; ++i) p.in[i] = (const float*)d_in[i];
    p.out = (float*)d_out; p.ws = (unsigned char*)d_ws;
#if MK_PER_PHASE
    for (int ph = 0; ph < NPH; ++ph) { p.ph_lo = ph; p.ph_hi = ph + 1; hipLaunchKernelGGL(fwd_megakernel, dim3(grid), dim3(512), LDS_BYTES, stream, p); }
#else
    p.ph_lo = 0; p.ph_hi = NPH;
    (void)hipMemsetAsync((char*)d_ws + WS_CTL, 0, 65536, stream);
    void* args[] = {&p};
    hipError_t e = hipLaunchCooperativeKernel((const void*)fwd_megakernel, dim3(grid), dim3(512), args, LDS_BYTES, stream);
    if (e != hipSuccess) fprintf(stderr, "kernel_launch: cooperative launch failed: %s (grid %d)\n", hipGetErrorString(e), grid);
#endif
}
```

```cpp
#include <hip/hip_runtime.h>
#include <hip/hip_cooperative_groups.h>
#include <cstdio>
#include <cstdint>
namespace cg = cooperative_groups;
#ifndef PROBE_G
#define PROBE_G -1
#endif
#ifndef PROBE_C
#define PROBE_C 0
#endif
#ifndef PROBE_S
#define PROBE_S 0
#endif
#ifndef PROBE_A
#define PROBE_A 0
#endif
#ifndef PROBE_B
#define PROBE_B 0
#endif
#ifndef EN_SGU
#define EN_SGU 1
#endif
#ifndef EN_CP
#define EN_CP 1
#endif
#ifndef EN_CS
#define EN_CS 1
#endif
#ifndef EN_PRO
#define EN_PRO 1
#endif
#ifndef EN_BR
#define EN_BR 1
#endif
#ifndef EN_AT
#define EN_AT 1
#endif
#ifndef EN_GEMM
#define EN_GEMM 1
#endif

#define DI __device__ __forceinline__
#define LAS __attribute__((address_space(3)))
typedef unsigned short bf16_t;
typedef short bf16x8 __attribute__((ext_vector_type(8)));
typedef short s16x4 __attribute__((ext_vector_type(4)));
typedef float f32x4 __attribute__((ext_vector_type(4)));
typedef float f32x2 __attribute__((ext_vector_type(2)));
typedef unsigned u32x4 __attribute__((ext_vector_type(4)));
typedef unsigned u32x2 __attribute__((ext_vector_type(2)));
typedef __bf16 bf16x2_t __attribute__((ext_vector_type(2)));

constexpr int DM = 1024, MP = 16384, MS = 1024, MT = MP + MS, SEQ = 2048, NB = 8, NSB = 128, NSQ = 8, WBR = 512, ZP = 7168, DFF = 4096;
constexpr float EPS = 1e-6f;
constexpr float LOG2E = 1.4426950408889634f;
constexpr int NPH = 20;
constexpr size_t O_YP = 0, O_YS = 16777216, O_POOLP = 17825792, O_SCP = 17948672, O_CCP = 17965056, O_MK = 18210816, O_MV = 22405120,
                 O_POOLS = 26599424, O_SCS = 28565504, O_CCS = 28827648, O_SGUV = 32759808, O_END = 33808384;
constexpr size_t MiB = 1u << 20;
constexpr size_t WS_WIN = 0, WS_WB = 32 * MiB, WS_WMIX = 40 * MiB, WS_WQ = 44 * MiB, WS_WKV = 48 * MiB, WS_WO = 56 * MiB, WS_W1 = 60 * MiB, WS_W2 = 76 * MiB,
                 WS_SGUW = 92 * MiB, WS_SS = 93 * MiB, WS_SSM = 95 * MiB, WS_MB = 96 * MiB, WS_KP = 100 * MiB, WS_VTP = 108 * MiB, WS_X = 116 * MiB,
                 WS_XB = 184 * MiB, WS_MG = 218 * MiB, WS_Q = 252 * MiB, WS_O = 286 * MiB, WS_BR = 320 * MiB, WS_Z = 388 * MiB, WS_CTL = 627 * MiB, WS_END = 628 * MiB;
constexpr size_t BR_STRIDE = (size_t)MT * WBR * 2;
constexpr int LDS_BYTES = 147456, LDS_MISC = 139264;

DI unsigned pk_bf16(float lo, float hi) { f32x2 v = {lo, hi}; bf16x2_t b = __builtin_convertvector(v, bf16x2_t); return __builtin_bit_cast(unsigned, b); }
DI float bf_lo(unsigned v) { return __uint_as_float(v << 16); }
DI float bf_hi(unsigned v) { return __uint_as_float(v & 0xffff0000u); }
DI float sigmoidf_(float x) { return __builtin_amdgcn_rcpf(1.f + __builtin_amdgcn_exp2f(-x * LOG2E)); }
DI float gelu_tanh(float x) { const float u = 1.5957691216057308f * (x + 0.044715f * x * x * x); return x * sigmoidf_(u); }
DI float wave_sum(float v) {
#pragma unroll
    for (int o = 1; o < 64; o <<= 1) v += __shfl_xor(v, o);
    return v;
}
DI float wave_max(float v) {
#pragma unroll
    for (int o = 1; o < 64; o <<= 1) v = fmaxf(v, __shfl_xor(v, o));
    return v;
}

DI int opaque_tid() { int t = threadIdx.x; asm volatile("" : "+v"(t)); return t; }
DI int opaque_bid() { int b = blockIdx.x; asm volatile("" : "+s"(b)); return b; }
template <int N, int D> struct XReduce {
    static DI void run(float* v, int lane) {
        const bool up = (lane & D) != 0;
#pragma unroll
        for (int i = 0; i < N / 2; ++i) { const float send = up ? v[i] : v[i + N / 2], keep = up ? v[i + N / 2] : v[i]; v[i] = keep + __shfl_xor(send, D); }
        XReduce<N / 2, D / 2>::run(v, lane);
    }
};
template <int D> struct XReduce<1, D> {
    static DI void run(float* v, int lane) {
#pragma unroll
        for (int d = D; d >= 1; d >>= 1) v[0] += __shfl_xor(v[0], d);
    }
};
struct Params { const float* in[34]; float* out; unsigned char* ws; int ph_lo, ph_hi; };
DI unsigned char* ws_of(const Params& p) { unsigned char* w = p.ws; asm volatile("" : "+s"(w)); return w; }
DI float* out_of(const Params& p) { float* o = p.out; asm volatile("" : "+s"(o)); return o; }

namespace pg8 {
constexpr int BM = 256, BK = 64, HALF = 128, HTB = HALF * BK * 2, STAGE_BYTES = 8 * HTB;
DI int lds_byte(int r, int c) { const int st = (r >> 4) * 2 + (c >> 5), rr = r & 15, cc = c & 31, ob = rr * 64 + cc * 2; return st * 1024 + (ob ^ (((ob >> 9) & 1) << 5)); }
DI void stage_rc(int b, int& R, int& C) { const int st = b / 1024, sb = b % 1024, swz = sb ^ (((sb >> 9) & 1) << 5); R = (st >> 1) * 16 + swz / 64; C = (st & 1) * 32 + (swz % 64) / 2; }
DI int perm32(int rho) { const int n = rho >> 4, i = rho & 15; return 8 * (i >> 2) + 4 * n + (i & 3); }

struct Unit { int pm, pn, kind, zc; const char* a; const char* b; };

DI void tile_of(int L, int nM, int nN, int& pm, int& pn) {
    const int nwg = nM * nN; int wgid = L;
    { const int q = nwg / 8, r = nwg % 8, xcd = wgid % 8, off = wgid / 8; wgid = (xcd < r ? xcd * (q + 1) : r * (q + 1) + (xcd - r) * q) + off; }
    const int nig = 8 * nN, gid = wgid / nig, fm = gid * 8, gsz = (nM - fm) < 8 ? (nM - fm) : 8;
    pm = fm + ((wgid % nig) % gsz); pn = (wgid % nig) / gsz;
}

typedef const volatile LAS int* DescP;
DI int dsc_i(DescP d, int i) { return __builtin_amdgcn_readfirstlane(d[i]); }
DI const char* dsc_p(DescP d, int i) { const unsigned lo = (unsigned)__builtin_amdgcn_readfirstlane(d[i]), hi = (unsigned)__builtin_amdgcn_readfirstlane(d[i + 1]); return (const char*)(((unsigned long long)hi << 32) | lo); }
struct SchedU {
    DescP d; int G, c;
    DI bool next(int i, Unit& u) const {
        const int mode = dsc_i(d, 0); const char* A = dsc_p(d, 8); const char* B = dsc_p(d, 10);
        if (mode == 2) {
            const int ti = i * G + c; if (ti >= 64 * 4) return false;
            tile_of(ti, 64, 4, u.pm, u.pn); u.kind = 9; u.zc = 0;
            u.a = A + (size_t)u.pm * (256 * 2048 * 2); u.b = B + (size_t)u.pn * (256 * 2048 * 2); return true;
        }
        const int L = i * G + c;
        if (mode == 1) {
            const int nN = dsc_i(d, 1), K = dsc_i(d, 2);
            const int nM = 64;
            if (L >= nM * nN) return false;
            tile_of(L, nM, nN, u.pm, u.pn); u.kind = dsc_i(d, 3); u.zc = u.pn * 256;
            u.a = A + (size_t)u.pm * ((size_t)512 * K); u.b = B + (size_t)u.pn * ((size_t)512 * K); return true;
        }
        if (L < 68 * 32) {
            tile_of(L, 68, 32, u.pm, u.pn); u.a = A + (size_t)u.pm * (512 * 1024); u.b = B + (size_t)u.pn * (512 * 1024);
            const int pn = u.pn;
            if (pn < 2) { u.kind = 0; u.zc = pn * 256; }
            else if (pn < 6) { u.kind = 3; u.zc = 512 + (pn - 2) * 128; }
            else if (pn < 8) { u.kind = 0; u.zc = 1024 + (pn - 6) * 256; }
            else if (pn < 12) { u.kind = 1; u.zc = 1536 + (pn - 8) * 256; }
            else if (pn < 16) { u.kind = 4; u.zc = 2560 + (pn - 12) * 128; }
            else { u.kind = 2; u.zc = 3072 + (pn - 16) * 256; }
            return true;
        }
        const int j = L - 68 * 32; if (j >= dsc_i(d, 4)) return false;
        const int l = j >> 6, rem = j & 63; u.pm = rem >> 3; u.pn = rem & 7; u.kind = 5; u.zc = l;
        u.a = dsc_p(d, 12) + (size_t)u.pm * (512 * 1024); u.b = dsc_p(d, 14) + (size_t)l * (4 * MiB) + (size_t)u.pn * (512 * 1024); return true;
    }
};

struct EpiU {
    DescP d; unsigned char* ws; float* out;
    template <int ACT> DI void plain(const f32x4 (&acc)[2][2][4][2], const Unit& u, const float (&rs)[2][4], int rloc, int cloc) const {
        const float* bias = (const float*)dsc_p(d, 20); bf16_t* Zout = (bf16_t*)dsc_p(d, 22); const int ldz = dsc_i(d, 5);
        f32x4 bv[2][2];
#pragma unroll
        for (int bj = 0; bj < 2; ++bj)
#pragma unroll
            for (int n = 0; n < 2; ++n) bv[bj][n] = (ACT == 2) ? *(const f32x4*)(bias + (u.zc - 3072) + cloc + bj * 128 + 4 * n) : (f32x4){0.f, 0.f, 0.f, 0.f};
#pragma unroll
        for (int ai = 0; ai < 2; ++ai)
#pragma unroll
            for (int m = 0; m < 4; ++m) {
                const int row = u.pm * 256 + rloc + ai * 128 + m * 16; bf16_t* rowp = Zout + (size_t)row * ldz + u.zc + cloc; const float r = rs[ai][m];
#pragma unroll
                for (int bj = 0; bj < 2; ++bj) {
                    float v[8];
#pragma unroll
                    for (int n = 0; n < 2; ++n)
#pragma unroll
                        for (int j = 0; j < 4; ++j) {
                            float x = acc[ai][bj][m][n][j] * r;
                            if (ACT == 1) x = gelu_tanh(x);
                            if (ACT == 2) x = sigmoidf_(x + bv[bj][n][j]);
                            if (ACT == 7) { x = fmaxf(x, 0.f); x = x * x; }
                            v[n * 4 + j] = x;
                        }
                    u32x4 w; w.x = pk_bf16(v[0], v[1]); w.y = pk_bf16(v[2], v[3]); w.z = pk_bf16(v[4], v[5]); w.w = pk_bf16(v[6], v[7]);
                    *(u32x4*)(rowp + bj * 128) = w;
                }
            }
    }
    template <int ACT> DI void merge2(const f32x4 (&acc)[2][2][4][2], const Unit& u, const float (&rs)[2][4], int rloc, int cloc) const {
        bf16_t* Zout = (bf16_t*)dsc_p(d, 22); const int ldz = dsc_i(d, 5);
#pragma unroll
        for (int ai = 0; ai < 2; ++ai)
#pragma unroll
            for (int m = 0; m < 4; ++m) {
                const int row = u.pm * 256 + rloc + ai * 128 + m * 16; bf16_t* rowp = Zout + (size_t)row * ldz + u.zc + cloc; const float r = rs[ai][m];
                float v[8];
#pragma unroll
                for (int n = 0; n < 2; ++n)
#pragma unroll
                    for (int j = 0; j < 4; ++j) {
                        const float a = acc[ai][0][m][n][j] * r, b = acc[ai][1][m][n][j] * r;
                        v[n * 4 + j] = (ACT == 3) ? a * b : a * sigmoidf_(b);
                    }
                u32x4 w; w.x = pk_bf16(v[0], v[1]); w.y = pk_bf16(v[2], v[3]); w.z = pk_bf16(v[4], v[5]); w.w = pk_bf16(v[6], v[7]);
                *(u32x4*)rowp = w;
            }
    }
    static DI float gclamp(float g) { return fmaxf(g, 1e-20f); }
    DI void rescale(f32x4 (&acc)[2][2][4][2], const Unit& u, int k, int wr, int wc, int fr, int fq) const {
        int rloc = wr * 64 + fr, cloc = wc * 32 + 8 * fq;
        asm volatile("" : "+v"(rloc), "+v"(cloc));
        const bf16_t* Zg = (const bf16_t*)(ws + WS_Z) + 3072 + 1024 * (k - 1) + u.pn * 256 + cloc;
#pragma unroll
        for (int ai = 0; ai < 2; ++ai) {
            u32x4 gp_[4][2], gn_[4][2];
#pragma unroll
            for (int m = 0; m < 4; ++m) { const int row = u.pm * 256 + rloc + ai * 128 + m * 16; const bf16_t* gp = Zg + (size_t)row * ZP;
#pragma unroll
                for (int bj = 0; bj < 2; ++bj) { gp_[m][bj] = *(const u32x4*)(gp + bj * 128); gn_[m][bj] = *(const u32x4*)(gp + 1024 + bj * 128); } }
#pragma unroll
            for (int m = 0; m < 4; ++m) {
#pragma unroll
                for (int bj = 0; bj < 2; ++bj) {
                    const u32x4 a = gp_[m][bj], b = gn_[m][bj];
                    acc[ai][bj][m][0][0] *= gclamp(bf_lo(a.x)) * __builtin_amdgcn_rcpf(gclamp(bf_lo(b.x))); acc[ai][bj][m][0][1] *= gclamp(bf_hi(a.x)) * __builtin_amdgcn_rcpf(gclamp(bf_hi(b.x)));
                    acc[ai][bj][m][0][2] *= gclamp(bf_lo(a.y)) * __builtin_amdgcn_rcpf(gclamp(bf_lo(b.y))); acc[ai][bj][m][0][3] *= gclamp(bf_hi(a.y)) * __builtin_amdgcn_rcpf(gclamp(bf_hi(b.y)));
                    acc[ai][bj][m][1][0] *= gclamp(bf_lo(a.z)) * __builtin_amdgcn_rcpf(gclamp(bf_lo(b.z))); acc[ai][bj][m][1][1] *= gclamp(bf_hi(a.z)) * __builtin_amdgcn_rcpf(gclamp(bf_hi(b.z)));
                    acc[ai][bj][m][1][2] *= gclamp(bf_lo(a.w)) * __builtin_amdgcn_rcpf(gclamp(bf_lo(b.w))); acc[ai][bj][m][1][3] *= gclamp(bf_hi(a.w)) * __builtin_amdgcn_rcpf(gclamp(bf_hi(b.w)));
                }
            }
            asm volatile("" ::: "memory");
        }
    }
    DI void operator()(const f32x4 (&acc)[2][2][4][2], const Unit& u, int wr, int wc, int fr, int fq) const {
        const int kind = u.kind; int rloc = wr * 64 + fr, cloc = wc * 32 + 8 * fq;
        asm volatile("" : "+v"(rloc), "+v"(cloc));
        if (kind == 8) {
            const int xf32 = dsc_i(d, 7);
            const float* xin = (u.pm < 64) ? (const float*)dsc_p(d, 16) : (const float*)dsc_p(d, 18) - (size_t)MP * DM;
            bf16_t* XB = (bf16_t*)(ws + WS_XB); float* SS = (float*)(ws + WS_SS);
#pragma unroll
            for (int ai = 0; ai < 2; ++ai) {
                u32x4 xv[4][2];
                if (!xf32) {
#pragma unroll
                    for (int m = 0; m < 4; ++m) { const size_t off = (size_t)(u.pm * 256 + rloc + ai * 128 + m * 16) * DM + u.pn * 256 + cloc;
#pragma unroll
                        for (int bj = 0; bj < 2; ++bj) xv[m][bj] = *(const u32x4*)(XB + off + bj * 128); }
                }
#pragma unroll
                for (int m = 0; m < 4; ++m) {
                    const int row = u.pm * 256 + rloc + ai * 128 + m * 16; const size_t off = (size_t)row * DM + u.pn * 256 + cloc; float ss = 0.f;
#pragma unroll
                    for (int bj = 0; bj < 2; ++bj) {
                        f32x4 x0, x1;
                        if (xf32) { x0 = *(const f32x4*)(xin + off + bj * 128); x1 = *(const f32x4*)(xin + off + bj * 128 + 4); }
                        else { const u32x4 v = xv[m][bj]; x0 = (f32x4){bf_lo(v.x), bf_hi(v.x), bf_lo(v.y), bf_hi(v.y)}; x1 = (f32x4){bf_lo(v.z), bf_hi(v.z), bf_lo(v.w), bf_hi(v.w)}; }
                        x0 += acc[ai][bj][m][0]; x1 += acc[ai][bj][m][1];
                        u32x4 w; w.x = pk_bf16(x0[0], x0[1]); w.y = pk_bf16(x0[2], x0[3]); w.z = pk_bf16(x1[0], x1[1]); w.w = pk_bf16(x1[2], x1[3]);
                        *(u32x4*)(XB + off + bj * 128) = w;
                        const f32x4 y0 = (f32x4){bf_lo(w.x), bf_hi(w.x), bf_lo(w.y), bf_hi(w.y)}, y1 = (f32x4){bf_lo(w.z), bf_hi(w.z), bf_lo(w.w), bf_hi(w.w)};
                        ss += (y0[0] * y0[0] + y0[1] * y0[1]) + (y0[2] * y0[2] + y0[3] * y0[3]) + (y1[0] * y1[0] + y1[1] * y1[1]) + (y1[2] * y1[2] + y1[3] * y1[3]);
                    }
                    ss += __shfl_xor(ss, 16); ss += __shfl_xor(ss, 32);
                    if (fq == 0) SS[(size_t)row * 16 + u.pn * 4 + wc] = ss;
                    if (xf32 && (m & 1)) asm volatile("" ::: "memory");
                }
                asm volatile("" ::: "memory");
            }
            return;
        }
        if (kind == 9) {
            const bf16_t* Zg = (const bf16_t*)(ws + WS_Z) + 3072 + 1024 * 3 + u.pn * 256 + cloc; bf16_t* MG = (bf16_t*)(ws + WS_MG);
#pragma unroll
            for (int ai = 0; ai < 2; ++ai) {
                u32x4 g[4][2];
#pragma unroll
                for (int m = 0; m < 4; ++m) { const int row = u.pm * 256 + rloc + ai * 128 + m * 16; const bf16_t* gp = Zg + (size_t)row * ZP;
#pragma unroll
                    for (int bj = 0; bj < 2; ++bj) g[m][bj] = *(const u32x4*)(gp + bj * 128); }
#pragma unroll
                for (int m = 0; m < 4; ++m) {
                    const int row = u.pm * 256 + rloc + ai * 128 + m * 16; bf16_t* mp = MG + (size_t)row * DM + u.pn * 256 + cloc;
#pragma unroll
                    for (int bj = 0; bj < 2; ++bj) {
                        const u32x4 gg = g[m][bj]; const f32x4 a0 = acc[ai][bj][m][0], a1 = acc[ai][bj][m][1]; u32x4 w;
                        w.x = pk_bf16(gclamp(bf_lo(gg.x)) * a0[0], gclamp(bf_hi(gg.x)) * a0[1]); w.y = pk_bf16(gclamp(bf_lo(gg.y)) * a0[2], gclamp(bf_hi(gg.y)) * a0[3]);
                        w.z = pk_bf16(gclamp(bf_lo(gg.z)) * a1[0], gclamp(bf_hi(gg.z)) * a1[1]); w.w = pk_bf16(gclamp(bf_lo(gg.w)) * a1[2], gclamp(bf_hi(gg.w)) * a1[3]);
                        *(u32x4*)(mp + bj * 128) = w;
                    }
                }
                asm volatile("" ::: "memory");
            }
            return;
        }
        if (kind == 5) {
            const float* SSM = (const float*)(ws + WS_SSM); const int l = u.zc, b = u.pm;
#pragma unroll
            for (int ai = 0; ai < 2; ++ai)
#pragma unroll
                for (int m = 0; m < 4; ++m) {
                    const int key = rloc + ai * 128 + m * 16, row = b * 256 + key; const float r = __builtin_amdgcn_rsqf(SSM[row] * (1.f / 1024.f) + EPS);
#pragma unroll
                    for (int bj = 0; bj < 2; ++bj) {
                        const int col = u.pn * 256 + bj * 128 + cloc;
                        const f32x4 v0 = acc[ai][bj][m][0] * r, v1 = acc[ai][bj][m][1] * r;
                        float* op = out + (col < 1024 ? O_MK : O_MV) + (size_t)l * 2097152 + (size_t)row * 1024 + (col & 1023);
                        *(f32x4*)op = v0; *(f32x4*)(op + 4) = v1;
                        const int h = (col & 1023) >> 8, d = col & 255; const size_t hb = ((size_t)(l * 8 + b) * 4 + h) * 65536;
                        if (col < 1024) {
                            u32x4 w; w.x = pk_bf16(v0[0], v0[1]); w.y = pk_bf16(v0[2], v0[3]); w.z = pk_bf16(v1[0], v1[1]); w.w = pk_bf16(v1[2], v1[3]);
                            *(u32x4*)((bf16_t*)(ws + WS_KP) + hb + (size_t)key * 256 + d) = w;
                        } else {
                            bf16_t* vt = (bf16_t*)(ws + WS_VTP) + hb + (size_t)d * 256 + key;
#pragma unroll
                            for (int j = 0; j < 4; ++j) { vt[j * 256] = (bf16_t)(pk_bf16(v0[j], 0.f) & 0xffffu); vt[(4 + j) * 256] = (bf16_t)(pk_bf16(v1[j], 0.f) & 0xffffu); }
                        }
                    }
                    asm volatile("" ::: "memory");
                }
            return;
        }
        float rs[2][4]; const float* SS = (const float*)(ws + WS_SS); const float scale = __int_as_float(dsc_i(d, 6));
#pragma unroll
        for (int ai = 0; ai < 2; ++ai)
#pragma unroll
            for (int m = 0; m < 4; ++m) {
                const f32x4 s4 = *(const f32x4*)(SS + (size_t)(u.pm * 256 + rloc + ai * 128 + m * 16) * 16 + fq * 4);
                float t = (s4[0] + s4[1]) + (s4[2] + s4[3]); t += __shfl_xor(t, 16); t += __shfl_xor(t, 32);
                rs[ai][m] = __builtin_amdgcn_rsqf(t * (1.f / 1024.f) + EPS) * scale;
            }
        switch (kind) {
            case 0: plain<0>(acc, u, rs, rloc, cloc); break;
            case 1: plain<1>(acc, u, rs, rloc, cloc); break;
            case 2: plain<2>(acc, u, rs, rloc, cloc); break;
            case 7: plain<7>(acc, u, rs, rloc, cloc); break;
            case 3: merge2<3>(acc, u, rs, rloc, cloc); break;
            default: merge2<4>(acc, u, rs, rloc, cloc); break;
        }
    }
};

DI void gemm_phase(LAS unsigned char* lds, const int K, const bool hook, const SchedU& S, const EpiU& E) {
    const int tid = opaque_tid(), wid = __builtin_amdgcn_readfirstlane(tid >> 6), lane = tid & 63, wr = wid >> 2, wc = wid & 3, fr = lane & 15, fq = lane >> 4;
    const int nt = K / BK;
    unsigned voffA[2], voffB[2];
#pragma unroll
    for (int i = 0; i < 2; ++i) { int R, C; stage_rc(tid * 16 + i * 8192, R, C); const int Rb = (R & ~31) + perm32(R & 31);
        voffA[i] = (unsigned)(R * K + C) * 2u; voffB[i] = (unsigned)(Rb * K + C) * 2u; }
    const size_t kstep = (size_t)(BK * 2);
    const size_t hstep = (size_t)HALF * K * 2;
    const unsigned ldsw = (unsigned)wid * 1024u;
    const int aoff = lds_byte(wr * 64 + fr, fq * 8), boff = lds_byte(wc * 32 + fr, fq * 8);
#define PG8_SA(b, h) (((b) * 2 + (h)) * HTB)
#define PG8_SB(b, h) ((4 + (b) * 2 + (h)) * HTB)
#define PG8_STAGE(bufoff, gbase, voff) do { _Pragma("unroll") for (int _i = 0; _i < 2; ++_i) \
        __builtin_amdgcn_global_load_lds((const unsigned*)((const char*)(gbase) + (voff)[_i]), (LAS unsigned*)(lds + (bufoff) + ldsw + _i * 8192), 16, 0, 0); } while (0)
#define PG8_LDA(dst, b, h) do { _Pragma("unroll") for (int m = 0; m < 4; ++m) _Pragma("unroll") for (int k = 0; k < 2; ++k) dst[m][k] = *(const LAS bf16x8*)(lds + PG8_SA(b, h) + aoff + m * 2048 + k * 1024); } while (0)
#define PG8_LDB(dst, b, h) do { _Pragma("unroll") for (int n = 0; n < 2; ++n) _Pragma("unroll") for (int k = 0; k < 2; ++k) dst[n][k] = *(const LAS bf16x8*)(lds + PG8_SB(b, h) + boff + n * 2048 + k * 1024); } while (0)
#define PG8_MMA(ai, bj, At, Bt) do { __builtin_amdgcn_s_setprio(1); _Pragma("unroll") for (int m = 0; m < 4; ++m) _Pragma("unroll") for (int n = 0; n < 2; ++n) _Pragma("unroll") for (int k = 0; k < 2; ++k) \
        acc[ai][bj][m][n] = __builtin_amdgcn_mfma_f32_16x16x32_bf16(Bt[n][k], At[m][k], acc[ai][bj][m][n], 0, 0, 0); __builtin_amdgcn_s_setprio(0); } while (0)
#define PG8_WAIT_V(n) asm volatile("s_waitcnt vmcnt(" #n ")" ::: "memory")
#define PG8_WAIT_L(n) asm volatile("s_waitcnt lgkmcnt(" #n ")" ::: "memory")
#define PG8_BAR __builtin_amdgcn_s_barrier()
#define PG8_SCHED __builtin_amdgcn_sched_barrier(0)
    Unit cur, nxt; int ui = 0;
    if (!S.next(0, cur)) return;
    f32x4 acc[2][2][4][2];
#pragma unroll
    for (int a = 0; a < 2; ++a)
#pragma unroll
        for (int b = 0; b < 2; ++b)
#pragma unroll
            for (int m = 0; m < 4; ++m)
#pragma unroll
                for (int n = 0; n < 2; ++n) acc[a][b][m][n] = (f32x4){0.f, 0.f, 0.f, 0.f};
    bf16x8 At[4][2], B0[2][2], B1[2][2];
    const char* cA = cur.a; const char* cB = cur.b;
    PG8_STAGE(PG8_SB(0, 0), cB, voffB); PG8_STAGE(PG8_SB(0, 1), cB + hstep, voffB); PG8_STAGE(PG8_SA(0, 0), cA, voffA); PG8_STAGE(PG8_SA(0, 1), cA + hstep, voffA);
    if (wr == 1) PG8_BAR;
    PG8_WAIT_V(2); PG8_BAR;
    PG8_STAGE(PG8_SB(1, 0), cB + kstep, voffB); PG8_STAGE(PG8_SA(1, 0), cA + kstep, voffA); PG8_STAGE(PG8_SB(1, 1), cB + hstep + kstep, voffB);
    PG8_WAIT_V(6); PG8_BAR;
    for (;;) {
        const bool has_next = S.next(ui + 1, nxt);
        const char* nA = has_next ? nxt.a : cA; const char* nB = has_next ? nxt.b : cB;
        for (int t = 0; t < nt; t += 2) {
            const bool last = (t == nt - 2);
            if (hook && t != 0 && (t & 7) == 0) E.rescale(acc, cur, t >> 3, wr, wc, fr, fq);
            asm volatile("" : "+v"(voffA[0]), "+v"(voffA[1]), "+v"(voffB[0]), "+v"(voffB[1]));
            const char* a1 = cA + (size_t)(t + 1) * kstep;
            const char* a2 = last ? nA : cA + (size_t)(t + 2) * kstep; const char* b2 = last ? nB : cB + (size_t)(t + 2) * kstep;
            const char* a3 = a2 + kstep; const char* b3 = b2 + kstep;
            PG8_LDB(B0, 0, 0); PG8_LDB(B1, 0, 1); PG8_SCHED; PG8_LDA(At, 0, 0); PG8_STAGE(PG8_SA(1, 1), a1 + hstep, voffA);
            PG8_WAIT_V(8); PG8_WAIT_L(0); PG8_BAR; PG8_MMA(0, 0, At, B0); PG8_MMA(0, 1, At, B1); PG8_BAR; PG8_SCHED;
            PG8_LDA(At, 0, 1); PG8_STAGE(PG8_SB(0, 0), b2, voffB); PG8_STAGE(PG8_SB(0, 1), b2 + hstep, voffB); PG8_STAGE(PG8_SA(0, 0), a2, voffA);
            PG8_WAIT_V(8); PG8_WAIT_L(0); PG8_BAR; PG8_MMA(1, 0, At, B0); PG8_MMA(1, 1, At, B1); PG8_BAR; PG8_SCHED;
            PG8_LDB(B0, 1, 0); PG8_LDB(B1, 1, 1); PG8_SCHED; PG8_LDA(At, 1, 0); PG8_STAGE(PG8_SA(0, 1), a2 + hstep, voffA);
            PG8_WAIT_V(8); PG8_WAIT_L(0); PG8_BAR; PG8_MMA(0, 0, At, B0); PG8_MMA(0, 1, At, B1); PG8_BAR; PG8_SCHED;
            PG8_LDA(At, 1, 1); PG8_STAGE(PG8_SB(1, 0), b3, voffB); PG8_STAGE(PG8_SB(1, 1), b3 + hstep, voffB); PG8_STAGE(PG8_SA(1, 0), a3, voffA);
            PG8_WAIT_V(8); PG8_WAIT_L(0); PG8_BAR; PG8_MMA(1, 0, At, B0); PG8_MMA(1, 1, At, B1); PG8_BAR; PG8_SCHED;
        }
        if (wr == 0) PG8_BAR;
        E(acc, cur, wr, wc, fr, fq);
        if (!has_next) break;
#pragma unroll
        for (int a = 0; a < 2; ++a)
#pragma unroll
            for (int b = 0; b < 2; ++b)
#pragma unroll
                for (int m = 0; m < 4; ++m)
#pragma unroll
                    for (int n = 0; n < 2; ++n) acc[a][b][m][n] = (f32x4){0.f, 0.f, 0.f, 0.f};
        cur = nxt; cA = nA; cB = nB; ++ui;
        if (wr == 1) PG8_BAR;
    }
    PG8_WAIT_V(0);
    PG8_BAR;
#undef PG8_SA
#undef PG8_SB
#undef PG8_STAGE
#undef PG8_LDA
#undef PG8_LDB
#undef PG8_MMA
#undef PG8_WAIT_V
#undef PG8_WAIT_L
#undef PG8_BAR
#undef PG8_SCHED
}
}

DI void transpose_item(const float* W, int K, int N, bf16_t* WT, int pitch, int k0, int n0, int drow0, const float* gk, float* scr, int lane) {
#pragma unroll
    for (int i = 0; i < 32; ++i) { const int kk = 2 * i + (lane >> 5); float v = W[(size_t)(k0 + kk) * N + n0 + (lane & 31)]; if (gk) v *= gk[k0 + kk]; scr[kk * 33 + (lane & 31)] = v; }
    asm volatile("s_waitcnt lgkmcnt(0)" ::: "memory");
    const int c = lane & 7;
#pragma unroll
    for (int j = 0; j < 4; ++j) { const int n = (lane >> 3) + 8 * j; const float* s = scr + (8 * c) * 33 + n;
        u32x4 o; o.x = pk_bf16(s[0 * 33], s[1 * 33]); o.y = pk_bf16(s[2 * 33], s[3 * 33]); o.z = pk_bf16(s[4 * 33], s[5 * 33]); o.w = pk_bf16(s[6 * 33], s[7 * 33]);
        *(u32x4*)(WT + (size_t)(drow0 + n) * pitch + k0 + 8 * c) = o; }
    asm volatile("s_waitcnt lgkmcnt(0)" ::: "memory");
}
DI int win_block_map(int sb) {
    if (sb < 4) return sb;
    if (sb < 8) return 4 + 2 * (sb - 4);
    if (sb < 12) return 12 + (sb - 8);
    if (sb < 16) return 5 + 2 * (sb - 12);
    if (sb < 24) return sb;
    if (sb < 28) return 24 + 2 * (sb - 24);
    if (sb < 32) return 25 + 2 * (sb - 28);
    return sb;
}
DI float row_to_bf16(const float* xrow, bf16_t* orow, int lane) {
    const f32x4* xr = (const f32x4*)xrow + lane; float s = 0.f; f32x4 v[4];
#pragma unroll
    for (int j = 0; j < 4; ++j) { v[j] = xr[64 * j]; s += (v[j].x * v[j].x + v[j].y * v[j].y) + (v[j].z * v[j].z + v[j].w * v[j].w); }
    u32x2* o = (u32x2*)orow + lane;
#pragma unroll
    for (int j = 0; j < 4; ++j) { u32x2 w; w.x = pk_bf16(v[j].x, v[j].y); w.y = pk_bf16(v[j].z, v[j].w); o[64 * j] = w; }
    return wave_sum(s);
}

DI void prologue(const Params& p, unsigned char* lds, int G, int mask) {
    const int tid = opaque_tid(), lane = tid & 63, wave = __builtin_amdgcn_readfirstlane(tid >> 6);
    float* scr = (float*)(lds + wave * 16384);
    const int gw = opaque_bid() * 8 + wave, NGW = G * 8;
    unsigned char* ws = ws_of(p);
    {
        constexpr int T_IN = 16 * 64, T_BR = 8 * 8, T_SQ = 16 * 8, T_F1 = 16 * 32, T_F2 = 64 * 8;
        constexpr int T_L = T_IN + 3 * T_BR + 5 * T_SQ + T_F1 + T_F2;
        unsigned* Tl = (unsigned*)lds;
        const int lr = tid >> 5, lc = (tid & 31) * 4;
        f32x4 cur[4], nxt[4]; const float* gk_c = nullptr; const float* gk_n = nullptr;
        bf16_t* WT_c = nullptr; bf16_t* WT_n = nullptr; int pitch_c = 0, pitch_n = 0, k0_c = 0, k0_n = 0, dr_c = 0, dr_n = 0;
#define TR_SETUP(it_, W_, N_, WT_, pitch_, gk_, k0_, n0_, dr_) do { \
            const int l_ = (it_) / T_L; int r_ = (it_) % T_L; bool is_in_ = false; int K_; (gk_) = nullptr; (pitch_) = 0; \
            if (r_ < T_IN) { W_ = p.in[9] + (size_t)l_ * 1024 * 8192; K_ = 1024; N_ = 8192; WT_ = (bf16_t*)(ws + WS_WIN) + (size_t)l_ * 8192 * 1024; gk_ = p.in[8] + l_ * 1024; is_in_ = true; } \
            else if ((r_ -= T_IN) < 3 * T_BR) { const int k_ = 1 + r_ / T_BR; r_ %= T_BR; W_ = p.in[21] + ((size_t)l_ * 4 + k_) * 512 * 1024; K_ = 512; N_ = 1024; WT_ = (bf16_t*)(ws + WS_WB) + (size_t)l_ * 2097152 + k_ * 512; pitch_ = 2048; } \
            else if ((r_ -= 3 * T_BR) < 5 * T_SQ) { const int w_ = r_ / T_SQ; r_ %= T_SQ; K_ = 1024; N_ = 1024; \
                if (w_ == 0) { W_ = p.in[23] + (size_t)l_ * 1048576; WT_ = (bf16_t*)(ws + WS_WMIX) + (size_t)l_ * 1048576; } \
                else if (w_ == 1) { W_ = p.in[26] + (size_t)l_ * 1048576; WT_ = (bf16_t*)(ws + WS_WQ) + (size_t)l_ * 1048576; gk_ = p.in[24] + l_ * 1024; } \
                else if (w_ == 2) { W_ = p.in[27] + (size_t)l_ * 1048576; WT_ = (bf16_t*)(ws + WS_WKV) + (size_t)l_ * 2097152; gk_ = p.in[25] + l_ * 1024; } \
                else if (w_ == 3) { W_ = p.in[28] + (size_t)l_ * 1048576; WT_ = (bf16_t*)(ws + WS_WKV) + (size_t)l_ * 2097152 + 1048576; gk_ = p.in[25] + l_ * 1024; } \
                else { W_ = p.in[29] + (size_t)l_ * 1048576; WT_ = (bf16_t*)(ws + WS_WO) + (size_t)l_ * 1048576; } } \
            else if ((r_ -= 5 * T_SQ) < T_F1) { W_ = p.in[31] + (size_t)l_ * 4194304; K_ = 1024; N_ = 4096; WT_ = (bf16_t*)(ws + WS_W1) + (size_t)l_ * 4194304; gk_ = p.in[30] + l_ * 1024; } \
            else { r_ -= T_F1; W_ = p.in[32] + (size_t)l_ * 4194304; K_ = 4096; N_ = 1024; WT_ = (bf16_t*)(ws + WS_W2) + (size_t)l_ * 4194304; } \
            if (!(pitch_)) (pitch_) = K_; \
            const int nblk_ = N_ / 128; (k0_) = 64 * (r_ / nblk_); (n0_) = 128 * (r_ % nblk_); (dr_) = is_in_ ? win_block_map((n0_) >> 7) * 128 : (n0_); } while (0)
        int it = opaque_bid();
        if ((mask & 1) && it < 2 * T_L) {
            { const float* W; int N, n0; TR_SETUP(it, W, N, WT_c, pitch_c, gk_c, k0_c, n0, dr_c);
#pragma unroll
              for (int i = 0; i < 4; ++i) cur[i] = *(const f32x4*)(W + (size_t)(k0_c + lr + 16 * i) * N + n0 + lc); }
            for (; it < 2 * T_L; it += G) {
                const int itn = it + G; const bool has_n = itn < 2 * T_L;
                if (has_n) { const float* W; int N, n0; TR_SETUP(itn, W, N, WT_n, pitch_n, gk_n, k0_n, n0, dr_n);
#pragma unroll
                    for (int i = 0; i < 4; ++i) nxt[i] = *(const f32x4*)(W + (size_t)(k0_n + lr + 16 * i) * N + n0 + lc); }
                unsigned short* Th = (unsigned short*)Tl;
#pragma unroll
                for (int i = 0; i < 4; ++i) {
                    const int kk = lr + 16 * i; const float g = gk_c ? gk_c[k0_c + kk] : 1.f; const f32x4 v = cur[i] * g;
#pragma unroll
                    for (int j = 0; j < 4; ++j) Th[(lc + j) * 66 + kk] = (unsigned short)(pk_bf16(v[j], 0.f) & 0xffffu);
                }
                __syncthreads();
#pragma unroll
                for (int q = 0; q < 2; ++q) {
                    const int idx = tid + 512 * q, n = idx >> 3, c = idx & 7; const unsigned* src = Tl + n * 33 + c * 4;
                    u32x4 o; o.x = src[0]; o.y = src[1]; o.z = src[2]; o.w = src[3];
                    *(u32x4*)(WT_c + (size_t)(dr_c + n) * pitch_c + k0_c + 8 * c) = o;
                }
                __syncthreads();
#pragma unroll
                for (int i = 0; i < 4; ++i) cur[i] = nxt[i];
                gk_c = gk_n; WT_c = WT_n; pitch_c = pitch_n; k0_c = k0_n; dr_c = dr_n;
            }
        }
#undef TR_SETUP
        __syncthreads();
    }
    if (mask & 2)
    for (int it = opaque_bid(); it < 2 * 4 * 32; it += G) {
        const int l = it >> 7, g = (it >> 5) & 3, db = it & 31;
        float* pwT = (float*)lds;
        __syncthreads();
        {
            const float* pw = p.in[10] + ((size_t)l * 4 + g) * 16384; const float* sc = p.in[11] + l * 512 + g * 128;
#pragma unroll 8
            for (int e = tid; e < 16384; e += 512) { const int i = e >> 7, j = e & 127; pwT[j * 132 + i] = pw[e] * sc[j]; }
        }
        __syncthreads();
        const int d = db * 32 + (tid & 31), i0 = (tid >> 5) * 8;
        const float* wb = p.in[21] + ((size_t)l * 4) * 512 * 1024 + (size_t)(g * 128) * 1024 + d;
        float a[8];
#pragma unroll
        for (int r = 0; r < 8; ++r) a[r] = 0.f;
#pragma unroll 16
        for (int j = 0; j < 128; ++j) {
            const float w = wb[(size_t)j * 1024];
            const f32x4 p0 = *(const f32x4*)(pwT + j * 132 + i0), p1 = *(const f32x4*)(pwT + j * 132 + i0 + 4);
            a[0] += p0[0] * w; a[1] += p0[1] * w; a[2] += p0[2] * w; a[3] += p0[3] * w; a[4] += p1[0] * w; a[5] += p1[1] * w; a[6] += p1[2] * w; a[7] += p1[3] * w;
        }
        bf16_t* o = (bf16_t*)(ws + WS_WB) + (size_t)l * 2097152 + (size_t)d * 2048 + g * 128 + i0;
        u32x4 w0; w0.x = pk_bf16(a[0], a[1]); w0.y = pk_bf16(a[2], a[3]); w0.z = pk_bf16(a[4], a[5]); w0.w = pk_bf16(a[6], a[7]);
        *(u32x4*)o = w0;
    }
    __syncthreads();
    if (mask & 4) {
    for (int e = opaque_bid() * 512 + tid; e < 2 * 4 * 128 * 128; e += G * 512) {
        const int t = (e >> 7) & 127, s = e & 127; const float v = (s <= t) ? p.in[15][e] : 0.f;
        ((bf16_t*)(ws + WS_SGUW))[e] = (bf16_t)(pk_bf16(v, 0.f) & 0xffffu);
    }
    float* SS = (float*)(ws + WS_SS);
    for (int m0 = gw; m0 < MT; m0 += 2 * NGW) {
        const int m1 = m0 + NGW; const bool two = m1 < MT;
        const float* x0 = (m0 < MP) ? p.in[0] + (size_t)m0 * DM : p.in[1] + (size_t)(m0 - MP) * DM;
        const float* x1 = two ? ((m1 < MP) ? p.in[0] + (size_t)m1 * DM : p.in[1] + (size_t)(m1 - MP) * DM) : x0;
        f32x4 v0[4], v1[4];
#pragma unroll
        for (int j = 0; j < 4; ++j) { v0[j] = ((const f32x4*)x0)[lane + 64 * j]; v1[j] = ((const f32x4*)x1)[lane + 64 * j]; }
        float s0 = 0.f, s1 = 0.f;
#pragma unroll
        for (int j = 0; j < 4; ++j) { s0 += (v0[j].x * v0[j].x + v0[j].y * v0[j].y) + (v0[j].z * v0[j].z + v0[j].w * v0[j].w); s1 += (v1[j].x * v1[j].x + v1[j].y * v1[j].y) + (v1[j].z * v1[j].z + v1[j].w * v1[j].w); }
        u32x2* o0 = (u32x2*)((bf16_t*)(ws + WS_XB) + (size_t)m0 * DM) + lane;
#pragma unroll
        for (int j = 0; j < 4; ++j) { u32x2 w; w.x = pk_bf16(v0[j].x, v0[j].y); w.y = pk_bf16(v0[j].z, v0[j].w); o0[64 * j] = w; }
        s0 = wave_sum(s0);
        if (lane < 16) SS[(size_t)m0 * 16 + lane] = (lane == 0) ? s0 : 0.f;
        if (two) {
            u32x2* o1 = (u32x2*)((bf16_t*)(ws + WS_XB) + (size_t)m1 * DM) + lane;
#pragma unroll
            for (int j = 0; j < 4; ++j) { u32x2 w; w.x = pk_bf16(v1[j].x, v1[j].y); w.y = pk_bf16(v1[j].z, v1[j].w); o1[64 * j] = w; }
            s1 = wave_sum(s1);
            if (lane < 16) SS[(size_t)m1 * 16 + lane] = (lane == 0) ? s1 : 0.f;
        }
    }
    for (int m = gw; m < 2048; m += NGW) {
        const float s = row_to_bf16(p.in[7] + (size_t)m * DM, (bf16_t*)(ws + WS_MB) + (size_t)m * DM, lane);
        if (lane == 0) ((float*)(ws + WS_SSM))[m] = s;
    }
    }
}

template <bool SAMPLE, int NROWS>
DI void stage_rows(float* tile, int hist, const float* state, const bf16_t* Zcol, int rowbase, int tt0, float* outp, int ncarry, bool write_carry, int tid) {
    constexpr int ITER = (NROWS * 64 + 511) / 512;
    u32x4 vb[ITER]; f32x4 slo[ITER], shi[ITER];
#pragma unroll
    for (int i = 0; i < ITER; ++i) {
        const int c = tid + 512 * i, k = c >> 6, cc = (c & 63) * 8;
        vb[i] = (u32x4){0u, 0u, 0u, 0u}; slo[i] = (f32x4){0.f, 0.f, 0.f, 0.f}; shi[i] = (f32x4){0.f, 0.f, 0.f, 0.f};
        if (c < NROWS * 64) {
            if (SAMPLE) {
                if (k < hist) { slo[i] = *(const f32x4*)(state + (size_t)k * WBR + cc); shi[i] = *(const f32x4*)(state + (size_t)k * WBR + cc + 4); }
                else vb[i] = *(const u32x4*)(Zcol + (size_t)(rowbase + k - hist) * ZP + cc);
            } else {
                const int t = tt0 - hist + k;
                if (t >= 0) vb[i] = *(const u32x4*)(Zcol + (size_t)(rowbase + t) * ZP + cc);
            }
        }
    }
#pragma unroll
    for (int i = 0; i < ITER; ++i) {
        const int c = tid + 512 * i, k = c >> 6, cc = (c & 63) * 8;
        if (c < NROWS * 64) {
            f32x4 lo, hi; int ci;
            const u32x4 v = vb[i];
            lo = (f32x4){bf_lo(v.x), bf_hi(v.x), bf_lo(v.y), bf_hi(v.y)}; hi = (f32x4){bf_lo(v.z), bf_hi(v.z), bf_lo(v.w), bf_hi(v.w)};
            if (SAMPLE) { if (k < hist) { lo = slo[i]; hi = shi[i]; } ci = k - (NROWS - ncarry); }
            else ci = (tt0 - hist + k) - (SEQ - ncarry);
            *(f32x4*)(tile + k * WBR + cc) = lo; *(f32x4*)(tile + k * WBR + cc + 4) = hi;
            if (write_carry && ci >= 0) { *(f32x4*)(outp + (size_t)ci * WBR + cc) = lo; *(f32x4*)(outp + (size_t)ci * WBR + cc + 4) = hi; }
        }
    }
}
template <int NT, int W> DI void pool_compute(const float* tile, int ch, int tt0, bool sample, float (&o)[NT]) {
    float e[NT + 15];
#pragma unroll
    for (int k = 0; k < NT + 15; ++k) e[k] = tile[k * WBR + ch];
#pragma unroll
    for (int j = 0; j < NT; ++j) {
        float s = 0.f;
#pragma unroll
        for (int i = 0; i < W; ++i) s += e[j + 15 - i];
        const int pos = tt0 + j; const float inv = (sample || pos + 1 >= W) ? 1.f / (float)W : 1.f / (float)(pos + 1);
        o[j] = s * inv - e[j + 15];
    }
}
struct ConvConst { float cw[31]; float cb, lng, lnb, sw0, sw1, sw2, sg, sb; };
template <int NT, bool SAMPLE>
DI void conv_item(const Params& p, int l, int b, int tt0, const ConvConst& cc, float* tile, float* red, int tid, int lane, int wave) {
    const bf16_t* Z = (const bf16_t*)(ws_of(p) + WS_Z); const int ch = tid;
    const int rowbase = SAMPLE ? MP + b * NSQ : b * SEQ; const int row0 = SAMPLE ? rowbase : rowbase + tt0;
    const bool lastp = SAMPLE || (tt0 + NT == SEQ);
    stage_rows<SAMPLE, NT + 15>(tile, 15, SAMPLE ? p.in[2] + ((size_t)l * NSB + b) * 15 * WBR : nullptr, Z, rowbase, tt0,
                       SAMPLE ? out_of(p) + O_POOLS + ((size_t)l * NSB + b) * 15 * WBR : out_of(p) + O_POOLP + ((size_t)l * NB + b) * 15 * WBR, 15, lastp, tid);
    __syncthreads();
    {
        float o[NT];
        switch (wave >> 1) {
            case 0: pool_compute<NT, 2>(tile, ch, tt0, SAMPLE, o); break;
            case 1: pool_compute<NT, 4>(tile, ch, tt0, SAMPLE, o); break;
            case 2: pool_compute<NT, 8>(tile, ch, tt0, SAMPLE, o); break;
            default: pool_compute<NT, 16>(tile, ch, tt0, SAMPLE, o); break;
        }
        bf16_t* BR0 = (bf16_t*)(ws_of(p) + WS_BR) + (size_t)row0 * 2048 + ch;
#pragma unroll
        for (int j = 0; j < NT; ++j) BR0[j * 2048] = (bf16_t)(pk_bf16(o[j], 0.f) & 0xffffu);
    }
    __syncthreads();
    stage_rows<SAMPLE, NT + 2>(tile, 2, SAMPLE ? p.in[3] + ((size_t)l * NSB + b) * 2 * WBR : nullptr, Z + 512, rowbase, tt0,
                       SAMPLE ? out_of(p) + O_SCS + ((size_t)l * NSB + b) * 2 * WBR : out_of(p) + O_SCP + ((size_t)l * NB + b) * 2 * WBR, 2, lastp, tid);
    stage_rows<false, NT>(tile + (NT + 2) * WBR, 0, nullptr, Z + 1024, row0, 0, nullptr, 0, false, tid);
    __syncthreads();
    {
        bf16_t* BR1 = (bf16_t*)(ws_of(p) + WS_BR) + (size_t)row0 * 2048 + 512 + ch;
#pragma unroll
        for (int j = 0; j < NT; ++j) {
            const float c = cc.sw0 * tile[j * WBR + ch] + cc.sw1 * tile[(j + 1) * WBR + ch] + cc.sw2 * tile[(j + 2) * WBR + ch];
            BR1[j * 2048] = (bf16_t)(pk_bf16(tile[(NT + 2 + j) * WBR + ch] * c, 0.f) & 0xffffu);
        }
    }
    __syncthreads();
    stage_rows<SAMPLE, NT + 30>(tile, 30, SAMPLE ? p.in[4] + ((size_t)l * NSB + b) * 30 * WBR : nullptr, Z + 2560, rowbase, tt0,
                       SAMPLE ? out_of(p) + O_CCS + ((size_t)l * NSB + b) * 30 * WBR : out_of(p) + O_CCP + ((size_t)l * NB + b) * 30 * WBR, 30, lastp, tid);
    __syncthreads();
    float a[NT];
#pragma unroll
    for (int j = 0; j < NT; ++j) a[j] = cc.cb;
#pragma unroll
    for (int k = 0; k < NT + 30; ++k) {
        const float v = tile[k * WBR + ch];
#pragma unroll
        for (int j = 0; j < NT; ++j) { const int tap = k - j; if (tap >= 0 && tap <= 30) a[j] += cc.cw[tap] * v; }
    }
#pragma unroll
    for (int j = 0; j < NT; ++j) {
        const float s1 = wave_sum(a[j]), s2 = wave_sum(a[j] * a[j]);
        if (lane == 0) { red[(wave * NT + j) * 2] = s1; red[(wave * NT + j) * 2 + 1] = s2; }
    }
    __syncthreads();
    {
        bf16_t* BR3 = (bf16_t*)(ws_of(p) + WS_BR) + (size_t)row0 * 2048 + 1536 + ch;
#pragma unroll
        for (int j = 0; j < NT; ++j) {
            float s1 = 0.f, s2 = 0.f;
#pragma unroll
            for (int w = 0; w < 8; ++w) { s1 += red[(w * NT + j) * 2]; s2 += red[(w * NT + j) * 2 + 1]; }
            const float mean = s1 * (1.f / 512.f), var = fmaxf(s2 * (1.f / 512.f) - mean * mean, 0.f), rstd = __builtin_amdgcn_rsqf(var + EPS);
            const float y = (a[j] - mean) * rstd * cc.lng + cc.lnb;
            BR3[j * 2048] = (bf16_t)(pk_bf16(y * sigmoidf_(y), 0.f) & 0xffffu);
        }
    }
    __syncthreads();
    if (SAMPLE) {
        stage_rows<false, NT>(tile, 0, nullptr, Z + 2048, row0, 0, nullptr, 0, false, tid);
        stage_rows<false, NT>(tile + NT * WBR, 0, nullptr, Z + 1536, row0, 0, nullptr, 0, false, tid);
        __syncthreads();
        float v[NT];
#pragma unroll
        for (int j = 0; j < NT; ++j) {
            v[j] = tile[j * WBR + ch];
            const float s1 = wave_sum(v[j]), s2 = wave_sum(v[j] * v[j]);
            if (lane == 0) { red[(wave * NT + j) * 2] = s1; red[(wave * NT + j) * 2 + 1] = s2; }
        }
        __syncthreads();
        float* ov = out_of(p) + O_SGUV + (((size_t)l * NSB + b) * NSQ) * WBR + ch;
#pragma unroll
        for (int j = 0; j < NT; ++j) {
            float s1 = 0.f, s2 = 0.f;
#pragma unroll
            for (int w = 0; w < 8; ++w) { s1 += red[(w * NT + j) * 2]; s2 += red[(w * NT + j) * 2 + 1]; }
            const float mean = s1 * (1.f / 512.f), var = fmaxf(s2 * (1.f / 512.f) - mean * mean, 0.f), rstd = __builtin_amdgcn_rsqf(var + EPS);
            v[j] = (v[j] - mean) * rstd * cc.sg + cc.sb;
            ov[j * WBR] = v[j];
        }
        const int g = wave >> 1;
        const float* Wg = p.in[15] + ((size_t)l * 4 + g) * 128 * 128; const float* bs = p.in[16] + ((size_t)l * 4 + g) * 128;
        bf16_t* BR2 = (bf16_t*)(ws_of(p) + WS_BR) + (size_t)row0 * 2048 + 1024 + ch;
#pragma unroll
        for (int t = 0; t < NT; ++t) {
            float s0 = bs[t];
#pragma unroll
            for (int s = 0; s <= t; ++s) s0 += Wg[t * 128 + s] * v[s];
            BR2[t * 2048] = (bf16_t)(pk_bf16(tile[(NT + t) * WBR + ch] * s0, 0.f) & 0xffffu);
        }
        __syncthreads();
    }
}

DI float ldh(const bf16_t* t, int idx) { return __uint_as_float((unsigned)t[idx] << 16); }
template <int W> DI void pool_compute_h(const bf16_t* tile, int ch, int tt0, float (&o)[16]) {
    float e[31];
#pragma unroll
    for (int k = 0; k < 31; ++k) e[k] = ldh(tile, k * WBR + ch);
#pragma unroll
    for (int j = 0; j < 16; ++j) {
        float s = 0.f;
#pragma unroll
        for (int i = 0; i < W; ++i) s += e[j + 15 - i];
        const int pos = tt0 + j; const float inv = (pos + 1 >= W) ? 1.f / (float)W : 1.f / (float)(pos + 1);
        o[j] = s * inv - e[j + 15];
    }
}
DI void conv_item_p(const Params& p, int l, int b, int tt0, const ConvConst& cc, unsigned char* lds, float* red, int tid, int lane, int wave) {
    constexpr int NT = 16, RA = 0, RB = 31, RBB = 49, RD = 65, NR = 111;
    const bf16_t* Z = (const bf16_t*)(ws_of(p) + WS_Z); const int ch = tid;
    const int rowbase = b * SEQ, row0 = rowbase + tt0; const bool lastp = (tt0 + NT == SEQ);
    bf16_t* tile = (bf16_t*)lds;
    {
#pragma unroll
        for (int i = 0; i < 14; ++i) {
            const int r = wave + 8 * i;
            if (r < NR) {
                int hist, col, kk;
                if (r < RB) { hist = 15; col = 0; kk = r; } else if (r < RBB) { hist = 2; col = 512; kk = r - RB; } else if (r < RD) { hist = 0; col = 1024; kk = r - RBB; } else { hist = 30; col = 2560; kk = r - RD; }
                const int t = tt0 - hist + kk;
                if (t >= 0) __builtin_amdgcn_global_load_lds((const unsigned*)(Z + (size_t)(rowbase + t) * ZP + col + lane * 8), (LAS unsigned*)((LAS unsigned char*)lds + r * 1024), 16, 0, 0);
                else *(u32x4*)(tile + r * WBR + lane * 8) = (u32x4){0u, 0u, 0u, 0u};
            }
        }
        asm volatile("s_waitcnt vmcnt(0)" ::: "memory");
    }
    __syncthreads();
    if (lastp) {
#pragma unroll 1
        for (int c = tid; c < NR * 64; c += 512) {
            const int r = c >> 6, cc8 = (c & 63) * 8;
            if (r < RBB || r >= RD) {
                int hist, kk, nc; size_t ob;
                if (r < RB) { hist = 15; kk = r; nc = 15; ob = O_POOLP + ((size_t)l * NB + b) * 15 * WBR; }
                else if (r < RBB) { hist = 2; kk = r - RB; nc = 2; ob = O_SCP + ((size_t)l * NB + b) * 2 * WBR; }
                else { hist = 30; kk = r - RD; nc = 30; ob = O_CCP + ((size_t)l * NB + b) * 30 * WBR; }
                const int ci = (tt0 - hist + kk) - (SEQ - nc);
                if (ci >= 0) { const u32x4 v = *(const u32x4*)(tile + r * WBR + cc8); float* o = out_of(p) + ob + (size_t)ci * WBR + cc8;
                    *(f32x4*)o = (f32x4){bf_lo(v.x), bf_hi(v.x), bf_lo(v.y), bf_hi(v.y)}; *(f32x4*)(o + 4) = (f32x4){bf_lo(v.z), bf_hi(v.z), bf_lo(v.w), bf_hi(v.w)}; }
            }
        }
    }
    float oA[NT], oB[NT];
    switch (wave >> 1) {
        case 0: pool_compute_h<2>(tile + RA * WBR, ch, tt0, oA); break;
        case 1: pool_compute_h<4>(tile + RA * WBR, ch, tt0, oA); break;
        case 2: pool_compute_h<8>(tile + RA * WBR, ch, tt0, oA); break;
        default: pool_compute_h<16>(tile + RA * WBR, ch, tt0, oA); break;
    }
    {
        const bf16_t* tb = tile + RB * WBR; const bf16_t* tbb = tile + RBB * WBR;
#pragma unroll
        for (int j = 0; j < NT; ++j) {
            const float c = cc.sw0 * ldh(tb, j * WBR + ch) + cc.sw1 * ldh(tb, (j + 1) * WBR + ch) + cc.sw2 * ldh(tb, (j + 2) * WBR + ch);
            oB[j] = ldh(tbb, j * WBR + ch) * c;
        }
    }
    float a[NT];
#pragma unroll
    for (int j = 0; j < NT; ++j) a[j] = cc.cb;
    {
        const bf16_t* td = tile + RD * WBR;
#pragma unroll
        for (int k = 0; k < NT + 30; ++k) {
            const float v = ldh(td, k * WBR + ch);
#pragma unroll
            for (int j = 0; j < NT; ++j) { const int tap = k - j; if (tap >= 0 && tap <= 30) a[j] += cc.cw[tap] * v; }
        }
    }
    {
        float v[2 * NT];
#pragma unroll
        for (int j = 0; j < NT; ++j) { v[2 * j] = a[j]; v[2 * j + 1] = a[j] * a[j]; }
        XReduce<2 * NT, 32>::run(v, lane);
        const int idx = lane >> 1;
        if ((lane & 1) == 0) red[((idx >> 1) * 8 + wave) * 2 + (idx & 1)] = v[0];
    }
    __syncthreads();
#pragma unroll
    for (int j = 0; j < NT; ++j) {
        const f32x4* rp = (const f32x4*)(red + j * 16); const f32x4 r0 = rp[0], r1 = rp[1], r2 = rp[2], r3 = rp[3];
        const float s1 = (r0[0] + r0[2]) + (r1[0] + r1[2]) + (r2[0] + r2[2]) + (r3[0] + r3[2]), s2 = (r0[1] + r0[3]) + (r1[1] + r1[3]) + (r2[1] + r2[3]) + (r3[1] + r3[3]);
        const float mean = s1 * (1.f / 512.f), var = fmaxf(s2 * (1.f / 512.f) - mean * mean, 0.f), rstd = __builtin_amdgcn_rsqf(var + EPS);
        const float y = (a[j] - mean) * rstd * cc.lng + cc.lnb;
        tile[(0 * NT + j) * WBR + ch] = (bf16_t)(pk_bf16(oA[j], 0.f) & 0xffffu);
        tile[(1 * NT + j) * WBR + ch] = (bf16_t)(pk_bf16(oB[j], 0.f) & 0xffffu);
        tile[(2 * NT + j) * WBR + ch] = (bf16_t)(pk_bf16(y * sigmoidf_(y), 0.f) & 0xffffu);
    }
    __syncthreads();
    {
        bf16_t* BRb = (bf16_t*)(ws_of(p) + WS_BR) + (size_t)row0 * 2048;
#pragma unroll
        for (int q = 0; q < 6; ++q) {
            const int idx = tid + 512 * q, br = idx >> 10, j = (idx >> 6) & 15, c8 = (idx & 63) * 8;
            const u32x4 v = *(const u32x4*)(tile + (br * NT + j) * WBR + c8);
            *(u32x4*)(BRb + (size_t)j * 2048 + (br == 2 ? 1536 : br * 512) + c8) = v;
        }
    }
    __syncthreads();
}

DI void sgu_item(const Params& p, int l, int it, unsigned char* lds) {
    const int tid = opaque_tid(), lane = tid & 63, wave = __builtin_amdgcn_readfirstlane(tid >> 6);
    const int g = it & 3, chunk = (it >> 2) & 15, b = it >> 6;
    const int rowbase = b * SEQ + chunk * 128;
    const bf16_t* Z = (const bf16_t*)(ws_of(p) + WS_Z);
    bf16_t* vnT = (bf16_t*)lds;
    float* Sb = (float*)(lds + 36864);
    {
        u32x4 v[16];
#pragma unroll
        for (int r = 0; r < 16; ++r) v[r] = *(const u32x4*)(Z + (size_t)(rowbase + wave * 16 + r) * ZP + 2048 + lane * 8);
        float s1[16], s2[16];
#pragma unroll
        for (int r = 0; r < 16; ++r) {
            const float x[8] = {bf_lo(v[r].x), bf_hi(v[r].x), bf_lo(v[r].y), bf_hi(v[r].y), bf_lo(v[r].z), bf_hi(v[r].z), bf_lo(v[r].w), bf_hi(v[r].w)};
            float a = 0.f, q = 0.f;
#pragma unroll
            for (int i = 0; i < 8; ++i) { a += x[i]; q += x[i] * x[i]; }
            s1[r] = a; s2[r] = q;
        }
        {
            float vv[32];
#pragma unroll
            for (int r = 0; r < 16; ++r) { vv[2 * r] = s1[r]; vv[2 * r + 1] = s2[r]; }
            XReduce<32, 32>::run(vv, lane);
            float* sb = (float*)(lds + LDS_MISC + 1024) + wave * 32;
            if ((lane & 1) == 0) sb[lane >> 1] = vv[0];
            asm volatile("s_waitcnt lgkmcnt(0)" ::: "memory");
#pragma unroll
            for (int r = 0; r < 16; ++r) { s1[r] = sb[2 * r]; s2[r] = sb[2 * r + 1]; }
            asm volatile("" ::: "memory");
        }
        if ((lane >> 4) == g) {
            const int c0 = (lane & 15) * 8;
            const f32x4 gA = *(const f32x4*)(p.in[13] + l * WBR + lane * 8), gB = *(const f32x4*)(p.in[13] + l * WBR + lane * 8 + 4);
            const f32x4 bA = *(const f32x4*)(p.in[14] + l * WBR + lane * 8), bB = *(const f32x4*)(p.in[14] + l * WBR + lane * 8 + 4);
            const float gg[8] = {gA.x, gA.y, gA.z, gA.w, gB.x, gB.y, gB.z, gB.w}, bb[8] = {bA.x, bA.y, bA.z, bA.w, bB.x, bB.y, bB.z, bB.w};
#pragma unroll
            for (int r = 0; r < 16; ++r) {
                const int s = wave * 16 + r;
                const float mean = s1[r] * (1.f / 512.f), var = fmaxf(s2[r] * (1.f / 512.f) - mean * mean, 0.f), rstd = __builtin_amdgcn_rsqf(var + EPS);
                const float x[8] = {bf_lo(v[r].x), bf_hi(v[r].x), bf_lo(v[r].y), bf_hi(v[r].y), bf_lo(v[r].z), bf_hi(v[r].z), bf_lo(v[r].w), bf_hi(v[r].w)};
#pragma unroll
                for (int i = 0; i < 8; ++i) { const float y = (x[i] - mean) * rstd * gg[i] + bb[i]; vnT[(c0 + i) * 136 + s] = (bf16_t)(pk_bf16(y, 0.f) & 0xffffu); }
            }
        }
    }
    __syncthreads();
    {
        const int fr = lane & 15, kq = lane >> 4;
        f32x4 acc[8];
#pragma unroll
        for (int cb = 0; cb < 8; ++cb) acc[cb] = (f32x4){0.f, 0.f, 0.f, 0.f};
        const bf16_t* Wt = (const bf16_t*)(ws_of(p) + WS_SGUW) + ((size_t)l * 4 + g) * 16384 + (size_t)(wave * 16 + fr) * 128 + kq * 8;
        const int nks = (wave >> 1) + 1;
        for (int ks = 0; ks < nks; ++ks) {
            const bf16x8 a = *(const bf16x8*)(Wt + ks * 32);
#pragma unroll
            for (int cb = 0; cb < 8; ++cb) {
                const bf16x8 bfr = *(const bf16x8*)(vnT + (cb * 16 + fr) * 136 + ks * 32 + kq * 8);
                acc[cb] = __builtin_amdgcn_mfma_f32_16x16x32_bf16(a, bfr, acc[cb], 0, 0, 0);
            }
        }
        const float* bs = p.in[16] + ((size_t)l * 4 + g) * 128;
#pragma unroll
        for (int j = 0; j < 4; ++j) {
            const int t = wave * 16 + kq * 4 + j; const float bt = bs[t];
#pragma unroll
            for (int cb = 0; cb < 8; ++cb) Sb[t * 132 + cb * 16 + fr] = acc[cb][j] + bt;
        }
    }
    __syncthreads();
    {
        bf16_t* BR2 = (bf16_t*)(ws_of(p) + WS_BR) + 1024 + g * 128;
        u32x4 cu[4];
#pragma unroll
        for (int q = 0; q < 4; ++q) { const int idx = tid + 512 * q, t = idx >> 4, c8 = (idx & 15) * 8; cu[q] = *(const u32x4*)(Z + (size_t)(rowbase + t) * ZP + 1536 + g * 128 + c8); }
#pragma unroll
        for (int q = 0; q < 4; ++q) {
            const int idx = tid + 512 * q, t = idx >> 4, c8 = (idx & 15) * 8;
            const f32x4 sa = *(const f32x4*)(Sb + t * 132 + c8), sb = *(const f32x4*)(Sb + t * 132 + c8 + 4); const u32x4 u = cu[q]; u32x4 w;
            w.x = pk_bf16(bf_lo(u.x) * sa[0], bf_hi(u.x) * sa[1]); w.y = pk_bf16(bf_lo(u.y) * sa[2], bf_hi(u.y) * sa[3]);
            w.z = pk_bf16(bf_lo(u.z) * sb[0], bf_hi(u.z) * sb[1]); w.w = pk_bf16(bf_lo(u.w) * sb[2], bf_hi(u.w) * sb[3]);
            *(u32x4*)(BR2 + (size_t)(rowbase + t) * 2048 + c8) = w;
        }
    }
    __syncthreads();
}

DI void branch_phase(const Params& p, int l, unsigned char* lds, int G, int mask) {
    const int tid = opaque_tid(), lane = tid & 63, wave = __builtin_amdgcn_readfirstlane(tid >> 6);
    float* red = (float*)(lds + LDS_MISC); float* tile = (float*)lds;
    if (mask & 1) {
        const int bid = opaque_bid();
        if (G == 256) {
            if (bid < 128) { if (EN_SGU) sgu_item(p, l, bid * 4, lds); }
            else for (int k = 0; k < 3; ++k) { if (EN_SGU) sgu_item(p, l, (bid - 128) * 4 + 1 + k, lds); }
        } else for (int it = bid; it < 512; it += G) { if (EN_SGU) sgu_item(p, l, it, lds); }
    }
    if (!(mask & 2)) return;
    ConvConst cc;
#pragma unroll
    for (int t = 0; t < 31; ++t) cc.cw[t] = p.in[17][((size_t)l * 31 + t) * WBR + tid];
    cc.cb = p.in[18][l * WBR + tid]; cc.lng = p.in[19][l * WBR + tid]; cc.lnb = p.in[20][l * WBR + tid];
    cc.sw0 = p.in[12][(size_t)l * 3 * WBR + tid]; cc.sw1 = p.in[12][(size_t)l * 3 * WBR + WBR + tid]; cc.sw2 = p.in[12][(size_t)l * 3 * WBR + 2 * WBR + tid];
    cc.sg = p.in[13][l * WBR + tid]; cc.sb = p.in[14][l * WBR + tid];
    if (G == 256) {
        const int bid = opaque_bid();
        for (int k = 0; k < 4; ++k) { const int it = bid * 4 + k; if (EN_CP) conv_item_p(p, l, it >> 7, (it & 127) * 16, cc, lds, red, tid, lane, wave); }
        if (bid < 128) { if (EN_CS) conv_item<8, true>(p, l, bid, 0, cc, tile, red, tid, lane, wave); }
    } else
    for (int it = opaque_bid(); it < 1152; it += G) {
        if (it < 1024) { if (EN_CP) conv_item_p(p, l, it >> 7, (it & 127) * 16, cc, lds, red, tid, lane, wave); }
        else { if (EN_CS) conv_item<8, true>(p, l, it - 1024, 0, cc, tile, red, tid, lane, wave); }
    }
}

constexpr int KPITCH = 264;
DI void attn_prompt_unit(const Params& p, int l, int u, unsigned char* lds) {
    const int tid = opaque_tid(), lane = tid & 63, wave = tid >> 6, fr = lane & 15, kq = lane >> 4;
    const int b = u >> 6, h = (u >> 4) & 3, qb = u & 15;
    const size_t hb = ((size_t)(l * 8 + b) * 4 + h) * 65536;
    const bf16_t* Kg = (const bf16_t*)(ws_of(p) + WS_KP) + hb; const bf16_t* Vg = (const bf16_t*)(ws_of(p) + WS_VTP) + hb;
    bf16_t* img = (bf16_t*)lds;
    const int qrow = b * SEQ + qb * 128 + wave * 16 + fr;
    const bf16_t* Qg = (const bf16_t*)(ws_of(p) + WS_Q) + (size_t)qrow * DM + h * 256 + kq * 8;
    bf16x8 qf[8];
#pragma unroll
    for (int ks = 0; ks < 8; ++ks) qf[ks] = *(const bf16x8*)(Qg + ks * 32);
    {
        u32x4 st[16];
#pragma unroll
        for (int i = 0; i < 16; ++i) { const int c = tid + 512 * i, r = c >> 5, c16 = c & 31; st[i] = *(const u32x4*)(Kg + r * 256 + c16 * 8); }
#pragma unroll
        for (int i = 0; i < 16; ++i) { const int c = tid + 512 * i, r = c >> 5, c16 = c & 31; *(u32x4*)(img + r * KPITCH + c16 * 8) = st[i]; }
    }
    __syncthreads();
    f32x4 s[16];
#pragma unroll
    for (int kb = 0; kb < 16; kb += 2) {
        bf16x8 kf0[8], kf1[8];
#pragma unroll
        for (int ks = 0; ks < 8; ++ks) { kf0[ks] = *(const bf16x8*)(img + (kb * 16 + fr) * KPITCH + ks * 32 + kq * 8); kf1[ks] = *(const bf16x8*)(img + ((kb + 1) * 16 + fr) * KPITCH + ks * 32 + kq * 8); }
        s[kb] = (f32x4){0.f, 0.f, 0.f, 0.f}; s[kb + 1] = (f32x4){0.f, 0.f, 0.f, 0.f};
#pragma unroll
        for (int ks = 0; ks < 8; ++ks) {
            s[kb] = __builtin_amdgcn_mfma_f32_16x16x32_bf16(kf0[ks], qf[ks], s[kb], 0, 0, 0);
            s[kb + 1] = __builtin_amdgcn_mfma_f32_16x16x32_bf16(kf1[ks], qf[ks], s[kb + 1], 0, 0, 0);
        }
    }
    u32x4 vst[16];
#pragma unroll
    for (int i = 0; i < 16; ++i) { const int c = tid + 512 * i, r = c >> 5, c16 = c & 31; vst[i] = *(const u32x4*)(Vg + r * 256 + c16 * 8); }
    float mx = -INFINITY;
#pragma unroll
    for (int kb = 0; kb < 16; ++kb) mx = fmaxf(fmaxf(fmaxf(mx, s[kb][0]), fmaxf(s[kb][1], s[kb][2])), s[kb][3]);
    mx = fmaxf(mx, __shfl_xor(mx, 16)); mx = fmaxf(mx, __shfl_xor(mx, 32));
    float sum = 0.f;
#pragma unroll
    for (int kb = 0; kb < 16; ++kb)
#pragma unroll
        for (int j = 0; j < 4; ++j) { const float e = __builtin_amdgcn_exp2f(s[kb][j] - mx); s[kb][j] = e; sum += e; }
    sum += __shfl_xor(sum, 16); sum += __shfl_xor(sum, 32);
    const float inv = __builtin_amdgcn_rcpf(sum);
    bf16x8 pb[8];
#pragma unroll
    for (int k2 = 0; k2 < 8; ++k2) {
        u32x4 w; w.x = pk_bf16(s[2 * k2][0], s[2 * k2][1]); w.y = pk_bf16(s[2 * k2][2], s[2 * k2][3]); w.z = pk_bf16(s[2 * k2 + 1][0], s[2 * k2 + 1][1]); w.w = pk_bf16(s[2 * k2 + 1][2], s[2 * k2 + 1][3]);
        pb[k2] = __builtin_bit_cast(bf16x8, w);
    }
    __syncthreads();
#pragma unroll
    for (int i = 0; i < 16; ++i) { const int c = tid + 512 * i, r = c >> 5, c16 = c & 31; *(u32x4*)(img + r * KPITCH + c16 * 8) = vst[i]; }
    __syncthreads();
    bf16_t* Og = (bf16_t*)(ws_of(p) + WS_O) + (size_t)qrow * DM + h * 256 + kq * 4;
#pragma unroll 2
    for (int db = 0; db < 16; db += 2) {
        f32x4 o0 = (f32x4){0.f, 0.f, 0.f, 0.f}, o1 = (f32x4){0.f, 0.f, 0.f, 0.f};
        bf16x8 vf0[8], vf1[8];
#pragma unroll
        for (int k2 = 0; k2 < 8; ++k2) {
            const bf16_t* vp = img + (db * 16 + fr) * KPITCH + k2 * 32 + kq * 4;
            const s16x4 lo = *(const s16x4*)vp, hi = *(const s16x4*)(vp + 16), lo1 = *(const s16x4*)(vp + 16 * KPITCH), hi1 = *(const s16x4*)(vp + 16 * KPITCH + 16);
            vf0[k2] = (bf16x8){lo[0], lo[1], lo[2], lo[3], hi[0], hi[1], hi[2], hi[3]};
            vf1[k2] = (bf16x8){lo1[0], lo1[1], lo1[2], lo1[3], hi1[0], hi1[1], hi1[2], hi1[3]};
        }
#pragma unroll
        for (int k2 = 0; k2 < 8; ++k2) {
            o0 = __builtin_amdgcn_mfma_f32_16x16x32_bf16(vf0[k2], pb[k2], o0, 0, 0, 0);
            o1 = __builtin_amdgcn_mfma_f32_16x16x32_bf16(vf1[k2], pb[k2], o1, 0, 0, 0);
        }
        u32x2 w; w.x = pk_bf16(o0[0] * inv, o0[1] * inv); w.y = pk_bf16(o0[2] * inv, o0[3] * inv);
        *(u32x2*)(Og + db * 16) = w;
        w.x = pk_bf16(o1[0] * inv, o1[1] * inv); w.y = pk_bf16(o1[2] * inv, o1[3] * inv);
        *(u32x2*)(Og + db * 16 + 16) = w;
    }
    __syncthreads();
}

DI void attn_sample_item(const Params& p, int l, int it, unsigned char* lds) {
    const int tid = opaque_tid(), lane = tid & 63, wave = tid >> 6, fr = lane & 15, kq = lane >> 4;
    const int b = it >> 2, h = it & 3;
    const float* Kc = p.in[5] + (((size_t)l * NSB + b) * 256) * 1024 + h * 256;
    const float* Vc = p.in[6] + (((size_t)l * NSB + b) * 256) * 1024 + h * 256;
    float* sS = (float*)lds;
    float* red = (float*)(lds + 8192);
    const int qrow = MP + b * NSQ + (fr & 7);
    const bf16_t* Qg = (const bf16_t*)(ws_of(p) + WS_Q) + (size_t)qrow * DM + h * 256 + kq * 8;
    bf16x8 qf[8];
#pragma unroll
    for (int ks = 0; ks < 8; ++ks) { qf[ks] = *(const bf16x8*)(Qg + ks * 32); if (fr >= 8) qf[ks] = (bf16x8){0, 0, 0, 0, 0, 0, 0, 0}; }
#pragma unroll
    for (int kb = 0; kb < 2; ++kb) {
        const float* kp = Kc + (size_t)(wave * 32 + kb * 16 + fr) * 1024 + kq * 8;
        f32x4 ka[8], kbv[8];
#pragma unroll
        for (int ks = 0; ks < 8; ++ks) { ka[ks] = *(const f32x4*)(kp + ks * 32); kbv[ks] = *(const f32x4*)(kp + ks * 32 + 4); }
        f32x4 s = (f32x4){0.f, 0.f, 0.f, 0.f};
#pragma unroll
        for (int ks = 0; ks < 8; ++ks) {
            u32x4 w; w.x = pk_bf16(ka[ks][0], ka[ks][1]); w.y = pk_bf16(ka[ks][2], ka[ks][3]); w.z = pk_bf16(kbv[ks][0], kbv[ks][1]); w.w = pk_bf16(kbv[ks][2], kbv[ks][3]);
            s = __builtin_amdgcn_mfma_f32_16x16x32_bf16(__builtin_bit_cast(bf16x8, w), qf[ks], s, 0, 0, 0);
        }
        if (fr < 8) {
#pragma unroll
            for (int j = 0; j < 4; ++j) sS[(wave * 32 + kb * 16 + kq * 4 + j) * 8 + fr] = s[j];
        }
    }
    __syncthreads();
    {
        float v[4]; float mx = -INFINITY;
#pragma unroll
        for (int i = 0; i < 4; ++i) { v[i] = sS[(lane + 64 * i) * 8 + wave]; mx = fmaxf(mx, v[i]); }
        mx = wave_max(mx); float sum = 0.f;
#pragma unroll
        for (int i = 0; i < 4; ++i) { v[i] = __builtin_amdgcn_exp2f(v[i] - mx); sum += v[i]; }
        sum = wave_sum(sum); const float inv = 1.f / sum;
#pragma unroll
        for (int i = 0; i < 4; ++i) sS[(lane + 64 * i) * 8 + wave] = v[i] * inv;
    }
    __syncthreads();
    {
        f32x4 o[8];
#pragma unroll
        for (int q = 0; q < 8; ++q) o[q] = (f32x4){0.f, 0.f, 0.f, 0.f};
        const float* vp = Vc + (size_t)(wave * 32) * 1024 + lane * 4;
#pragma unroll 8
        for (int k = 0; k < 32; ++k) {
            const f32x4 v = *(const f32x4*)(vp + (size_t)k * 1024);
            const f32x4 p0 = *(const f32x4*)(sS + (wave * 32 + k) * 8), p1 = *(const f32x4*)(sS + (wave * 32 + k) * 8 + 4);
            o[0] += v * p0[0]; o[1] += v * p0[1]; o[2] += v * p0[2]; o[3] += v * p0[3];
            o[4] += v * p1[0]; o[5] += v * p1[1]; o[6] += v * p1[2]; o[7] += v * p1[3];
        }
#pragma unroll
        for (int q = 0; q < 8; ++q) *(f32x4*)(red + ((wave * 8 + q) * 256) + lane * 4) = o[q];
    }
    __syncthreads();
    {
        const int q = tid >> 6; f32x4 a = (f32x4){0.f, 0.f, 0.f, 0.f};
#pragma unroll
        for (int w = 0; w < 8; ++w) a += *(const f32x4*)(red + ((w * 8 + q) * 256) + lane * 4);
        bf16_t* Og = (bf16_t*)(ws_of(p) + WS_O) + (size_t)(MP + b * NSQ + q) * DM + h * 256 + lane * 4;
        u32x2 w; w.x = pk_bf16(a[0], a[1]); w.y = pk_bf16(a[2], a[3]); *(u32x2*)Og = w;
    }
    __syncthreads();
}

DI void attn_phase(const Params& p, int l, unsigned char* lds, int G, int mask) {
    for (int it = opaque_bid(); it < 1024; it += G) {
        if (it < 512) {
            int u = it;
            if (G == 256) { const int c = it & 255; u = (it & 256) + (c & 7) * 32 + (c >> 3); }
            if (mask & 1) attn_prompt_unit(p, l, u, lds);
        } else { if (mask & 2) attn_sample_item(p, l, it - 512, lds); }
    }
}

DI void final_phase(const Params& p, int G) {
    const int tid = opaque_tid(), lane = tid & 63, wave = tid >> 6;
    const bf16_t* XBf = (const bf16_t*)(ws_of(p) + WS_XB); const float* SS = (const float*)(ws_of(p) + WS_SS); const float* g = p.in[33];
    f32x4 gv[4];
#pragma unroll
    for (int j = 0; j < 4; ++j) gv[j] = ((const f32x4*)g)[lane + 64 * j];
    const int NW = G * 8;
    for (int m0 = opaque_bid() * 8 + wave; m0 < MT; m0 += 4 * NW) {
        u32x2 xv[4][4]; float sv[4];
#pragma unroll
        for (int r = 0; r < 4; ++r) {
            const int m = m0 + r * NW; const bool ok = m < MT; const int mm = ok ? m : m0;
            sv[r] = (lane < 16) ? SS[(size_t)mm * 16 + lane] : 0.f;
            const u32x2* xr = (const u32x2*)(XBf + (size_t)mm * DM) + lane;
#pragma unroll
            for (int j = 0; j < 4; ++j) xv[r][j] = xr[64 * j];
        }
#pragma unroll
        for (int r = 0; r < 4; ++r) {
            const int m = m0 + r * NW; if (m >= MT) break;
            const float rs = __builtin_amdgcn_rsqf(wave_sum(sv[r]) * (1.f / 1024.f) + EPS);
            f32x4* o = (f32x4*)(out_of(p) + (size_t)m * DM) + lane;
#pragma unroll
            for (int j = 0; j < 4; ++j) { const u32x2 v = xv[r][j]; o[64 * j] = (f32x4){bf_lo(v.x), bf_hi(v.x), bf_lo(v.y), bf_hi(v.y)} * rs * gv[j]; }
        }
    }
}

constexpr int MPITCH = 264, MOPB = 64 * MPITCH * 2;
DI void mini_unit(const Params& p, unsigned char* lds, int kind, const bf16_t* A, const bf16_t* Bt, int Kfull, int mu, int nct, float scale, const float* xin_s) {
    const int tid = opaque_tid(), lane = tid & 63, wave = __builtin_amdgcn_readfirstlane(tid >> 6), fr = lane & 15, kq = lane >> 4, rb = wave & 3, kh = wave >> 2;
    const int rt = mu / nct, ct = mu % nct, r0 = rt * 64 + rb * 16;
    unsigned char* ws = ws_of(p);
    f32x4 tot[4], acc[4];
#pragma unroll
    for (int cb = 0; cb < 4; ++cb) { tot[cb] = (f32x4){0.f, 0.f, 0.f, 0.f}; acc[cb] = (f32x4){0.f, 0.f, 0.f, 0.f}; }
    const int pitch = Kfull, nch = Kfull >> 8;
    const bf16_t* Ag = A + (size_t)(rt * 64 + (tid >> 5)) * pitch + (tid & 31) * 8;
    const bf16_t* Bg = Bt + (size_t)(ct * 64 + (tid >> 5)) * pitch + (tid & 31) * 8;
    const int sto = (tid >> 5) * MPITCH + (tid & 31) * 8;
    u32x4 ra[4], rbv[4];
#pragma unroll
    for (int i = 0; i < 4; ++i) { ra[i] = *(const u32x4*)(Ag + (size_t)(16 * i) * pitch); rbv[i] = *(const u32x4*)(Bg + (size_t)(16 * i) * pitch); }
    __syncthreads();
    {
        bf16_t* sa = (bf16_t*)lds; bf16_t* sb = (bf16_t*)(lds + MOPB);
#pragma unroll
        for (int i = 0; i < 4; ++i) { *(u32x4*)(sa + sto + 16 * i * MPITCH) = ra[i]; *(u32x4*)(sb + sto + 16 * i * MPITCH) = rbv[i]; }
    }
    __syncthreads();
    for (int c = 0; c < nch; ++c) {
        const bool more = (c + 1 < nch);
        if (more) {
#pragma unroll
            for (int i = 0; i < 4; ++i) { ra[i] = *(const u32x4*)(Ag + (size_t)(16 * i) * pitch + (c + 1) * 256); rbv[i] = *(const u32x4*)(Bg + (size_t)(16 * i) * pitch + (c + 1) * 256); }
        }
        const bf16_t* sa = (const bf16_t*)(lds + (c & 1) * 2 * MOPB) + (rb * 16 + fr) * MPITCH + kh * 128 + kq * 8;
        const bf16_t* sb = (const bf16_t*)(lds + (c & 1) * 2 * MOPB + MOPB) + fr * MPITCH + kh * 128 + kq * 8;
#pragma unroll
        for (int ks = 0; ks < 4; ++ks) {
            const bf16x8 a = *(const bf16x8*)(sa + ks * 32);
#pragma unroll
            for (int cb = 0; cb < 4; ++cb) { const bf16x8 bfr = *(const bf16x8*)(sb + cb * 16 * MPITCH + ks * 32); acc[cb] = __builtin_amdgcn_mfma_f32_16x16x32_bf16(bfr, a, acc[cb], 0, 0, 0); }
        }
        if (kind == 9) {
            if (c & 1) {
                const int sg = c >> 1;
                const bf16_t* gp = (const bf16_t*)(ws + WS_Z) + (size_t)(MP + r0 + fr) * ZP + 3072 + 1024 * sg + ct * 64 + 4 * kq;
#pragma unroll
                for (int cb = 0; cb < 4; ++cb) { const u32x2 g = *(const u32x2*)(gp + cb * 16);
                    tot[cb][0] += bf_lo(g.x) * acc[cb][0]; tot[cb][1] += bf_hi(g.x) * acc[cb][1]; tot[cb][2] += bf_lo(g.y) * acc[cb][2]; tot[cb][3] += bf_hi(g.y) * acc[cb][3];
                    acc[cb] = (f32x4){0.f, 0.f, 0.f, 0.f}; }
            }
        }
        if (more) {
            bf16_t* sa2 = (bf16_t*)(lds + ((c + 1) & 1) * 2 * MOPB); bf16_t* sb2 = (bf16_t*)(lds + ((c + 1) & 1) * 2 * MOPB + MOPB);
#pragma unroll
            for (int i = 0; i < 4; ++i) { *(u32x4*)(sa2 + sto + 16 * i * MPITCH) = ra[i]; *(u32x4*)(sb2 + sto + 16 * i * MPITCH) = rbv[i]; }
        }
        __syncthreads();
    }
    if (kind != 9) {
#pragma unroll
        for (int cb = 0; cb < 4; ++cb) tot[cb] = acc[cb];
    }
    float* red = (float*)lds;
    if (kh == 1) {
#pragma unroll
        for (int cb = 0; cb < 4; ++cb) *(f32x4*)(red + ((rb * 64 + lane) * 4 + cb) * 4) = tot[cb];
    }
    __syncthreads();
    if (kh == 0) {
#pragma unroll
        for (int cb = 0; cb < 4; ++cb) tot[cb] += *(const f32x4*)(red + ((rb * 64 + lane) * 4 + cb) * 4);
        const int row = MP + r0 + fr, col0 = ct * 64 + 4 * kq;
        if (kind == 8) {
            bf16_t* XB = (bf16_t*)(ws + WS_XB) + (size_t)row * DM + col0; const float* xi = xin_s ? xin_s + (size_t)(r0 + fr) * DM + col0 : nullptr;
            float ss = 0.f;
#pragma unroll
            for (int cb = 0; cb < 4; ++cb) {
                f32x4 x;
                if (xin_s) x = *(const f32x4*)(xi + cb * 16); else { const u32x2 v = *(const u32x2*)(XB + cb * 16); x = (f32x4){bf_lo(v.x), bf_hi(v.x), bf_lo(v.y), bf_hi(v.y)}; }
                x += tot[cb];
                u32x2 w; w.x = pk_bf16(x[0], x[1]); w.y = pk_bf16(x[2], x[3]); *(u32x2*)(XB + cb * 16) = w;
                const f32x4 y = (f32x4){bf_lo(w.x), bf_hi(w.x), bf_lo(w.y), bf_hi(w.y)};
                ss += (y[0] * y[0] + y[1] * y[1]) + (y[2] * y[2] + y[3] * y[3]);
            }
            ss += __shfl_xor(ss, 16); ss += __shfl_xor(ss, 32);
            if (kq == 0) ((float*)(ws + WS_SS))[(size_t)row * 16 + ct] = ss;
        } else if (kind == 0 || kind == 7) {
            const f32x4 s4 = *(const f32x4*)((const float*)(ws + WS_SS) + (size_t)row * 16 + kq * 4);
            float t = (s4[0] + s4[1]) + (s4[2] + s4[3]); t += __shfl_xor(t, 16); t += __shfl_xor(t, 32);
            const float r = __builtin_amdgcn_rsqf(t * (1.f / 1024.f) + EPS) * scale;
            bf16_t* Q = (kind == 0) ? (bf16_t*)(ws + WS_Q) + (size_t)row * DM + col0 : (bf16_t*)(ws + WS_Z) + (size_t)row * DFF + col0;
#pragma unroll
            for (int cb = 0; cb < 4; ++cb) {
                f32x4 v = tot[cb] * r;
                if (kind == 7) { v[0] = fmaxf(v[0], 0.f); v[1] = fmaxf(v[1], 0.f); v[2] = fmaxf(v[2], 0.f); v[3] = fmaxf(v[3], 0.f); v = v * v; }
                u32x2 w; w.x = pk_bf16(v[0], v[1]); w.y = pk_bf16(v[2], v[3]); *(u32x2*)(Q + cb * 16) = w; }
        } else {
            bf16_t* MG = (bf16_t*)(ws + WS_MG) + (size_t)row * DM + col0;
#pragma unroll
            for (int cb = 0; cb < 4; ++cb) { u32x2 w; w.x = pk_bf16(tot[cb][0], tot[cb][1]); w.y = pk_bf16(tot[cb][2], tot[cb][3]); *(u32x2*)(MG + cb * 16) = w; }
        }
    }
    __syncthreads();
}

#define XB_TMO      128
#define XB_XCNT(j)  (256  + 64 * (j))
#define XB_XSUB(j)  (1280 + 64 * (j))
#define XB_XGEN(j)  (2304 + 64 * (j))
#define XB_TOP      3328
#define XB_TOPGEN   3392
#define XCD_BAR_WORDS 3456
#define XB_SPIN_CAP (1u << 22)
DI unsigned xb_ld(unsigned* p)              { return __hip_atomic_load(p, __ATOMIC_RELAXED, __HIP_MEMORY_SCOPE_AGENT); }
DI unsigned xb_add(unsigned* p, unsigned v) { return __hip_atomic_fetch_add(p, v, __ATOMIC_RELAXED, __HIP_MEMORY_SCOPE_AGENT); }
DI unsigned xb_xcc_id() { return (unsigned)__builtin_amdgcn_s_getreg((3 << 11) | 20) & 0xFu; }
#define XB_SPIN(cond, bar) do { unsigned _sp = 0; while (cond) { __builtin_amdgcn_s_sleep(1); \
    if ((++_sp & 255u) == 0u) { if (xb_ld(&(bar)[XB_TMO])) break; if (_sp > XB_SPIN_CAP) { atomicAdd(&(bar)[XB_TMO], 1u); break; } } } } while (0)
struct XcdBarrier { unsigned* bar; unsigned x; volatile LAS unsigned* st; };
DI XcdBarrier xcd_barrier_post(unsigned* bar, volatile LAS unsigned* st) {
    XcdBarrier b; b.bar = bar; b.x = xb_xcc_id(); b.st = st;
    if (threadIdx.x == 0) (void)xb_add(&bar[XB_XCNT(b.x)], 1u);
    return b;
}
DI void xcd_barrier_complete(unsigned* bar, unsigned x, unsigned& nloc, unsigned& nx) {
    const unsigned G = gridDim.x * gridDim.y * gridDim.z;
    unsigned sum, cnt, mine, sp = 0u;
    for (;;) {
        sum = 0u; cnt = 0u; mine = 0u;
#pragma unroll
        for (unsigned j = 0; j < 16; ++j) { const unsigned c = xb_ld(&bar[XB_XCNT(j)]); sum += c; cnt += (c > 0u) ? 1u : 0u; mine = (j == x) ? c : mine; }
        if (sum == G) break;
        __builtin_amdgcn_s_sleep(1);
        if ((++sp & 255u) == 0u) { if (xb_ld(&bar[XB_TMO])) break; if (sp > XB_SPIN_CAP) { atomicAdd(&bar[XB_TMO], 1u); break; } }
    }
    nloc = mine > 0u ? mine : 1u; nx = cnt > 0u ? cnt : 1u;
}
DI void xcd_barrier(const XcdBarrier& b) {
    asm volatile("s_waitcnt vmcnt(0)" ::: "memory");
    __syncthreads();
    if (threadIdx.x == 0) {
        unsigned* bar = b.bar;
        __builtin_amdgcn_s_waitcnt(0);
        unsigned nloc = b.st[0], nx = b.st[1];
        if (nloc == 0u) { xcd_barrier_complete(bar, b.x, nloc, nx); b.st[0] = nloc; b.st[1] = nx; }
        const unsigned old = xb_add(&bar[XB_XSUB(b.x)], 1u);
        const unsigned gen = old / nloc;
        if (old + 1u == (gen + 1u) * nloc) {
            __builtin_amdgcn_fence(__ATOMIC_RELEASE, "agent");
            asm volatile("s_waitcnt vmcnt(0)" ::: "memory");
            const unsigned og = xb_add(&bar[XB_TOP], 1u);
            const unsigned tg = og / nx;
            if (og + 1u == (tg + 1u) * nx) xb_add(&bar[XB_TOPGEN], 1u);
            else XB_SPIN(xb_ld(&bar[XB_TOPGEN]) == tg, bar);
            __builtin_amdgcn_fence(__ATOMIC_ACQUIRE, "agent");
            xb_add(&bar[XB_XGEN(b.x)], 1u);
            asm volatile("s_waitcnt vmcnt(0)" ::: "memory");
        } else {
            XB_SPIN(xb_ld(&bar[XB_XGEN(b.x)]) == gen, bar);
            __builtin_amdgcn_fence(__ATOMIC_ACQUIRE, "agent");
            asm volatile("s_waitcnt vmcnt(0)" ::: "memory");
        }
    }
    __syncthreads();
}

__global__ void __launch_bounds__(512, 2) fwd_megakernel(Params p) {
    extern __shared__ __attribute__((aligned(16))) unsigned char lds[];
    cg::grid_group grid = cg::this_grid();
    const int G = gridDim.x;
    volatile LAS int* dsc = (volatile LAS int*)((LAS unsigned char*)lds + LDS_MISC + 2048);
    volatile LAS unsigned* bst = (volatile LAS unsigned*)((LAS unsigned char*)lds + LDS_MISC + 4096);
    if (threadIdx.x < 2) bst[threadIdx.x] = 0u;
    __syncthreads();
    const bool multi = (p.ph_hi - p.ph_lo) > 1;
    XcdBarrier xbar; xbar.bar = (unsigned*)(p.ws + WS_CTL); xbar.x = 0; xbar.st = bst;
    if (multi) xbar = xcd_barrier_post((unsigned*)(p.ws + WS_CTL), bst);
    for (int ph = p.ph_lo; ph < p.ph_hi; ++ph) {
        int is_gemm = 0, K = 1024;
        if (ph == 0) { int reps = PROBE_A ? 2 : 1; asm volatile("" : "+s"(reps)); for (int r = 0; r < reps; ++r) { if (EN_PRO) prologue(p, lds, G, r == 0 ? 7 : PROBE_A); __syncthreads(); } }
        else if (ph == NPH - 1) final_phase(p, G);
        else {
            const int l = (ph - 1) / 9, s = (ph - 1) % 9;
            if (s == 1) { int reps = PROBE_B ? 2 : 1; asm volatile("" : "+s"(reps)); for (int r = 0; r < reps; ++r) { if (EN_BR) branch_phase(p, l, lds, G, r == 0 ? 3 : PROBE_B); __syncthreads(); } }
            else if (s == 5) { int reps = PROBE_C ? 2 : 1; asm volatile("" : "+s"(reps)); for (int r = 0; r < reps; ++r) { if (EN_AT) attn_phase(p, l, lds, G, r == 0 ? 3 : PROBE_C); __syncthreads(); } }
            else {
                is_gemm = 1; K = (s == 2) ? 2048 : (s == 8) ? 4096 : 1024;
                if (threadIdx.x == 0) {
                    const float* X = (const float*)(ws_of(p) + WS_X);
                    int mode = 1, nN = 4, kind = 0, nkv = 0, ldz = 0; float scale = 1.f;
                    const void *A = nullptr, *B = nullptr, *xin_p = X, *xin_s = X + (size_t)MP * DM, *bias = nullptr, *Zout = nullptr;
                    switch (s) {
                        case 0: mode = 0; A = ws_of(p) + WS_XB; B = ws_of(p) + WS_WIN + (size_t)l * 16 * MiB; nkv = (l == 0) ? 128 : 0; Zout = ws_of(p) + WS_Z; ldz = ZP; bias = p.in[22] + (size_t)l * 4096; break;
                        case 2: mode = 2; A = ws_of(p) + WS_BR; B = ws_of(p) + WS_WB + (size_t)l * 4 * MiB; break;
                        case 3: kind = 8; A = ws_of(p) + WS_MG; B = ws_of(p) + WS_WMIX + (size_t)l * 2 * MiB; if (l == 0) { xin_p = p.in[0]; xin_s = p.in[1]; } break;
                        case 4: kind = 0; A = ws_of(p) + WS_XB; B = ws_of(p) + WS_WQ + (size_t)l * 2 * MiB; Zout = ws_of(p) + WS_Q; ldz = DM; scale = 0.0625f * LOG2E; break;
                        case 6: kind = 8; A = ws_of(p) + WS_O; B = ws_of(p) + WS_WO + (size_t)l * 2 * MiB; break;
                        case 7: kind = 7; nN = 16; A = ws_of(p) + WS_XB; B = ws_of(p) + WS_W1 + (size_t)l * 8 * MiB; Zout = ws_of(p) + WS_Z; ldz = DFF; break;
                        default: kind = 8; A = ws_of(p) + WS_Z; B = ws_of(p) + WS_W2 + (size_t)l * 8 * MiB; break;
                    }
                    dsc[0] = mode; dsc[1] = nN; dsc[2] = K; dsc[3] = kind; dsc[4] = nkv; dsc[5] = ldz; dsc[6] = __float_as_int(scale); dsc[7] = (s == 3 && l == 0) ? 1 : 0;
                    const unsigned long long pa[8] = {(unsigned long long)A, (unsigned long long)B, (unsigned long long)(ws_of(p) + WS_MB), (unsigned long long)(ws_of(p) + WS_WKV), (unsigned long long)xin_p, (unsigned long long)xin_s, (unsigned long long)bias, (unsigned long long)Zout};
#pragma unroll
                    for (int i = 0; i < 8; ++i) { dsc[8 + 2 * i] = (int)(unsigned)pa[i]; dsc[9 + 2 * i] = (int)(unsigned)(pa[i] >> 32); }
                }
                __syncthreads();
            }
        }
        int greps = 1; if (PROBE_G >= 0 && is_gemm && ((ph - 1) % 9) == PROBE_G) greps = 2; asm volatile("" : "+s"(greps));
        for (int gr = 0; gr < greps; ++gr)
        if (EN_GEMM && is_gemm) {
            pg8::SchedU S; S.d = (pg8::DescP)dsc; S.G = G; S.c = opaque_bid();
            pg8::EpiU E; E.d = (pg8::DescP)dsc; E.ws = ws_of(p); E.out = out_of(p);
            pg8::gemm_phase((LAS unsigned char*)lds, K, (ph - 1) % 9 == 2, S, E);
            const int l = (ph - 1) / 9, s = (ph - 1) % 9;
            if (s == 2 || s == 3 || s == 4 || s == 6 || s == 7 || s == 8) {
                unsigned char* ws = ws_of(p);
                int kind = 8; const bf16_t* A; const bf16_t* B; float scale = 1.f;
                const float* xin_s = (l == 0 && s == 3) ? p.in[1] : nullptr;
                if (s == 2) { kind = 9; A = (const bf16_t*)(ws + WS_BR) + (size_t)MP * 2048; B = (const bf16_t*)(ws + WS_WB + (size_t)l * 4 * MiB); }
                else if (s == 3) { A = (const bf16_t*)(ws + WS_MG) + (size_t)MP * DM; B = (const bf16_t*)(ws + WS_WMIX + (size_t)l * 2 * MiB); }
                else if (s == 4) { kind = 0; A = (const bf16_t*)(ws + WS_XB) + (size_t)MP * DM; B = (const bf16_t*)(ws + WS_WQ + (size_t)l * 2 * MiB); scale = 0.0625f * LOG2E; }
                else if (s == 6) { A = (const bf16_t*)(ws + WS_O) + (size_t)MP * DM; B = (const bf16_t*)(ws + WS_WO + (size_t)l * 2 * MiB); }
                else if (s == 7) { kind = 7; A = (const bf16_t*)(ws + WS_XB) + (size_t)MP * DM; B = (const bf16_t*)(ws + WS_W1 + (size_t)l * 8 * MiB); }
                else { A = (const bf16_t*)(ws + WS_Z) + (size_t)MP * DFF; B = (const bf16_t*)(ws + WS_W2 + (size_t)l * 8 * MiB); }
                const int nct = (s == 7) ? 64 : 16;
                for (int mu = opaque_bid(); mu < 16 * nct; mu += G) mini_unit(p, lds, kind, A, B, K, mu, nct, scale, xin_s);
            }
        }
        if (ph + 1 < p.ph_hi) {
            if (p.ph_lo < 0) grid.sync();
            else { int reps = 1 + PROBE_S; asm volatile("" : "+s"(reps)); for (int r = 0; r < reps; ++r) xcd_barrier(xbar); }
        }
    }
}

#ifndef MK_PER_PHASE
#define MK_PER_PHASE 0
#endif
extern "C" void kernel_launch(void* const* d_in, const int* in_sizes, int n_in, void* d_out, int out_size, void* d_ws, size_t ws_size, hipStream_t stream) {
    static int grid = 0;
    if (grid == 0) {
        if (n_in != 34 || out_size != (int)O_END || ws_size < WS_END) { fprintf(stderr, "kernel_launch: unexpected shapes: n_in %d out %d ws %zu\n", n_in, out_size, ws_size); grid = -1; return; }
        int dev = 0, cus = 0, per_cu = 0;
        (void)hipGetDevice(&dev); (void)hipDeviceGetAttribute(&cus, hipDeviceAttributeMultiprocessorCount, dev);
        if (hipFuncSetAttribute((const void*)fwd_megakernel, hipFuncAttributeMaxDynamicSharedMemorySize, LDS_BYTES) != hipSuccess) { fprintf(stderr, "kernel_launch: hipFuncSetAttribute failed\n"); grid = -1; return; }
        if (hipOccupancyMaxActiveBlocksPerMultiprocessor(&per_cu, (const void*)fwd_megakernel, 512, LDS_BYTES) != hipSuccess || per_cu < 1) { fprintf(stderr, "kernel_launch: occupancy query gave %d\n", per_cu); per_cu = 1; }
        (void)hipGetLastError();
        grid = cus * per_cu; if (grid > 256) grid = 256;
        if (grid <= 0) grid = 256;
    }
    if (grid < 0) return;
    Params p{};
    for (int i = 0; i < 34; ++i) p.in[i] = (const float*)d_in[i];
    p.out = (float*)d_out; p.ws = (unsigned char*)d_ws;
#if MK_PER_PHASE
    for (int ph = 0; ph < NPH; ++ph) { p.ph_lo = ph; p.ph_hi = ph + 1; hipLaunchKernelGGL(fwd_megakernel, dim3(grid), dim3(512), LDS_BYTES, stream, p); }
#else
    p.ph_lo = 0; p.ph_hi = NPH;
    (void)hipMemsetAsync((char*)d_ws + WS_CTL, 0, 65536, stream);
    void* args[] = {&p};
    hipError_t e = hipLaunchCooperativeKernel((const void*)fwd_megakernel, dim3(grid), dim3(512), args, LDS_BYTES, stream);
    if (e != hipSuccess) fprintf(stderr, "kernel_launch: cooperative launch failed: %s (grid %d)\n", hipGetErrorString(e), grid);
#endif
}
```

```cpp
#include <hip/hip_runtime.h>
#include <hip/hip_cooperative_groups.h>
#include <cstdio>
#include <cstdint>
namespace cg = cooperative_groups;
#ifndef PROBE_G
#define PROBE_G -1
#endif
#ifndef PROBE_C
#define PROBE_C 0
#endif
#ifndef PROBE_S
#define PROBE_S 0
#endif
#ifndef PROBE_A
#define PROBE_A 0
#endif
#ifndef PROBE_B
#define PROBE_B 0
#endif
#ifndef EN_SGU
#define EN_SGU 1
#endif
#ifndef EN_CP
#define EN_CP 1
#endif
#ifndef EN_CS
#define EN_CS 1
#endif
#ifndef EN_PRO
#define EN_PRO 1
#endif
#ifndef EN_BR
#define EN_BR 1
#endif
#ifndef EN_AT
#define EN_AT 1
#endif
#ifndef EN_GEMM
#define EN_GEMM 1
#endif

#define DI __device__ __forceinline__
#define LAS __attribute__((address_space(3)))
typedef unsigned short bf16_t;
typedef short bf16x8 __attribute__((ext_vector_type(8)));
typedef short s16x4 __attribute__((ext_vector_type(4)));
typedef float f32x4 __attribute__((ext_vector_type(4)));
typedef float f32x2 __attribute__((ext_vector_type(2)));
typedef unsigned u32x4 __attribute__((ext_vector_type(4)));
typedef unsigned u32x2 __attribute__((ext_vector_type(2)));
typedef __bf16 bf16x2_t __attribute__((ext_vector_type(2)));

constexpr int DM = 1024, MP = 16384, MS = 1024, MT = MP + MS, SEQ = 2048, NB = 8, NSB = 128, NSQ = 8, WBR = 512, ZP = 7168, DFF = 4096;
constexpr float EPS = 1e-6f;
constexpr float LOG2E = 1.4426950408889634f;
constexpr int NPH = 20;
constexpr size_t O_YP = 0, O_YS = 16777216, O_POOLP = 17825792, O_SCP = 17948672, O_CCP = 17965056, O_MK = 18210816, O_MV = 22405120,
                 O_POOLS = 26599424, O_SCS = 28565504, O_CCS = 28827648, O_SGUV = 32759808, O_END = 33808384;
constexpr size_t MiB = 1u << 20;
constexpr size_t WS_WIN = 0, WS_WB = 32 * MiB, WS_WMIX = 40 * MiB, WS_WQ = 44 * MiB, WS_WKV = 48 * MiB, WS_WO = 56 * MiB, WS_W1 = 60 * MiB, WS_W2 = 76 * MiB,
                 WS_SGUW = 92 * MiB, WS_SS = 93 * MiB, WS_SSM = 95 * MiB, WS_MB = 96 * MiB, WS_KP = 100 * MiB, WS_VTP = 108 * MiB, WS_X = 116 * MiB,
                 WS_XB = 184 * MiB, WS_MG = 218 * MiB, WS_Q = 252 * MiB, WS_O = 286 * MiB, WS_BR = 320 * MiB, WS_Z = 388 * MiB, WS_CTL = 627 * MiB, WS_END = 628 * MiB;
constexpr size_t BR_STRIDE = (size_t)MT * WBR * 2;
constexpr int LDS_BYTES = 147456, LDS_MISC = 139264;

DI unsigned pk_bf16(float lo, float hi) { f32x2 v = {lo, hi}; bf16x2_t b = __builtin_convertvector(v, bf16x2_t); return __builtin_bit_cast(unsigned, b); }
DI float bf_lo(unsigned v) { return __uint_as_float(v << 16); }
DI float bf_hi(unsigned v) { return __uint_as_float(v & 0xffff0000u); }
DI float sigmoidf_(float x) { return __builtin_amdgcn_rcpf(1.f + __builtin_amdgcn_exp2f(-x * LOG2E)); }
DI float gelu_tanh(float x) { const float u = 1.5957691216057308f * (x + 0.044715f * x * x * x); return x * sigmoidf_(u); }
DI float wave_sum(float v) {
#pragma unroll
    for (int o = 1; o < 64; o <<= 1) v += __shfl_xor(v, o);
    return v;
}
DI float wave_max(float v) {
#pragma unroll
    for (int o = 1; o < 64; o <<= 1) v = fmaxf(v, __shfl_xor(v, o));
    return v;
}

DI int opaque_tid() { int t = threadIdx.x; asm volatile("" : "+v"(t)); return t; }
DI int opaque_bid() { int b = blockIdx.x; asm volatile("" : "+s"(b)); return b; }
template <int N, int D> struct XReduce {
    static DI void run(float* v, int lane) {
        const bool up = (lane & D) != 0;
#pragma unroll
        for (int i = 0; i < N / 2; ++i) { const float send = up ? v[i] : v[i + N / 2], keep = up ? v[i + N / 2] : v[i]; v[i] = keep + __shfl_xor(send, D); }
        XReduce<N / 2, D / 2>::run(v, lane);
    }
};
template <int D> struct XReduce<1, D> {
    static DI void run(float* v, int lane) {
#pragma unroll
        for (int d = D; d >= 1; d >>= 1) v[0] += __shfl_xor(v[0], d);
    }
};
struct Params { const float* in[34]; float* out; unsigned char* ws; int ph_lo, ph_hi; };
DI unsigned char* ws_of(const Params& p) { unsigned char* w = p.ws; asm volatile("" : "+s"(w)); return w; }
DI float* out_of(const Params& p) { float* o = p.out; asm volatile("" : "+s"(o)); return o; }

namespace pg8 {
constexpr int BM = 256, BK = 64, HALF = 128, HTB = HALF * BK * 2, STAGE_BYTES = 8 * HTB;
DI int lds_byte(int r, int c) { const int st = (r >> 4) * 2 + (c >> 5), rr = r & 15, cc = c & 31, ob = rr * 64 + cc * 2; return st * 1024 + (ob ^ (((ob >> 9) & 1) << 5)); }
DI void stage_rc(int b, int& R, int& C) { const int st = b / 1024, sb = b % 1024, swz = sb ^ (((sb >> 9) & 1) << 5); R = (st >> 1) * 16 + swz / 64; C = (st & 1) * 32 + (swz % 64) / 2; }
DI int perm32(int rho) { const int n = rho >> 4, i = rho & 15; return 8 * (i >> 2) + 4 * n + (i & 3); }

struct Unit { int pm, pn, kind, zc; const char* a; const char* b; };

DI void tile_of(int L, int nM, int nN, int& pm, int& pn) {
    const int nwg = nM * nN; int wgid = L;
    { const int q = nwg / 8, r = nwg % 8, xcd = wgid % 8, off = wgid / 8; wgid = (xcd < r ? xcd * (q + 1) : r * (q + 1) + (xcd - r) * q) + off; }
    const int nig = 8 * nN, gid = wgid / nig, fm = gid * 8, gsz = (nM - fm) < 8 ? (nM - fm) : 8;
    pm = fm + ((wgid % nig) % gsz); pn = (wgid % nig) / gsz;
}

typedef const volatile LAS int* DescP;
DI int dsc_i(DescP d, int i) { return __builtin_amdgcn_readfirstlane(d[i]); }
DI const char* dsc_p(DescP d, int i) { const unsigned lo = (unsigned)__builtin_amdgcn_readfirstlane(d[i]), hi = (unsigned)__builtin_amdgcn_readfirstlane(d[i + 1]); return (const char*)(((unsigned long long)hi << 32) | lo); }
struct SchedU {
    DescP d; int G, c;
    DI bool next(int i, Unit& u) const {
        const int mode = dsc_i(d, 0); const char* A = dsc_p(d, 8); const char* B = dsc_p(d, 10);
        if (mode == 2) {
            const int ti = i * G + c; if (ti >= 64 * 4) return false;
            tile_of(ti, 64, 4, u.pm, u.pn); u.kind = 9; u.zc = 0;
            u.a = A + (size_t)u.pm * (256 * 2048 * 2); u.b = B + (size_t)u.pn * (256 * 2048 * 2); return true;
        }
        const int L = i * G + c;
        if (mode == 1) {
            const int nN = dsc_i(d, 1), K = dsc_i(d, 2);
            const int nM = 64;
            if (L >= nM * nN) return false;
            tile_of(L, nM, nN, u.pm, u.pn); u.kind = dsc_i(d, 3); u.zc = u.pn * 256;
            u.a = A + (size_t)u.pm * ((size_t)512 * K); u.b = B + (size_t)u.pn * ((size_t)512 * K); return true;
        }
        if (L < 68 * 32) {
            tile_of(L, 68, 32, u.pm, u.pn); u.a = A + (size_t)u.pm * (512 * 1024); u.b = B + (size_t)u.pn * (512 * 1024);
            const int pn = u.pn;
            if (pn < 2) { u.kind = 0; u.zc = pn * 256; }
            else if (pn < 6) { u.kind = 3; u.zc = 512 + (pn - 2) * 128; }
            else if (pn < 8) { u.kind = 0; u.zc = 1024 + (pn - 6) * 256; }
            else if (pn < 12) { u.kind = 1; u.zc = 1536 + (pn - 8) * 256; }
            else if (pn < 16) { u.kind = 4; u.zc = 2560 + (pn - 12) * 128; }
            else { u.kind = 2; u.zc = 3072 + (pn - 16) * 256; }
            return true;
        }
        const int j = L - 68 * 32; if (j >= dsc_i(d, 4)) return false;
        const int l = j >> 6, rem = j & 63; u.pm = rem >> 3; u.pn = rem & 7; u.kind = 5; u.zc = l;
        u.a = dsc_p(d, 12) + (size_t)u.pm * (512 * 1024); u.b = dsc_p(d, 14) + (size_t)l * (4 * MiB) + (size_t)u.pn * (512 * 1024); return true;
    }
};

struct EpiU {
    DescP d; unsigned char* ws; float* out;
    template <int ACT> DI void plain(const f32x4 (&acc)[2][2][4][2], const Unit& u, const float (&rs)[2][4], int rloc, int cloc) const {
        const float* bias = (const float*)dsc_p(d, 20); bf16_t* Zout = (bf16_t*)dsc_p(d, 22); const int ldz = dsc_i(d, 5);
        f32x4 bv[2][2];
#pragma unroll
        for (int bj = 0; bj < 2; ++bj)
#pragma unroll
            for (int n = 0; n < 2; ++n) bv[bj][n] = (ACT == 2) ? *(const f32x4*)(bias + (u.zc - 3072) + cloc + bj * 128 + 4 * n) : (f32x4){0.f, 0.f, 0.f, 0.f};
#pragma unroll
        for (int ai = 0; ai < 2; ++ai)
#pragma unroll
            for (int m = 0; m < 4; ++m) {
                const int row = u.pm * 256 + rloc + ai * 128 + m * 16; bf16_t* rowp = Zout + (size_t)row * ldz + u.zc + cloc; const float r = rs[ai][m];
#pragma unroll
                for (int bj = 0; bj < 2; ++bj) {
                    float v[8];
#pragma unroll
                    for (int n = 0; n < 2; ++n)
#pragma unroll
                        for (int j = 0; j < 4; ++j) {
                            float x = acc[ai][bj][m][n][j] * r;
                            if (ACT == 1) x = gelu_tanh(x);
                            if (ACT == 2) x = sigmoidf_(x + bv[bj][n][j]);
                            if (ACT == 7) { x = fmaxf(x, 0.f); x = x * x; }
                            v[n * 4 + j] = x;
                        }
                    u32x4 w; w.x = pk_bf16(v[0], v[1]); w.y = pk_bf16(v[2], v[3]); w.z = pk_bf16(v[4], v[5]); w.w = pk_bf16(v[6], v[7]);
                    *(u32x4*)(rowp + bj * 128) = w;
                }
            }
    }
    template <int ACT> DI void merge2(const f32x4 (&acc)[2][2][4][2], const Unit& u, const float (&rs)[2][4], int rloc, int cloc) const {
        bf16_t* Zout = (bf16_t*)dsc_p(d, 22); const int ldz = dsc_i(d, 5);
#pragma unroll
        for (int ai = 0; ai < 2; ++ai)
#pragma unroll
            for (int m = 0; m < 4; ++m) {
                const int row = u.pm * 256 + rloc + ai * 128 + m * 16; bf16_t* rowp = Zout + (size_t)row * ldz + u.zc + cloc; const float r = rs[ai][m];
                float v[8];
#pragma unroll
                for (int n = 0; n < 2; ++n)
#pragma unroll
                    for (int j = 0; j < 4; ++j) {
                        const float a = acc[ai][0][m][n][j] * r, b = acc[ai][1][m][n][j] * r;
                        v[n * 4 + j] = (ACT == 3) ? a * b : a * sigmoidf_(b);
                    }
                u32x4 w; w.x = pk_bf16(v[0], v[1]); w.y = pk_bf16(v[2], v[3]); w.z = pk_bf16(v[4], v[5]); w.w = pk_bf16(v[6], v[7]);
                *(u32x4*)rowp = w;
            }
    }
    static DI float gclamp(float g) { return fmaxf(g, 1e-20f); }
    DI void rescale(f32x4 (&acc)[2][2][4][2], const Unit& u, int k, int wr, int wc, int fr, int fq) const {
        int rloc = wr * 64 + fr, cloc = wc * 32 + 8 * fq;
        asm volatile("" : "+v"(rloc), "+v"(cloc));
        const bf16_t* Zg = (const bf16_t*)(ws + WS_Z) + 3072 + 1024 * (k - 1) + u.pn * 256 + cloc;
#pragma unroll
        for (int ai = 0; ai < 2; ++ai) {
            u32x4 gp_[4][2], gn_[4][2];
#pragma unroll
            for (int m = 0; m < 4; ++m) { const int row = u.pm * 256 + rloc + ai * 128 + m * 16; const bf16_t* gp = Zg + (size_t)row * ZP;
#pragma unroll
                for (int bj = 0; bj < 2; ++bj) { gp_[m][bj] = *(const u32x4*)(gp + bj * 128); gn_[m][bj] = *(const u32x4*)(gp + 1024 + bj * 128); } }
#pragma unroll
            for (int m = 0; m < 4; ++m) {
#pragma unroll
                for (int bj = 0; bj < 2; ++bj) {
                    const u32x4 a = gp_[m][bj], b = gn_[m][bj];
                    acc[ai][bj][m][0][0] *= gclamp(bf_lo(a.x)) * __builtin_amdgcn_rcpf(gclamp(bf_lo(b.x))); acc[ai][bj][m][0][1] *= gclamp(bf_hi(a.x)) * __builtin_amdgcn_rcpf(gclamp(bf_hi(b.x)));
                    acc[ai][bj][m][0][2] *= gclamp(bf_lo(a.y)) * __builtin_amdgcn_rcpf(gclamp(bf_lo(b.y))); acc[ai][bj][m][0][3] *= gclamp(bf_hi(a.y)) * __builtin_amdgcn_rcpf(gclamp(bf_hi(b.y)));
                    acc[ai][bj][m][1][0] *= gclamp(bf_lo(a.z)) * __builtin_amdgcn_rcpf(gclamp(bf_lo(b.z))); acc[ai][bj][m][1][1] *= gclamp(bf_hi(a.z)) * __builtin_amdgcn_rcpf(gclamp(bf_hi(b.z)));
                    acc[ai][bj][m][1][2] *= gclamp(bf_lo(a.w)) * __builtin_amdgcn_rcpf(gclamp(bf_lo(b.w))); acc[ai][bj][m][1][3] *= gclamp(bf_hi(a.w)) * __builtin_amdgcn_rcpf(gclamp(bf_hi(b.w)));
                }
            }
            asm volatile("" ::: "memory");
        }
    }
    DI void operator()(const f32x4 (&acc)[2][2][4][2], const Unit& u, int wr, int wc, int fr, int fq) const {
        const int kind = u.kind; int rloc = wr * 64 + fr, cloc = wc * 32 + 8 * fq;
        asm volatile("" : "+v"(rloc), "+v"(cloc));
        if (kind == 8) {
            const int xf32 = dsc_i(d, 7);
            const float* xin = (u.pm < 64) ? (const float*)dsc_p(d, 16) : (const float*)dsc_p(d, 18) - (size_t)MP * DM;
            bf16_t* XB = (bf16_t*)(ws + WS_XB); float* SS = (float*)(ws + WS_SS);
#pragma unroll
            for (int ai = 0; ai < 2; ++ai) {
                u32x4 xv[4][2];
                if (!xf32) {
#pragma unroll
                    for (int m = 0; m < 4; ++m) { const size_t off = (size_t)(u.pm * 256 + rloc + ai * 128 + m * 16) * DM + u.pn * 256 + cloc;
#pragma unroll
                        for (int bj = 0; bj < 2; ++bj) xv[m][bj] = *(const u32x4*)(XB + off + bj * 128); }
                }
#pragma unroll
                for (int m = 0; m < 4; ++m) {
                    const int row = u.pm * 256 + rloc + ai * 128 + m * 16; const size_t off = (size_t)row * DM + u.pn * 256 + cloc; float ss = 0.f;
#pragma unroll
                    for (int bj = 0; bj < 2; ++bj) {
                        f32x4 x0, x1;
                        if (xf32) { x0 = *(const f32x4*)(xin + off + bj * 128); x1 = *(const f32x4*)(xin + off + bj * 128 + 4); }
                        else { const u32x4 v = xv[m][bj]; x0 = (f32x4){bf_lo(v.x), bf_hi(v.x), bf_lo(v.y), bf_hi(v.y)}; x1 = (f32x4){bf_lo(v.z), bf_hi(v.z), bf_lo(v.w), bf_hi(v.w)}; }
                        x0 += acc[ai][bj][m][0]; x1 += acc[ai][bj][m][1];
                        u32x4 w; w.x = pk_bf16(x0[0], x0[1]); w.y = pk_bf16(x0[2], x0[3]); w.z = pk_bf16(x1[0], x1[1]); w.w = pk_bf16(x1[2], x1[3]);
                        *(u32x4*)(XB + off + bj * 128) = w;
                        const f32x4 y0 = (f32x4){bf_lo(w.x), bf_hi(w.x), bf_lo(w.y), bf_hi(w.y)}, y1 = (f32x4){bf_lo(w.z), bf_hi(w.z), bf_lo(w.w), bf_hi(w.w)};
                        ss += (y0[0] * y0[0] + y0[1] * y0[1]) + (y0[2] * y0[2] + y0[3] * y0[3]) + (y1[0] * y1[0] + y1[1] * y1[1]) + (y1[2] * y1[2] + y1[3] * y1[3]);
                    }
                    ss += __shfl_xor(ss, 16); ss += __shfl_xor(ss, 32);
                    if (fq == 0) SS[(size_t)row * 16 + u.pn * 4 + wc] = ss;
                    if (xf32 && (m & 1)) asm volatile("" ::: "memory");
                }
                asm volatile("" ::: "memory");
            }
            return;
        }
        if (kind == 9) {
            const bf16_t* Zg = (const bf16_t*)(ws + WS_Z) + 3072 + 1024 * 3 + u.pn * 256 + cloc; bf16_t* MG = (bf16_t*)(ws + WS_MG);
#pragma unroll
            for (int ai = 0; ai < 2; ++ai) {
                u32x4 g[4][2];
#pragma unroll
                for (int m = 0; m < 4; ++m) { const int row = u.pm * 256 + rloc + ai * 128 + m * 16; const bf16_t* gp = Zg + (size_t)row * ZP;
#pragma unroll
                    for (int bj = 0; bj < 2; ++bj) g[m][bj] = *(const u32x4*)(gp + bj * 128); }
#pragma unroll
                for (int m = 0; m < 4; ++m) {
                    const int row = u.pm * 256 + rloc + ai * 128 + m * 16; bf16_t* mp = MG + (size_t)row * DM + u.pn * 256 + cloc;
#pragma unroll
                    for (int bj = 0; bj < 2; ++bj) {
                        const u32x4 gg = g[m][bj]; const f32x4 a0 = acc[ai][bj][m][0], a1 = acc[ai][bj][m][1]; u32x4 w;
                        w.x = pk_bf16(gclamp(bf_lo(gg.x)) * a0[0], gclamp(bf_hi(gg.x)) * a0[1]); w.y = pk_bf16(gclamp(bf_lo(gg.y)) * a0[2], gclamp(bf_hi(gg.y)) * a0[3]);
                        w.z = pk_bf16(gclamp(bf_lo(gg.z)) * a1[0], gclamp(bf_hi(gg.z)) * a1[1]); w.w = pk_bf16(gclamp(bf_lo(gg.w)) * a1[2], gclamp(bf_hi(gg.w)) * a1[3]);
                        *(u32x4*)(mp + bj * 128) = w;
                    }
                }
                asm volatile("" ::: "memory");
            }
            return;
        }
        if (kind == 5) {
            const float* SSM = (const float*)(ws + WS_SSM); const int l = u.zc, b = u.pm;
#pragma unroll
            for (int ai = 0; ai < 2; ++ai)
#pragma unroll
                for (int m = 0; m < 4; ++m) {
                    const int key = rloc + ai * 128 + m * 16, row = b * 256 + key; const float r = __builtin_amdgcn_rsqf(SSM[row] * (1.f / 1024.f) + EPS);
#pragma unroll
                    for (int bj = 0; bj < 2; ++bj) {
                        const int col = u.pn * 256 + bj * 128 + cloc;
                        const f32x4 v0 = acc[ai][bj][m][0] * r, v1 = acc[ai][bj][m][1] * r;
                        float* op = out + (col < 1024 ? O_MK : O_MV) + (size_t)l * 2097152 + (size_t)row * 1024 + (col & 1023);
                        *(f32x4*)op = v0; *(f32x4*)(op + 4) = v1;
                        const int h = (col & 1023) >> 8, d = col & 255; const size_t hb = ((size_t)(l * 8 + b) * 4 + h) * 65536;
                        if (col < 1024) {
                            u32x4 w; w.x = pk_bf16(v0[0], v0[1]); w.y = pk_bf16(v0[2], v0[3]); w.z = pk_bf16(v1[0], v1[1]); w.w = pk_bf16(v1[2], v1[3]);
                            *(u32x4*)((bf16_t*)(ws + WS_KP) + hb + (size_t)key * 256 + d) = w;
                        } else {
                            bf16_t* vt = (bf16_t*)(ws + WS_VTP) + hb + (size_t)d * 256 + key;
#pragma unroll
                            for (int j = 0; j < 4; ++j) { vt[j * 256] = (bf16_t)(pk_bf16(v0[j], 0.f) & 0xffffu); vt[(4 + j) * 256] = (bf16_t)(pk_bf16(v1[j], 0.f) & 0xffffu); }
                        }
                    }
                    asm volatile("" ::: "memory");
                }
            return;
        }
        float rs[2][4]; const float* SS = (const float*)(ws + WS_SS); const float scale = __int_as_float(dsc_i(d, 6));
#pragma unroll
        for (int ai = 0; ai < 2; ++ai)
#pragma unroll
            for (int m = 0; m < 4; ++m) {
                const f32x4 s4 = *(const f32x4*)(SS + (size_t)(u.pm * 256 + rloc + ai * 128 + m * 16) * 16 + fq * 4);
                float t = (s4[0] + s4[1]) + (s4[2] + s4[3]); t += __shfl_xor(t, 16); t += __shfl_xor(t, 32);
                rs[ai][m] = __builtin_amdgcn_rsqf(t * (1.f / 1024.f) + EPS) * scale;
            }
        switch (kind) {
            case 0: plain<0>(acc, u, rs, rloc, cloc); break;
            case 1: plain<1>(acc, u, rs, rloc, cloc); break;
            case 2: plain<2>(acc, u, rs, rloc, cloc); break;
            case 7: plain<7>(acc, u, rs, rloc, cloc); break;
            case 3: merge2<3>(acc, u, rs, rloc, cloc); break;
            default: merge2<4>(acc, u, rs, rloc, cloc); break;
        }
    }
};

DI void gemm_phase(LAS unsigned char* lds, const int K, const bool hook, const SchedU& S, const EpiU& E) {
    const int tid = opaque_tid(), wid = __builtin_amdgcn_readfirstlane(tid >> 6), lane = tid & 63, wr = wid >> 2, wc = wid & 3, fr = lane & 15, fq = lane >> 4;
    const int nt = K / BK;
    unsigned voffA[2], voffB[2];
#pragma unroll
    for (int i = 0; i < 2; ++i) { int R, C; stage_rc(tid * 16 + i * 8192, R, C); const int Rb = (R & ~31) + perm32(R & 31);
        voffA[i] = (unsigned)(R * K + C) * 2u; voffB[i] = (unsigned)(Rb * K + C) * 2u; }
    const size_t kstep = (size_t)(BK * 2);
    const size_t hstep = (size_t)HALF * K * 2;
    const unsigned ldsw = (unsigned)wid * 1024u;
    const int aoff = lds_byte(wr * 64 + fr, fq * 8), boff = lds_byte(wc * 32 + fr, fq * 8);
#define PG8_SA(b, h) (((b) * 2 + (h)) * HTB)
#define PG8_SB(b, h) ((4 + (b) * 2 + (h)) * HTB)
#define PG8_STAGE(bufoff, gbase, voff) do { _Pragma("unroll") for (int _i = 0; _i < 2; ++_i) \
        __builtin_amdgcn_global_load_lds((const unsigned*)((const char*)(gbase) + (voff)[_i]), (LAS unsigned*)(lds + (bufoff) + ldsw + _i * 8192), 16, 0, 0); } while (0)
#define PG8_LDA(dst, b, h) do { _Pragma("unroll") for (int m = 0; m < 4; ++m) _Pragma("unroll") for (int k = 0; k < 2; ++k) dst[m][k] = *(const LAS bf16x8*)(lds + PG8_SA(b, h) + aoff + m * 2048 + k * 1024); } while (0)
#define PG8_LDB(dst, b, h) do { _Pragma("unroll") for (int n = 0; n < 2; ++n) _Pragma("unroll") for (int k = 0; k < 2; ++k) dst[n][k] = *(const LAS bf16x8*)(lds + PG8_SB(b, h) + boff + n * 2048 + k * 1024); } while (0)
#define PG8_MMA(ai, bj, At, Bt) do { __builtin_amdgcn_s_setprio(1); _Pragma("unroll") for (int m = 0; m < 4; ++m) _Pragma("unroll") for (int n = 0; n < 2; ++n) _Pragma("unroll") for (int k = 0; k < 2; ++k) \
        acc[ai][bj][m][n] = __builtin_amdgcn_mfma_f32_16x16x32_bf16(Bt[n][k], At[m][k], acc[ai][bj][m][n], 0, 0, 0); __builtin_amdgcn_s_setprio(0); } while (0)
#define PG8_WAIT_V(n) asm volatile("s_waitcnt vmcnt(" #n ")" ::: "memory")
#define PG8_WAIT_L(n) asm volatile("s_waitcnt lgkmcnt(" #n ")" ::: "memory")
#define PG8_BAR __builtin_amdgcn_s_barrier()
#define PG8_SCHED __builtin_amdgcn_sched_barrier(0)
    Unit cur, nxt; int ui = 0;
    if (!S.next(0, cur)) return;
    f32x4 acc[2][2][4][2];
#pragma unroll
    for (int a = 0; a < 2; ++a)
#pragma unroll
        for (int b = 0; b < 2; ++b)
#pragma unroll
            for (int m = 0; m < 4; ++m)
#pragma unroll
                for (int n = 0; n < 2; ++n) acc[a][b][m][n] = (f32x4){0.f, 0.f, 0.f, 0.f};
    bf16x8 At[4][2], B0[2][2], B1[2][2];
    const char* cA = cur.a; const char* cB = cur.b;
    PG8_STAGE(PG8_SB(0, 0), cB, voffB); PG8_STAGE(PG8_SB(0, 1), cB + hstep, voffB); PG8_STAGE(PG8_SA(0, 0), cA, voffA); PG8_STAGE(PG8_SA(0, 1), cA + hstep, voffA);
    if (wr == 1) PG8_BAR;
    PG8_WAIT_V(2); PG8_BAR;
    PG8_STAGE(PG8_SB(1, 0), cB + kstep, voffB); PG8_STAGE(PG8_SA(1, 0), cA + kstep, voffA); PG8_STAGE(PG8_SB(1, 1), cB + hstep + kstep, voffB);
    PG8_WAIT_V(6); PG8_BAR;
    for (;;) {
        const bool has_next = S.next(ui + 1, nxt);
        const char* nA = has_next ? nxt.a : cA; const char* nB = has_next ? nxt.b : cB;
        for (int t = 0; t < nt; t += 2) {
            const bool last = (t == nt - 2);
            if (hook && t != 0 && (t & 7) == 0) E.rescale(acc, cur, t >> 3, wr, wc, fr, fq);
            asm volatile("" : "+v"(voffA[0]), "+v"(voffA[1]), "+v"(voffB[0]), "+v"(voffB[1]));
            const char* a1 = cA + (size_t)(t + 1) * kstep;
            const char* a2 = last ? nA : cA + (size_t)(t + 2) * kstep; const char* b2 = last ? nB : cB + (size_t)(t + 2) * kstep;
            const char* a3 = a2 + kstep; const char* b3 = b2 + kstep;
            PG8_LDB(B0, 0, 0); PG8_LDB(B1, 0, 1); PG8_SCHED; PG8_LDA(At, 0, 0); PG8_STAGE(PG8_SA(1, 1), a1 + hstep, voffA);
            PG8_WAIT_V(8); PG8_WAIT_L(0); PG8_BAR; PG8_MMA(0, 0, At, B0); PG8_MMA(0, 1, At, B1); PG8_BAR; PG8_SCHED;
            PG8_LDA(At, 0, 1); PG8_STAGE(PG8_SB(0, 0), b2, voffB); PG8_STAGE(PG8_SB(0, 1), b2 + hstep, voffB); PG8_STAGE(PG8_SA(0, 0), a2, voffA);
            PG8_WAIT_V(8); PG8_WAIT_L(0); PG8_BAR; PG8_MMA(1, 0, At, B0); PG8_MMA(1, 1, At, B1); PG8_BAR; PG8_SCHED;
            PG8_LDB(B0, 1, 0); PG8_LDB(B1, 1, 1); PG8_SCHED; PG8_LDA(At, 1, 0); PG8_STAGE(PG8_SA(0, 1), a2 + hstep, voffA);
            PG8_WAIT_V(8); PG8_WAIT_L(0); PG8_BAR; PG8_MMA(0, 0, At, B0); PG8_MMA(0, 1, At, B1); PG8_BAR; PG8_SCHED;
            PG8_LDA(At, 1, 1); PG8_STAGE(PG8_SB(1, 0), b3, voffB); PG8_STAGE(PG8_SB(1, 1), b3 + hstep, voffB); PG8_STAGE(PG8_SA(1, 0), a3, voffA);
            PG8_WAIT_V(8); PG8_WAIT_L(0); PG8_BAR; PG8_MMA(1, 0, At, B0); PG8_MMA(1, 1, At, B1); PG8_BAR; PG8_SCHED;
        }
        if (wr == 0) PG8_BAR;
        E(acc, cur, wr, wc, fr, fq);
        if (!has_next) break;
#pragma unroll
        for (int a = 0; a < 2; ++a)
#pragma unroll
            for (int b = 0; b < 2; ++b)
#pragma unroll
                for (int m = 0; m < 4; ++m)
#pragma unroll
                    for (int n = 0; n < 2; ++n) acc[a][b][m][n] = (f32x4){0.f, 0.f, 0.f, 0.f};
        cur = nxt; cA = nA; cB = nB; ++ui;
        if (wr == 1) PG8_BAR;
    }
    PG8_WAIT_V(0);
    PG8_BAR;
#undef PG8_SA
#undef PG8_SB
#undef PG8_STAGE
#undef PG8_LDA
#undef PG8_LDB
#undef PG8_MMA
#undef PG8_WAIT_V
#undef PG8_WAIT_L
#undef PG8_BAR
#undef PG8_SCHED
}
}

DI void transpose_item(const float* W, int K, int N, bf16_t* WT, int pitch, int k0, int n0, int drow0, const float* gk, float* scr, int lane) {
#pragma unroll
    for (int i = 0; i < 32; ++i) { const int kk = 2 * i + (lane >> 5); float v = W[(size_t)(k0 + kk) * N + n0 + (lane & 31)]; if (gk) v *= gk[k0 + kk]; scr[kk * 33 + (lane & 31)] = v; }
    asm volatile("s_waitcnt lgkmcnt(0)" ::: "memory");
    const int c = lane & 7;
#pragma unroll
    for (int j = 0; j < 4; ++j) { const int n = (lane >> 3) + 8 * j; const float* s = scr + (8 * c) * 33 + n;
        u32x4 o; o.x = pk_bf16(s[0 * 33], s[1 * 33]); o.y = pk_bf16(s[2 * 33], s[3 * 33]); o.z = pk_bf16(s[4 * 33], s[5 * 33]); o.w = pk_bf16(s[6 * 33], s[7 * 33]);
        *(u32x4*)(WT + (size_t)(drow0 + n) * pitch + k0 + 8 * c) = o; }
    asm volatile("s_waitcnt lgkmcnt(0)" ::: "memory");
}
DI int win_block_map(int sb) {
    if (sb < 4) return sb;
    if (sb < 8) return 4 + 2 * (sb - 4);
    if (sb < 12) return 12 + (sb - 8);
    if (sb < 16) return 5 + 2 * (sb - 12);
    if (sb < 24) return sb;
    if (sb < 28) return 24 + 2 * (sb - 24);
    if (sb < 32) return 25 + 2 * (sb - 28);
    return sb;
}
DI float row_to_bf16(const float* xrow, bf16_t* orow, int lane) {
    const f32x4* xr = (const f32x4*)xrow + lane; float s = 0.f; f32x4 v[4];
#pragma unroll
    for (int j = 0; j < 4; ++j) { v[j] = xr[64 * j]; s += (v[j].x * v[j].x + v[j].y * v[j].y) + (v[j].z * v[j].z + v[j].w * v[j].w); }
    u32x2* o = (u32x2*)orow + lane;
#pragma unroll
    for (int j = 0; j < 4; ++j) { u32x2 w; w.x = pk_bf16(v[j].x, v[j].y); w.y = pk_bf16(v[j].z, v[j].w); o[64 * j] = w; }
    return wave_sum(s);
}

DI void prologue(const Params& p, unsigned char* lds, int G, int mask) {
    const int tid = opaque_tid(), lane = tid & 63, wave = __builtin_amdgcn_readfirstlane(tid >> 6);
    float* scr = (float*)(lds + wave * 16384);
    const int gw = opaque_bid() * 8 + wave, NGW = G * 8;
    unsigned char* ws = ws_of(p);
    {
        constexpr int T_IN = 16 * 64, T_BR = 8 * 8, T_SQ = 16 * 8, T_F1 = 16 * 32, T_F2 = 64 * 8;
        constexpr int T_L = T_IN + 3 * T_BR + 5 * T_SQ + T_F1 + T_F2;
        unsigned* Tl = (unsigned*)lds;
        const int lr = tid >> 5, lc = (tid & 31) * 4;
        f32x4 cur[4], nxt[4]; const float* gk_c = nullptr; const float* gk_n = nullptr;
        bf16_t* WT_c = nullptr; bf16_t* WT_n = nullptr; int pitch_c = 0, pitch_n = 0, k0_c = 0, k0_n = 0, dr_c = 0, dr_n = 0;
#define TR_SETUP(it_, W_, N_, WT_, pitch_, gk_, k0_, n0_, dr_) do { \
            const int l_ = (it_) / T_L; int r_ = (it_) % T_L; bool is_in_ = false; int K_; (gk_) = nullptr; (pitch_) = 0; \
            if (r_ < T_IN) { W_ = p.in[9] + (size_t)l_ * 1024 * 8192; K_ = 1024; N_ = 8192; WT_ = (bf16_t*)(ws + WS_WIN) + (size_t)l_ * 8192 * 1024; gk_ = p.in[8] + l_ * 1024; is_in_ = true; } \
            else if ((r_ -= T_IN) < 3 * T_BR) { const int k_ = 1 + r_ / T_BR; r_ %= T_BR; W_ = p.in[21] + ((size_t)l_ * 4 + k_) * 512 * 1024; K_ = 512; N_ = 1024; WT_ = (bf16_t*)(ws + WS_WB) + (size_t)l_ * 2097152 + k_ * 512; pitch_ = 2048; } \
            else if ((r_ -= 3 * T_BR) < 5 * T_SQ) { const int w_ = r_ / T_SQ; r_ %= T_SQ; K_ = 1024; N_ = 1024; \
                if (w_ == 0) { W_ = p.in[23] + (size_t)l_ * 1048576; WT_ = (bf16_t*)(ws + WS_WMIX) + (size_t)l_ * 1048576; } \
                else if (w_ == 1) { W_ = p.in[26] + (size_t)l_ * 1048576; WT_ = (bf16_t*)(ws + WS_WQ) + (size_t)l_ * 1048576; gk_ = p.in[24] + l_ * 1024; } \
                else if (w_ == 2) { W_ = p.in[27] + (size_t)l_ * 1048576; WT_ = (bf16_t*)(ws + WS_WKV) + (size_t)l_ * 2097152; gk_ = p.in[25] + l_ * 1024; } \
                else if (w_ == 3) { W_ = p.in[28] + (size_t)l_ * 1048576; WT_ = (bf16_t*)(ws + WS_WKV) + (size_t)l_ * 2097152 + 1048576; gk_ = p.in[25] + l_ * 1024; } \
                else { W_ = p.in[29] + (size_t)l_ * 1048576; WT_ = (bf16_t*)(ws + WS_WO) + (size_t)l_ * 1048576; } } \
            else if ((r_ -= 5 * T_SQ) < T_F1) { W_ = p.in[31] + (size_t)l_ * 4194304; K_ = 1024; N_ = 4096; WT_ = (bf16_t*)(ws + WS_W1) + (size_t)l_ * 4194304; gk_ = p.in[30] + l_ * 1024; } \
            else { r_ -= T_F1; W_ = p.in[32] + (size_t)l_ * 4194304; K_ = 4096; N_ = 1024; WT_ = (bf16_t*)(ws + WS_W2) + (size_t)l_ * 4194304; } \
            if (!(pitch_)) (pitch_) = K_; \
            const int nblk_ = N_ / 128; (k0_) = 64 * (r_ / nblk_); (n0_) = 128 * (r_ % nblk_); (dr_) = is_in_ ? win_block_map((n0_) >> 7) * 128 : (n0_); } while (0)
        int it = opaque_bid();
        if ((mask & 1) && it < 2 * T_L) {
            { const float* W; int N, n0; TR_SETUP(it, W, N, WT_c, pitch_c, gk_c, k0_c, n0, dr_c);
#pragma unroll
              for (int i = 0; i < 4; ++i) cur[i] = *(const f32x4*)(W + (size_t)(k0_c + lr + 16 * i) * N + n0 + lc); }
            for (; it < 2 * T_L; it += G) {
                const int itn = it + G; const bool has_n = itn < 2 * T_L;
                if (has_n) { const float* W; int N, n0; TR_SETUP(itn, W, N, WT_n, pitch_n, gk_n, k0_n, n0, dr_n);
#pragma unroll
                    for (int i = 0; i < 4; ++i) nxt[i] = *(const f32x4*)(W + (size_t)(k0_n + lr + 16 * i) * N + n0 + lc); }
                unsigned short* Th = (unsigned short*)Tl;
#pragma unroll
                for (int i = 0; i < 4; ++i) {
                    const int kk = lr + 16 * i; const float g = gk_c ? gk_c[k0_c + kk] : 1.f; const f32x4 v = cur[i] * g;
#pragma unroll
                    for (int j = 0; j < 4; ++j) Th[(lc + j) * 66 + kk] = (unsigned short)(pk_bf16(v[j], 0.f) & 0xffffu);
                }
                __syncthreads();
#pragma unroll
                for (int q = 0; q < 2; ++q) {
                    const int idx = tid + 512 * q, n = idx >> 3, c = idx & 7; const unsigned* src = Tl + n * 33 + c * 4;
                    u32x4 o; o.x = src[0]; o.y = src[1]; o.z = src[2]; o.w = src[3];
                    *(u32x4*)(WT_c + (size_t)(dr_c + n) * pitch_c + k0_c + 8 * c) = o;
                }
                __syncthreads();
#pragma unroll
                for (int i = 0; i < 4; ++i) cur[i] = nxt[i];
                gk_c = gk_n; WT_c = WT_n; pitch_c = pitch_n; k0_c = k0_n; dr_c = dr_n;
            }
        }
#undef TR_SETUP
        __syncthreads();
    }
    if (mask & 2)
    for (int it = opaque_bid(); it < 2 * 4 * 32; it += G) {
        const int l = it >> 7, g = (it >> 5) & 3, db = it & 31;
        float* pwT = (float*)lds;
        __syncthreads();
        {
            const float* pw = p.in[10] + ((size_t)l * 4 + g) * 16384; const float* sc = p.in[11] + l * 512 + g * 128;
#pragma unroll 8
            for (int e = tid; e < 16384; e += 512) { const int i = e >> 7, j = e & 127; pwT[j * 132 + i] = pw[e] * sc[j]; }
        }
        __syncthreads();
        const int d = db * 32 + (tid & 31), i0 = (tid >> 5) * 8;
        const float* wb = p.in[21] + ((size_t)l * 4) * 512 * 1024 + (size_t)(g * 128) * 1024 + d;
        float a[8];
#pragma unroll
        for (int r = 0; r < 8; ++r) a[r] = 0.f;
#pragma unroll 16
        for (int j = 0; j < 128; ++j) {
            const float w = wb[(size_t)j * 1024];
            const f32x4 p0 = *(const f32x4*)(pwT + j * 132 + i0), p1 = *(const f32x4*)(pwT + j * 132 + i0 + 4);
            a[0] += p0[0] * w; a[1] += p0[1] * w; a[2] += p0[2] * w; a[3] += p0[3] * w; a[4] += p1[0] * w; a[5] += p1[1] * w; a[6] += p1[2] * w; a[7] += p1[3] * w;
        }
        bf16_t* o = (bf16_t*)(ws + WS_WB) + (size_t)l * 2097152 + (size_t)d * 2048 + g * 128 + i0;
        u32x4 w0; w0.x = pk_bf16(a[0], a[1]); w0.y = pk_bf16(a[2], a[3]); w0.z = pk_bf16(a[4], a[5]); w0.w = pk_bf16(a[6], a[7]);
        *(u32x4*)o = w0;
    }
    __syncthreads();
    if (mask & 4) {
    for (int e = opaque_bid() * 512 + tid; e < 2 * 4 * 128 * 128; e += G * 512) {
        const int t = (e >> 7) & 127, s = e & 127; const float v = (s <= t) ? p.in[15][e] : 0.f;
        ((bf16_t*)(ws + WS_SGUW))[e] = (bf16_t)(pk_bf16(v, 0.f) & 0xffffu);
    }
    float* SS = (float*)(ws + WS_SS);
    for (int m0 = gw; m0 < MT; m0 += 2 * NGW) {
        const int m1 = m0 + NGW; const bool two = m1 < MT;
        const float* x0 = (m0 < MP) ? p.in[0] + (size_t)m0 * DM : p.in[1] + (size_t)(m0 - MP) * DM;
        const float* x1 = two ? ((m1 < MP) ? p.in[0] + (size_t)m1 * DM : p.in[1] + (size_t)(m1 - MP) * DM) : x0;
        f32x4 v0[4], v1[4];
#pragma unroll
        for (int j = 0; j < 4; ++j) { v0[j] = ((const f32x4*)x0)[lane + 64 * j]; v1[j] = ((const f32x4*)x1)[lane + 64 * j]; }
        float s0 = 0.f, s1 = 0.f;
#pragma unroll
        for (int j = 0; j < 4; ++j) { s0 += (v0[j].x * v0[j].x + v0[j].y * v0[j].y) + (v0[j].z * v0[j].z + v0[j].w * v0[j].w); s1 += (v1[j].x * v1[j].x + v1[j].y * v1[j].y) + (v1[j].z * v1[j].z + v1[j].w * v1[j].w); }
        u32x2* o0 = (u32x2*)((bf16_t*)(ws + WS_XB) + (size_t)m0 * DM) + lane;
#pragma unroll
        for (int j = 0; j < 4; ++j) { u32x2 w; w.x = pk_bf16(v0[j].x, v0[j].y); w.y = pk_bf16(v0[j].z, v0[j].w); o0[64 * j] = w; }
        s0 = wave_sum(s0);
        if (lane < 16) SS[(size_t)m0 * 16 + lane] = (lane == 0) ? s0 : 0.f;
        if (two) {
            u32x2* o1 = (u32x2*)((bf16_t*)(ws + WS_XB) + (size_t)m1 * DM) + lane;
#pragma unroll
            for (int j = 0; j < 4; ++j) { u32x2 w; w.x = pk_bf16(v1[j].x, v1[j].y); w.y = pk_bf16(v1[j].z, v1[j].w); o1[64 * j] = w; }
            s1 = wave_sum(s1);
            if (lane < 16) SS[(size_t)m1 * 16 + lane] = (lane == 0) ? s1 : 0.f;
        }
    }
    for (int m = gw; m < 2048; m += NGW) {
        const float s = row_to_bf16(p.in[7] + (size_t)m * DM, (bf16_t*)(ws + WS_MB) + (size_t)m * DM, lane);
        if (lane == 0) ((float*)(ws + WS_SSM))[m] = s;
    }
    }
}

template <bool SAMPLE, int NROWS>
DI void stage_rows(float* tile, int hist, const float* state, const bf16_t* Zcol, int rowbase, int tt0, float* outp, int ncarry, bool write_carry, int tid) {
    constexpr int ITER = (NROWS * 64 + 511) / 512;
    u32x4 vb[ITER]; f32x4 slo[ITER], shi[ITER];
#pragma unroll
    for (int i = 0; i < ITER; ++i) {
        const int c = tid + 512 * i, k = c >> 6, cc = (c & 63) * 8;
        vb[i] = (u32x4){0u, 0u, 0u, 0u}; slo[i] = (f32x4){0.f, 0.f, 0.f, 0.f}; shi[i] = (f32x4){0.f, 0.f, 0.f, 0.f};
        if (c < NROWS * 64) {
            if (SAMPLE) {
                if (k < hist) { slo[i] = *(const f32x4*)(state + (size_t)k * WBR + cc); shi[i] = *(const f32x4*)(state + (size_t)k * WBR + cc + 4); }
                else vb[i] = *(const u32x4*)(Zcol + (size_t)(rowbase + k - hist) * ZP + cc);
            } else {
                const int t = tt0 - hist + k;
                if (t >= 0) vb[i] = *(const u32x4*)(Zcol + (size_t)(rowbase + t) * ZP + cc);
            }
        }
    }
#pragma unroll
    for (int i = 0; i < ITER; ++i) {
        const int c = tid + 512 * i, k = c >> 6, cc = (c & 63) * 8;
        if (c < NROWS * 64) {
            f32x4 lo, hi; int ci;
            const u32x4 v = vb[i];
            lo = (f32x4){bf_lo(v.x), bf_hi(v.x), bf_lo(v.y), bf_hi(v.y)}; hi = (f32x4){bf_lo(v.z), bf_hi(v.z), bf_lo(v.w), bf_hi(v.w)};
            if (SAMPLE) { if (k < hist) { lo = slo[i]; hi = shi[i]; } ci = k - (NROWS - ncarry); }
            else ci = (tt0 - hist + k) - (SEQ - ncarry);
            *(f32x4*)(tile + k * WBR + cc) = lo; *(f32x4*)(tile + k * WBR + cc + 4) = hi;
            if (write_carry && ci >= 0) { *(f32x4*)(outp + (size_t)ci * WBR + cc) = lo; *(f32x4*)(outp + (size_t)ci * WBR + cc + 4) = hi; }
        }
    }
}
template <int NT, int W> DI void pool_compute(const float* tile, int ch, int tt0, bool sample, float (&o)[NT]) {
    float e[NT + 15];
#pragma unroll
    for (int k = 0; k < NT + 15; ++k) e[k] = tile[k * WBR + ch];
#pragma unroll
    for (int j = 0; j < NT; ++j) {
        float s = 0.f;
#pragma unroll
        for (int i = 0; i < W; ++i) s += e[j + 15 - i];
        const int pos = tt0 + j; const float inv = (sample || pos + 1 >= W) ? 1.f / (float)W : 1.f / (float)(pos + 1);
        o[j] = s * inv - e[j + 15];
    }
}
struct ConvConst { float cw[31]; float cb, lng, lnb, sw0, sw1, sw2, sg, sb; };
template <int NT, bool SAMPLE>
DI void conv_item(const Params& p, int l, int b, int tt0, const ConvConst& cc, float* tile, float* red, int tid, int lane, int wave) {
    const bf16_t* Z = (const bf16_t*)(ws_of(p) + WS_Z); const int ch = tid;
    const int rowbase = SAMPLE ? MP + b * NSQ : b * SEQ; const int row0 = SAMPLE ? rowbase : rowbase + tt0;
    const bool lastp = SAMPLE || (tt0 + NT == SEQ);
    stage_rows<SAMPLE, NT + 15>(tile, 15, SAMPLE ? p.in[2] + ((size_t)l * NSB + b) * 15 * WBR : nullptr, Z, rowbase, tt0,
                       SAMPLE ? out_of(p) + O_POOLS + ((size_t)l * NSB + b) * 15 * WBR : out_of(p) + O_POOLP + ((size_t)l * NB + b) * 15 * WBR, 15, lastp, tid);
    __syncthreads();
    {
        float o[NT];
        switch (wave >> 1) {
            case 0: pool_compute<NT, 2>(tile, ch, tt0, SAMPLE, o); break;
            case 1: pool_compute<NT, 4>(tile, ch, tt0, SAMPLE, o); break;
            case 2: pool_compute<NT, 8>(tile, ch, tt0, SAMPLE, o); break;
            default: pool_compute<NT, 16>(tile, ch, tt0, SAMPLE, o); break;
        }
        bf16_t* BR0 = (bf16_t*)(ws_of(p) + WS_BR) + (size_t)row0 * 2048 + ch;
#pragma unroll
        for (int j = 0; j < NT; ++j) BR0[j * 2048] = (bf16_t)(pk_bf16(o[j], 0.f) & 0xffffu);
    }
    __syncthreads();
    stage_rows<SAMPLE, NT + 2>(tile, 2, SAMPLE ? p.in[3] + ((size_t)l * NSB + b) * 2 * WBR : nullptr, Z + 512, rowbase, tt0,
                       SAMPLE ? out_of(p) + O_SCS + ((size_t)l * NSB + b) * 2 * WBR : out_of(p) + O_SCP + ((size_t)l * NB + b) * 2 * WBR, 2, lastp, tid);
    stage_rows<false, NT>(tile + (NT + 2) * WBR, 0, nullptr, Z + 1024, row0, 0, nullptr, 0, false, tid);
    __syncthreads();
    {
        bf16_t* BR1 = (bf16_t*)(ws_of(p) + WS_BR) + (size_t)row0 * 2048 + 512 + ch;
#pragma unroll
        for (int j = 0; j < NT; ++j) {
            const float c = cc.sw0 * tile[j * WBR + ch] + cc.sw1 * tile[(j + 1) * WBR + ch] + cc.sw2 * tile[(j + 2) * WBR + ch];
            BR1[j * 2048] = (bf16_t)(pk_bf16(tile[(NT + 2 + j) * WBR + ch] * c, 0.f) & 0xffffu);
        }
    }
    __syncthreads();
    stage_rows<SAMPLE, NT + 30>(tile, 30, SAMPLE ? p.in[4] + ((size_t)l * NSB + b) * 30 * WBR : nullptr, Z + 2560, rowbase, tt0,
                       SAMPLE ? out_of(p) + O_CCS + ((size_t)l * NSB + b) * 30 * WBR : out_of(p) + O_CCP + ((size_t)l * NB + b) * 30 * WBR, 30, lastp, tid);
    __syncthreads();
    float a[NT];
#pragma unroll
    for (int j = 0; j < NT; ++j) a[j] = cc.cb;
#pragma unroll
    for (int k = 0; k < NT + 30; ++k) {
        const float v = tile[k * WBR + ch];
#pragma unroll
        for (int j = 0; j < NT; ++j) { const int tap = k - j; if (tap >= 0 && tap <= 30) a[j] += cc.cw[tap] * v; }
    }
#pragma unroll
    for (int j = 0; j < NT; ++j) {
        const float s1 = wave_sum(a[j]), s2 = wave_sum(a[j] * a[j]);
        if (lane == 0) { red[(wave * NT + j) * 2] = s1; red[(wave * NT + j) * 2 + 1] = s2; }
    }
    __syncthreads();
    {
        bf16_t* BR3 = (bf16_t*)(ws_of(p) + WS_BR) + (size_t)row0 * 2048 + 1536 + ch;
#pragma unroll
        for (int j = 0; j < NT; ++j) {
            float s1 = 0.f, s2 = 0.f;
#pragma unroll
            for (int w = 0; w < 8; ++w) { s1 += red[(w * NT + j) * 2]; s2 += red[(w * NT + j) * 2 + 1]; }
            const float mean = s1 * (1.f / 512.f), var = fmaxf(s2 * (1.f / 512.f) - mean * mean, 0.f), rstd = __builtin_amdgcn_rsqf(var + EPS);
            const float y = (a[j] - mean) * rstd * cc.lng + cc.lnb;
            BR3[j * 2048] = (bf16_t)(pk_bf16(y * sigmoidf_(y), 0.f) & 0xffffu);
        }
    }
    __syncthreads();
    if (SAMPLE) {
        stage_rows<false, NT>(tile, 0, nullptr, Z + 2048, row0, 0, nullptr, 0, false, tid);
        stage_rows<false, NT>(tile + NT * WBR, 0, nullptr, Z + 1536, row0, 0, nullptr, 0, false, tid);
        __syncthreads();
        float v[NT];
#pragma unroll
        for (int j = 0; j < NT; ++j) {
            v[j] = tile[j * WBR + ch];
            const float s1 = wave_sum(v[j]), s2 = wave_sum(v[j] * v[j]);
            if (lane == 0) { red[(wave * NT + j) * 2] = s1; red[(wave * NT + j) * 2 + 1] = s2; }
        }
        __syncthreads();
        float* ov = out_of(p) + O_SGUV + (((size_t)l * NSB + b) * NSQ) * WBR + ch;
#pragma unroll
        for (int j = 0; j < NT; ++j) {
            float s1 = 0.f, s2 = 0.f;
#pragma unroll
            for (int w = 0; w < 8; ++w) { s1 += red[(w * NT + j) * 2]; s2 += red[(w * NT + j) * 2 + 1]; }
            const float mean = s1 * (1.f / 512.f), var = fmaxf(s2 * (1.f / 512.f) - mean * mean, 0.f), rstd = __builtin_amdgcn_rsqf(var + EPS);
            v[j] = (v[j] - mean) * rstd * cc.sg + cc.sb;
            ov[j * WBR] = v[j];
        }
        const int g = wave >> 1;
        const float* Wg = p.in[15] + ((size_t)l * 4 + g) * 128 * 128; const float* bs = p.in[16] + ((size_t)l * 4 + g) * 128;
        bf16_t* BR2 = (bf16_t*)(ws_of(p) + WS_BR) + (size_t)row0 * 2048 + 1024 + ch;
#pragma unroll
        for (int t = 0; t < NT; ++t) {
            float s0 = bs[t];
#pragma unroll
            for (int s = 0; s <= t; ++s) s0 += Wg[t * 128 + s] * v[s];
            BR2[t * 2048] = (bf16_t)(pk_bf16(tile[(NT + t) * WBR + ch] * s0, 0.f) & 0xffffu);
        }
        __syncthreads();
    }
}

DI float ldh(const bf16_t* t, int idx) { return __uint_as_float((unsigned)t[idx] << 16); }
template <int W> DI void pool_compute_h(const bf16_t* tile, int ch, int tt0, float (&o)[16]) {
    float e[31];
#pragma unroll
    for (int k = 0; k < 31; ++k) e[k] = ldh(tile, k * WBR + ch);
#pragma unroll
    for (int j = 0; j < 16; ++j) {
        float s = 0.f;
#pragma unroll
        for (int i = 0; i < W; ++i) s += e[j + 15 - i];
        const int pos = tt0 + j; const float inv = (pos + 1 >= W) ? 1.f / (float)W : 1.f / (float)(pos + 1);
        o[j] = s * inv - e[j + 15];
    }
}
DI void conv_item_p(const Params& p, int l, int b, int tt0, const ConvConst& cc, unsigned char* lds, float* red, int tid, int lane, int wave) {
    constexpr int NT = 16, RA = 0, RB = 31, RBB = 49, RD = 65, NR = 111;
    const bf16_t* Z = (const bf16_t*)(ws_of(p) + WS_Z); const int ch = tid;
    const int rowbase = b * SEQ, row0 = rowbase + tt0; const bool lastp = (tt0 + NT == SEQ);
    bf16_t* tile = (bf16_t*)lds;
    {
        constexpr int ITER = (NR * 64 + 511) / 512, HB = ITER / 2;
#pragma unroll 1
        for (int h = 0; h < 2; ++h) {
            u32x4 vb[HB];
#pragma unroll
            for (int i = 0; i < HB; ++i) {
                const int c = tid + 512 * (h * HB + i), r = c >> 6, cc8 = (c & 63) * 8; vb[i] = (u32x4){0u, 0u, 0u, 0u};
                if (c < NR * 64) {
                    int hist, col, kk;
                    if (r < RB) { hist = 15; col = 0; kk = r; } else if (r < RBB) { hist = 2; col = 512; kk = r - RB; } else if (r < RD) { hist = 0; col = 1024; kk = r - RBB; } else { hist = 30; col = 2560; kk = r - RD; }
                    const int t = tt0 - hist + kk;
                    if (t >= 0) vb[i] = *(const u32x4*)(Z + (size_t)(rowbase + t) * ZP + col + cc8);
                }
            }
#pragma unroll
            for (int i = 0; i < HB; ++i) {
                const int c = tid + 512 * (h * HB + i), r = c >> 6, cc8 = (c & 63) * 8;
                if (c < NR * 64) *(u32x4*)(tile + r * WBR + cc8) = vb[i];
            }
        }
    }
    __syncthreads();
    if (lastp) {
#pragma unroll 1
        for (int c = tid; c < NR * 64; c += 512) {
            const int r = c >> 6, cc8 = (c & 63) * 8;
            if (r < RBB || r >= RD) {
                int hist, kk, nc; size_t ob;
                if (r < RB) { hist = 15; kk = r; nc = 15; ob = O_POOLP + ((size_t)l * NB + b) * 15 * WBR; }
                else if (r < RBB) { hist = 2; kk = r - RB; nc = 2; ob = O_SCP + ((size_t)l * NB + b) * 2 * WBR; }
                else { hist = 30; kk = r - RD; nc = 30; ob = O_CCP + ((size_t)l * NB + b) * 30 * WBR; }
                const int ci = (tt0 - hist + kk) - (SEQ - nc);
                if (ci >= 0) { const u32x4 v = *(const u32x4*)(tile + r * WBR + cc8); float* o = out_of(p) + ob + (size_t)ci * WBR + cc8;
                    *(f32x4*)o = (f32x4){bf_lo(v.x), bf_hi(v.x), bf_lo(v.y), bf_hi(v.y)}; *(f32x4*)(o + 4) = (f32x4){bf_lo(v.z), bf_hi(v.z), bf_lo(v.w), bf_hi(v.w)}; }
            }
        }
    }
    float oA[NT], oB[NT];
    switch (wave >> 1) {
        case 0: pool_compute_h<2>(tile + RA * WBR, ch, tt0, oA); break;
        case 1: pool_compute_h<4>(tile + RA * WBR, ch, tt0, oA); break;
        case 2: pool_compute_h<8>(tile + RA * WBR, ch, tt0, oA); break;
        default: pool_compute_h<16>(tile + RA * WBR, ch, tt0, oA); break;
    }
    {
        const bf16_t* tb = tile + RB * WBR; const bf16_t* tbb = tile + RBB * WBR;
#pragma unroll
        for (int j = 0; j < NT; ++j) {
            const float c = cc.sw0 * ldh(tb, j * WBR + ch) + cc.sw1 * ldh(tb, (j + 1) * WBR + ch) + cc.sw2 * ldh(tb, (j + 2) * WBR + ch);
            oB[j] = ldh(tbb, j * WBR + ch) * c;
        }
    }
    float a[NT];
#pragma unroll
    for (int j = 0; j < NT; ++j) a[j] = cc.cb;
    {
        const bf16_t* td = tile + RD * WBR;
#pragma unroll
        for (int k = 0; k < NT + 30; ++k) {
            const float v = ldh(td, k * WBR + ch);
#pragma unroll
            for (int j = 0; j < NT; ++j) { const int tap = k - j; if (tap >= 0 && tap <= 30) a[j] += cc.cw[tap] * v; }
        }
    }
    {
        float v[2 * NT];
#pragma unroll
        for (int j = 0; j < NT; ++j) { v[2 * j] = a[j]; v[2 * j + 1] = a[j] * a[j]; }
        XReduce<2 * NT, 32>::run(v, lane);
        const int idx = lane >> 1;
        if ((lane & 1) == 0) red[((idx >> 1) * 8 + wave) * 2 + (idx & 1)] = v[0];
    }
    __syncthreads();
#pragma unroll
    for (int j = 0; j < NT; ++j) {
        const f32x4* rp = (const f32x4*)(red + j * 16); const f32x4 r0 = rp[0], r1 = rp[1], r2 = rp[2], r3 = rp[3];
        const float s1 = (r0[0] + r0[2]) + (r1[0] + r1[2]) + (r2[0] + r2[2]) + (r3[0] + r3[2]), s2 = (r0[1] + r0[3]) + (r1[1] + r1[3]) + (r2[1] + r2[3]) + (r3[1] + r3[3]);
        const float mean = s1 * (1.f / 512.f), var = fmaxf(s2 * (1.f / 512.f) - mean * mean, 0.f), rstd = __builtin_amdgcn_rsqf(var + EPS);
        const float y = (a[j] - mean) * rstd * cc.lng + cc.lnb;
        tile[(0 * NT + j) * WBR + ch] = (bf16_t)(pk_bf16(oA[j], 0.f) & 0xffffu);
        tile[(1 * NT + j) * WBR + ch] = (bf16_t)(pk_bf16(oB[j], 0.f) & 0xffffu);
        tile[(2 * NT + j) * WBR + ch] = (bf16_t)(pk_bf16(y * sigmoidf_(y), 0.f) & 0xffffu);
    }
    __syncthreads();
    {
        bf16_t* BRb = (bf16_t*)(ws_of(p) + WS_BR) + (size_t)row0 * 2048;
#pragma unroll
        for (int q = 0; q < 6; ++q) {
            const int idx = tid + 512 * q, br = idx >> 10, j = (idx >> 6) & 15, c8 = (idx & 63) * 8;
            const u32x4 v = *(const u32x4*)(tile + (br * NT + j) * WBR + c8);
            *(u32x4*)(BRb + (size_t)j * 2048 + (br == 2 ? 1536 : br * 512) + c8) = v;
        }
    }
    __syncthreads();
}

DI void sgu_item(const Params& p, int l, int it, unsigned char* lds) {
    const int tid = opaque_tid(), lane = tid & 63, wave = __builtin_amdgcn_readfirstlane(tid >> 6);
    const int g = it & 3, chunk = (it >> 2) & 15, b = it >> 6;
    const int rowbase = b * SEQ + chunk * 128;
    const bf16_t* Z = (const bf16_t*)(ws_of(p) + WS_Z);
    bf16_t* vnT = (bf16_t*)lds;
    float* Sb = (float*)(lds + 36864);
    {
        u32x4 v[16];
#pragma unroll
        for (int r = 0; r < 16; ++r) v[r] = *(const u32x4*)(Z + (size_t)(rowbase + wave * 16 + r) * ZP + 2048 + lane * 8);
        float s1[16], s2[16];
#pragma unroll
        for (int r = 0; r < 16; ++r) {
            const float x[8] = {bf_lo(v[r].x), bf_hi(v[r].x), bf_lo(v[r].y), bf_hi(v[r].y), bf_lo(v[r].z), bf_hi(v[r].z), bf_lo(v[r].w), bf_hi(v[r].w)};
            float a = 0.f, q = 0.f;
#pragma unroll
            for (int i = 0; i < 8; ++i) { a += x[i]; q += x[i] * x[i]; }
            s1[r] = a; s2[r] = q;
        }
        {
            float vv[32];
#pragma unroll
            for (int r = 0; r < 16; ++r) { vv[2 * r] = s1[r]; vv[2 * r + 1] = s2[r]; }
            XReduce<32, 32>::run(vv, lane);
            float* sb = (float*)(lds + LDS_MISC + 1024) + wave * 32;
            if ((lane & 1) == 0) sb[lane >> 1] = vv[0];
            asm volatile("s_waitcnt lgkmcnt(0)" ::: "memory");
#pragma unroll
            for (int r = 0; r < 16; ++r) { s1[r] = sb[2 * r]; s2[r] = sb[2 * r + 1]; }
            asm volatile("" ::: "memory");
        }
        if ((lane >> 4) == g) {
            const int c0 = (lane & 15) * 8;
            const f32x4 gA = *(const f32x4*)(p.in[13] + l * WBR + lane * 8), gB = *(const f32x4*)(p.in[13] + l * WBR + lane * 8 + 4);
            const f32x4 bA = *(const f32x4*)(p.in[14] + l * WBR + lane * 8), bB = *(const f32x4*)(p.in[14] + l * WBR + lane * 8 + 4);
            const float gg[8] = {gA.x, gA.y, gA.z, gA.w, gB.x, gB.y, gB.z, gB.w}, bb[8] = {bA.x, bA.y, bA.z, bA.w, bB.x, bB.y, bB.z, bB.w};
#pragma unroll
            for (int r = 0; r < 16; ++r) {
                const int s = wave * 16 + r;
                const float mean = s1[r] * (1.f / 512.f), var = fmaxf(s2[r] * (1.f / 512.f) - mean * mean, 0.f), rstd = __builtin_amdgcn_rsqf(var + EPS);
                const float x[8] = {bf_lo(v[r].x), bf_hi(v[r].x), bf_lo(v[r].y), bf_hi(v[r].y), bf_lo(v[r].z), bf_hi(v[r].z), bf_lo(v[r].w), bf_hi(v[r].w)};
#pragma unroll
                for (int i = 0; i < 8; ++i) { const float y = (x[i] - mean) * rstd * gg[i] + bb[i]; vnT[(c0 + i) * 136 + s] = (bf16_t)(pk_bf16(y, 0.f) & 0xffffu); }
            }
        }
    }
    __syncthreads();
    {
        const int fr = lane & 15, kq = lane >> 4;
        f32x4 acc[8];
#pragma unroll
        for (int cb = 0; cb < 8; ++cb) acc[cb] = (f32x4){0.f, 0.f, 0.f, 0.f};
        const bf16_t* Wt = (const bf16_t*)(ws_of(p) + WS_SGUW) + ((size_t)l * 4 + g) * 16384 + (size_t)(wave * 16 + fr) * 128 + kq * 8;
        const int nks = (wave >> 1) + 1;
        for (int ks = 0; ks < nks; ++ks) {
            const bf16x8 a = *(const bf16x8*)(Wt + ks * 32);
#pragma unroll
            for (int cb = 0; cb < 8; ++cb) {
                const bf16x8 bfr = *(const bf16x8*)(vnT + (cb * 16 + fr) * 136 + ks * 32 + kq * 8);
                acc[cb] = __builtin_amdgcn_mfma_f32_16x16x32_bf16(a, bfr, acc[cb], 0, 0, 0);
            }
        }
        const float* bs = p.in[16] + ((size_t)l * 4 + g) * 128;
#pragma unroll
        for (int j = 0; j < 4; ++j) {
            const int t = wave * 16 + kq * 4 + j; const float bt = bs[t];
#pragma unroll
            for (int cb = 0; cb < 8; ++cb) Sb[t * 132 + cb * 16 + fr] = acc[cb][j] + bt;
        }
    }
    __syncthreads();
    {
        bf16_t* BR2 = (bf16_t*)(ws_of(p) + WS_BR) + 1024 + g * 128;
        u32x4 cu[4];
#pragma unroll
        for (int q = 0; q < 4; ++q) { const int idx = tid + 512 * q, t = idx >> 4, c8 = (idx & 15) * 8; cu[q] = *(const u32x4*)(Z + (size_t)(rowbase + t) * ZP + 1536 + g * 128 + c8); }
#pragma unroll
        for (int q = 0; q < 4; ++q) {
            const int idx = tid + 512 * q, t = idx >> 4, c8 = (idx & 15) * 8;
            const f32x4 sa = *(const f32x4*)(Sb + t * 132 + c8), sb = *(const f32x4*)(Sb + t * 132 + c8 + 4); const u32x4 u = cu[q]; u32x4 w;
            w.x = pk_bf16(bf_lo(u.x) * sa[0], bf_hi(u.x) * sa[1]); w.y = pk_bf16(bf_lo(u.y) * sa[2], bf_hi(u.y) * sa[3]);
            w.z = pk_bf16(bf_lo(u.z) * sb[0], bf_hi(u.z) * sb[1]); w.w = pk_bf16(bf_lo(u.w) * sb[2], bf_hi(u.w) * sb[3]);
            *(u32x4*)(BR2 + (size_t)(rowbase + t) * 2048 + c8) = w;
        }
    }
    __syncthreads();
}

DI void branch_phase(const Params& p, int l, unsigned char* lds, int G, int mask) {
    const int tid = opaque_tid(), lane = tid & 63, wave = __builtin_amdgcn_readfirstlane(tid >> 6);
    float* red = (float*)(lds + LDS_MISC); float* tile = (float*)lds;
    if (mask & 1) {
        const int bid = opaque_bid();
        if (G == 256) {
            if (bid < 128) { if (EN_SGU) sgu_item(p, l, bid * 4, lds); }
            else for (int k = 0; k < 3; ++k) { if (EN_SGU) sgu_item(p, l, (bid - 128) * 4 + 1 + k, lds); }
        } else for (int it = bid; it < 512; it += G) { if (EN_SGU) sgu_item(p, l, it, lds); }
    }
    if (!(mask & 2)) return;
    ConvConst cc;
#pragma unroll
    for (int t = 0; t < 31; ++t) cc.cw[t] = p.in[17][((size_t)l * 31 + t) * WBR + tid];
    cc.cb = p.in[18][l * WBR + tid]; cc.lng = p.in[19][l * WBR + tid]; cc.lnb = p.in[20][l * WBR + tid];
    cc.sw0 = p.in[12][(size_t)l * 3 * WBR + tid]; cc.sw1 = p.in[12][(size_t)l * 3 * WBR + WBR + tid]; cc.sw2 = p.in[12][(size_t)l * 3 * WBR + 2 * WBR + tid];
    cc.sg = p.in[13][l * WBR + tid]; cc.sb = p.in[14][l * WBR + tid];
    if (G == 256) {
        const int bid = opaque_bid();
        for (int k = 0; k < 4; ++k) { const int it = bid * 4 + k; if (EN_CP) conv_item_p(p, l, it >> 7, (it & 127) * 16, cc, lds, red, tid, lane, wave); }
        if (bid < 128) { if (EN_CS) conv_item<8, true>(p, l, bid, 0, cc, tile, red, tid, lane, wave); }
    } else
    for (int it = opaque_bid(); it < 1152; it += G) {
        if (it < 1024) { if (EN_CP) conv_item_p(p, l, it >> 7, (it & 127) * 16, cc, lds, red, tid, lane, wave); }
        else { if (EN_CS) conv_item<8, true>(p, l, it - 1024, 0, cc, tile, red, tid, lane, wave); }
    }
}

constexpr int KPITCH = 264;
DI void attn_prompt_unit(const Params& p, int l, int u, unsigned char* lds) {
    const int tid = opaque_tid(), lane = tid & 63, wave = tid >> 6, fr = lane & 15, kq = lane >> 4;
    const int b = u >> 6, h = (u >> 4) & 3, qb = u & 15;
    const size_t hb = ((size_t)(l * 8 + b) * 4 + h) * 65536;
    const bf16_t* Kg = (const bf16_t*)(ws_of(p) + WS_KP) + hb; const bf16_t* Vg = (const bf16_t*)(ws_of(p) + WS_VTP) + hb;
    bf16_t* img = (bf16_t*)lds;
    const int qrow = b * SEQ + qb * 128 + wave * 16 + fr;
    const bf16_t* Qg = (const bf16_t*)(ws_of(p) + WS_Q) + (size_t)qrow * DM + h * 256 + kq * 8;
    bf16x8 qf[8];
#pragma unroll
    for (int ks = 0; ks < 8; ++ks) qf[ks] = *(const bf16x8*)(Qg + ks * 32);
    {
        u32x4 st[16];
#pragma unroll
        for (int i = 0; i < 16; ++i) { const int c = tid + 512 * i, r = c >> 5, c16 = c & 31; st[i] = *(const u32x4*)(Kg + r * 256 + c16 * 8); }
#pragma unroll
        for (int i = 0; i < 16; ++i) { const int c = tid + 512 * i, r = c >> 5, c16 = c & 31; *(u32x4*)(img + r * KPITCH + c16 * 8) = st[i]; }
    }
    __syncthreads();
    f32x4 s[16];
#pragma unroll
    for (int kb = 0; kb < 16; kb += 2) {
        bf16x8 kf0[8], kf1[8];
#pragma unroll
        for (int ks = 0; ks < 8; ++ks) { kf0[ks] = *(const bf16x8*)(img + (kb * 16 + fr) * KPITCH + ks * 32 + kq * 8); kf1[ks] = *(const bf16x8*)(img + ((kb + 1) * 16 + fr) * KPITCH + ks * 32 + kq * 8); }
        s[kb] = (f32x4){0.f, 0.f, 0.f, 0.f}; s[kb + 1] = (f32x4){0.f, 0.f, 0.f, 0.f};
#pragma unroll
        for (int ks = 0; ks < 8; ++ks) {
            s[kb] = __builtin_amdgcn_mfma_f32_16x16x32_bf16(kf0[ks], qf[ks], s[kb], 0, 0, 0);
            s[kb + 1] = __builtin_amdgcn_mfma_f32_16x16x32_bf16(kf1[ks], qf[ks], s[kb + 1], 0, 0, 0);
        }
    }
    u32x4 vst[16];
#pragma unroll
    for (int i = 0; i < 16; ++i) { const int c = tid + 512 * i, r = c >> 5, c16 = c & 31; vst[i] = *(const u32x4*)(Vg + r * 256 + c16 * 8); }
    float mx = -INFINITY;
#pragma unroll
    for (int kb = 0; kb < 16; ++kb) mx = fmaxf(fmaxf(fmaxf(mx, s[kb][0]), fmaxf(s[kb][1], s[kb][2])), s[kb][3]);
    mx = fmaxf(mx, __shfl_xor(mx, 16)); mx = fmaxf(mx, __shfl_xor(mx, 32));
    float sum = 0.f;
#pragma unroll
    for (int kb = 0; kb < 16; ++kb)
#pragma unroll
        for (int j = 0; j < 4; ++j) { const float e = __builtin_amdgcn_exp2f(s[kb][j] - mx); s[kb][j] = e; sum += e; }
    sum += __shfl_xor(sum, 16); sum += __shfl_xor(sum, 32);
    const float inv = __builtin_amdgcn_rcpf(sum);
    bf16x8 pb[8];
#pragma unroll
    for (int k2 = 0; k2 < 8; ++k2) {
        u32x4 w; w.x = pk_bf16(s[2 * k2][0], s[2 * k2][1]); w.y = pk_bf16(s[2 * k2][2], s[2 * k2][3]); w.z = pk_bf16(s[2 * k2 + 1][0], s[2 * k2 + 1][1]); w.w = pk_bf16(s[2 * k2 + 1][2], s[2 * k2 + 1][3]);
        pb[k2] = __builtin_bit_cast(bf16x8, w);
    }
    __syncthreads();
#pragma unroll
    for (int i = 0; i < 16; ++i) { const int c = tid + 512 * i, r = c >> 5, c16 = c & 31; *(u32x4*)(img + r * KPITCH + c16 * 8) = vst[i]; }
    __syncthreads();
    bf16_t* Og = (bf16_t*)(ws_of(p) + WS_O) + (size_t)qrow * DM + h * 256 + kq * 4;
#pragma unroll 2
    for (int db = 0; db < 16; db += 2) {
        f32x4 o0 = (f32x4){0.f, 0.f, 0.f, 0.f}, o1 = (f32x4){0.f, 0.f, 0.f, 0.f};
        bf16x8 vf0[8], vf1[8];
#pragma unroll
        for (int k2 = 0; k2 < 8; ++k2) {
            const bf16_t* vp = img + (db * 16 + fr) * KPITCH + k2 * 32 + kq * 4;
            const s16x4 lo = *(const s16x4*)vp, hi = *(const s16x4*)(vp + 16), lo1 = *(const s16x4*)(vp + 16 * KPITCH), hi1 = *(const s16x4*)(vp + 16 * KPITCH + 16);
            vf0[k2] = (bf16x8){lo[0], lo[1], lo[2], lo[3], hi[0], hi[1], hi[2], hi[3]};
            vf1[k2] = (bf16x8){lo1[0], lo1[1], lo1[2], lo1[3], hi1[0], hi1[1], hi1[2], hi1[3]};
        }
#pragma unroll
        for (int k2 = 0; k2 < 8; ++k2) {
            o0 = __builtin_amdgcn_mfma_f32_16x16x32_bf16(vf0[k2], pb[k2], o0, 0, 0, 0);
            o1 = __builtin_amdgcn_mfma_f32_16x16x32_bf16(vf1[k2], pb[k2], o1, 0, 0, 0);
        }
        u32x2 w; w.x = pk_bf16(o0[0] * inv, o0[1] * inv); w.y = pk_bf16(o0[2] * inv, o0[3] * inv);
        *(u32x2*)(Og + db * 16) = w;
        w.x = pk_bf16(o1[0] * inv, o1[1] * inv); w.y = pk_bf16(o1[2] * inv, o1[3] * inv);
        *(u32x2*)(Og + db * 16 + 16) = w;
    }
    __syncthreads();
}

DI void attn_sample_item(const Params& p, int l, int it, unsigned char* lds) {
    const int tid = opaque_tid(), lane = tid & 63, wave = tid >> 6, fr = lane & 15, kq = lane >> 4;
    const int b = it >> 2, h = it & 3;
    const float* Kc = p.in[5] + (((size_t)l * NSB + b) * 256) * 1024 + h * 256;
    const float* Vc = p.in[6] + (((size_t)l * NSB + b) * 256) * 1024 + h * 256;
    float* sS = (float*)lds;
    float* red = (float*)(lds + 8192);
    const int qrow = MP + b * NSQ + (fr & 7);
    const bf16_t* Qg = (const bf16_t*)(ws_of(p) + WS_Q) + (size_t)qrow * DM + h * 256 + kq * 8;
    bf16x8 qf[8];
#pragma unroll
    for (int ks = 0; ks < 8; ++ks) { qf[ks] = *(const bf16x8*)(Qg + ks * 32); if (fr >= 8) qf[ks] = (bf16x8){0, 0, 0, 0, 0, 0, 0, 0}; }
#pragma unroll
    for (int kb = 0; kb < 2; ++kb) {
        const float* kp = Kc + (size_t)(wave * 32 + kb * 16 + fr) * 1024 + kq * 8;
        f32x4 ka[8], kbv[8];
#pragma unroll
        for (int ks = 0; ks < 8; ++ks) { ka[ks] = *(const f32x4*)(kp + ks * 32); kbv[ks] = *(const f32x4*)(kp + ks * 32 + 4); }
        f32x4 s = (f32x4){0.f, 0.f, 0.f, 0.f};
#pragma unroll
        for (int ks = 0; ks < 8; ++ks) {
            u32x4 w; w.x = pk_bf16(ka[ks][0], ka[ks][1]); w.y = pk_bf16(ka[ks][2], ka[ks][3]); w.z = pk_bf16(kbv[ks][0], kbv[ks][1]); w.w = pk_bf16(kbv[ks][2], kbv[ks][3]);
            s = __builtin_amdgcn_mfma_f32_16x16x32_bf16(__builtin_bit_cast(bf16x8, w), qf[ks], s, 0, 0, 0);
        }
        if (fr < 8) {
#pragma unroll
            for (int j = 0; j < 4; ++j) sS[(wave * 32 + kb * 16 + kq * 4 + j) * 8 + fr] = s[j];
        }
    }
    __syncthreads();
    {
        float v[4]; float mx = -INFINITY;
#pragma unroll
        for (int i = 0; i < 4; ++i) { v[i] = sS[(lane + 64 * i) * 8 + wave]; mx = fmaxf(mx, v[i]); }
        mx = wave_max(mx); float sum = 0.f;
#pragma unroll
        for (int i = 0; i < 4; ++i) { v[i] = __builtin_amdgcn_exp2f(v[i] - mx); sum += v[i]; }
        sum = wave_sum(sum); const float inv = 1.f / sum;
#pragma unroll
        for (int i = 0; i < 4; ++i) sS[(lane + 64 * i) * 8 + wave] = v[i] * inv;
    }
    __syncthreads();
    {
        f32x4 o[8];
#pragma unroll
        for (int q = 0; q < 8; ++q) o[q] = (f32x4){0.f, 0.f, 0.f, 0.f};
        const float* vp = Vc + (size_t)(wave * 32) * 1024 + lane * 4;
#pragma unroll 8
        for (int k = 0; k < 32; ++k) {
            const f32x4 v = *(const f32x4*)(vp + (size_t)k * 1024);
            const f32x4 p0 = *(const f32x4*)(sS + (wave * 32 + k) * 8), p1 = *(const f32x4*)(sS + (wave * 32 + k) * 8 + 4);
            o[0] += v * p0[0]; o[1] += v * p0[1]; o[2] += v * p0[2]; o[3] += v * p0[3];
            o[4] += v * p1[0]; o[5] += v * p1[1]; o[6] += v * p1[2]; o[7] += v * p1[3];
        }
#pragma unroll
        for (int q = 0; q < 8; ++q) *(f32x4*)(red + ((wave * 8 + q) * 256) + lane * 4) = o[q];
    }
    __syncthreads();
    {
        const int q = tid >> 6; f32x4 a = (f32x4){0.f, 0.f, 0.f, 0.f};
#pragma unroll
        for (int w = 0; w < 8; ++w) a += *(const f32x4*)(red + ((w * 8 + q) * 256) + lane * 4);
        bf16_t* Og = (bf16_t*)(ws_of(p) + WS_O) + (size_t)(MP + b * NSQ + q) * DM + h * 256 + lane * 4;
        u32x2 w; w.x = pk_bf16(a[0], a[1]); w.y = pk_bf16(a[2], a[3]); *(u32x2*)Og = w;
    }
    __syncthreads();
}

DI void attn_sample_pair(const Params& p, int l, int pr, unsigned char* lds) {
    const int tid = opaque_tid(), lane = tid & 63, wave = tid >> 6, fr = lane & 15, kq = lane >> 4, sub = wave >> 2, w4 = wave & 3;
    const int it = pr * 2 + sub, b = it >> 2, h = it & 3;
    const float* Kc = p.in[5] + (((size_t)l * NSB + b) * 256) * 1024 + h * 256;
    const float* Vc = p.in[6] + (((size_t)l * NSB + b) * 256) * 1024 + h * 256;
    float* sS = (float*)lds + sub * 2048;
    float* red = (float*)(lds + 16384) + sub * 8192;
    const int qrow = MP + b * NSQ + (fr & 7);
    const bf16_t* Qg = (const bf16_t*)(ws_of(p) + WS_Q) + (size_t)qrow * DM + h * 256 + kq * 8;
    bf16x8 qf[8];
#pragma unroll
    for (int ks = 0; ks < 8; ++ks) { qf[ks] = *(const bf16x8*)(Qg + ks * 32); if (fr >= 8) qf[ks] = (bf16x8){0, 0, 0, 0, 0, 0, 0, 0}; }
#pragma unroll 1
    for (int kh2 = 0; kh2 < 2; ++kh2) {
#pragma unroll
        for (int kb = 0; kb < 2; ++kb) {
            const int key0 = w4 * 64 + kh2 * 32 + kb * 16;
            const float* kp = Kc + (size_t)(key0 + fr) * 1024 + kq * 8;
            f32x4 ka[8], kbv[8];
#pragma unroll
            for (int ks = 0; ks < 8; ++ks) { ka[ks] = *(const f32x4*)(kp + ks * 32); kbv[ks] = *(const f32x4*)(kp + ks * 32 + 4); }
            f32x4 s = (f32x4){0.f, 0.f, 0.f, 0.f};
#pragma unroll
            for (int ks = 0; ks < 8; ++ks) {
                u32x4 w; w.x = pk_bf16(ka[ks][0], ka[ks][1]); w.y = pk_bf16(ka[ks][2], ka[ks][3]); w.z = pk_bf16(kbv[ks][0], kbv[ks][1]); w.w = pk_bf16(kbv[ks][2], kbv[ks][3]);
                s = __builtin_amdgcn_mfma_f32_16x16x32_bf16(__builtin_bit_cast(bf16x8, w), qf[ks], s, 0, 0, 0);
            }
            if (fr < 8) {
#pragma unroll
                for (int j = 0; j < 4; ++j) sS[(key0 + kq * 4 + j) * 8 + fr] = s[j];
            }
        }
    }
    __syncthreads();
#pragma unroll
    for (int qq = 0; qq < 2; ++qq) {
        const int q = w4 * 2 + qq;
        float v[4]; float mx = -INFINITY;
#pragma unroll
        for (int i = 0; i < 4; ++i) { v[i] = sS[(lane + 64 * i) * 8 + q]; mx = fmaxf(mx, v[i]); }
        mx = wave_max(mx); float sum = 0.f;
#pragma unroll
        for (int i = 0; i < 4; ++i) { v[i] = __builtin_amdgcn_exp2f(v[i] - mx); sum += v[i]; }
        sum = wave_sum(sum); const float inv = 1.f / sum;
#pragma unroll
        for (int i = 0; i < 4; ++i) sS[(lane + 64 * i) * 8 + q] = v[i] * inv;
    }
    __syncthreads();
    {
        f32x4 o[8];
#pragma unroll
        for (int q = 0; q < 8; ++q) o[q] = (f32x4){0.f, 0.f, 0.f, 0.f};
        const float* vp = Vc + (size_t)(w4 * 64) * 1024 + lane * 4;
#pragma unroll 8
        for (int k = 0; k < 64; ++k) {
            const f32x4 v = *(const f32x4*)(vp + (size_t)k * 1024);
            const f32x4 p0 = *(const f32x4*)(sS + (w4 * 64 + k) * 8), p1 = *(const f32x4*)(sS + (w4 * 64 + k) * 8 + 4);
            o[0] += v * p0[0]; o[1] += v * p0[1]; o[2] += v * p0[2]; o[3] += v * p0[3];
            o[4] += v * p1[0]; o[5] += v * p1[1]; o[6] += v * p1[2]; o[7] += v * p1[3];
        }
#pragma unroll
        for (int q = 0; q < 8; ++q) *(f32x4*)(red + ((w4 * 8 + q) * 256) + lane * 4) = o[q];
    }
    __syncthreads();
    {
        const int q = (tid >> 5) & 7, d0 = (tid & 31) * 8; f32x4 a0 = (f32x4){0.f, 0.f, 0.f, 0.f}, a1 = a0;
#pragma unroll
        for (int w = 0; w < 4; ++w) { a0 += *(const f32x4*)(red + ((w * 8 + q) * 256) + d0); a1 += *(const f32x4*)(red + ((w * 8 + q) * 256) + d0 + 4); }
        bf16_t* Og = (bf16_t*)(ws_of(p) + WS_O) + (size_t)(MP + b * NSQ + q) * DM + h * 256 + d0;
        u32x4 w; w.x = pk_bf16(a0[0], a0[1]); w.y = pk_bf16(a0[2], a0[3]); w.z = pk_bf16(a1[0], a1[1]); w.w = pk_bf16(a1[2], a1[3]); *(u32x4*)Og = w;
    }
    __syncthreads();
}

DI void attn_phase(const Params& p, int l, unsigned char* lds, int G, int mask) {
    for (int it = opaque_bid(); it < 512; it += G) {
        int u = it;
        if (G == 256) { const int c = it & 255; u = (it & 256) + (c & 7) * 32 + (c >> 3); }
        if (mask & 1) attn_prompt_unit(p, l, u, lds);
    }
    if (mask & 2) for (int pr = opaque_bid(); pr < 256; pr += G) attn_sample_pair(p, l, pr, lds);
}

DI void final_phase(const Params& p, int G) {
    const int tid = opaque_tid(), lane = tid & 63, wave = tid >> 6;
    const bf16_t* XBf = (const bf16_t*)(ws_of(p) + WS_XB); const float* SS = (const float*)(ws_of(p) + WS_SS); const float* g = p.in[33];
    f32x4 gv[4];
#pragma unroll
    for (int j = 0; j < 4; ++j) gv[j] = ((const f32x4*)g)[lane + 64 * j];
    const int NW = G * 8;
    for (int m0 = opaque_bid() * 8 + wave; m0 < MT; m0 += 4 * NW) {
        u32x2 xv[4][4]; float sv[4];
#pragma unroll
        for (int r = 0; r < 4; ++r) {
            const int m = m0 + r * NW; const bool ok = m < MT; const int mm = ok ? m : m0;
            sv[r] = (lane < 16) ? SS[(size_t)mm * 16 + lane] : 0.f;
            const u32x2* xr = (const u32x2*)(XBf + (size_t)mm * DM) + lane;
#pragma unroll
            for (int j = 0; j < 4; ++j) xv[r][j] = xr[64 * j];
        }
#pragma unroll
        for (int r = 0; r < 4; ++r) {
            const int m = m0 + r * NW; if (m >= MT) break;
            const float rs = __builtin_amdgcn_rsqf(wave_sum(sv[r]) * (1.f / 1024.f) + EPS);
            f32x4* o = (f32x4*)(out_of(p) + (size_t)m * DM) + lane;
#pragma unroll
            for (int j = 0; j < 4; ++j) { const u32x2 v = xv[r][j]; o[64 * j] = (f32x4){bf_lo(v.x), bf_hi(v.x), bf_lo(v.y), bf_hi(v.y)} * rs * gv[j]; }
        }
    }
}

constexpr int MPITCH = 264, MOPB = 64 * MPITCH * 2;
DI void mini_unit(const Params& p, unsigned char* lds, int kind, const bf16_t* A, const bf16_t* Bt, int Kfull, int mu, int nct, float scale, const float* xin_s) {
    const int tid = opaque_tid(), lane = tid & 63, wave = __builtin_amdgcn_readfirstlane(tid >> 6), fr = lane & 15, kq = lane >> 4, rb = wave & 3, kh = wave >> 2;
    const int rt = mu / nct, ct = mu % nct, r0 = rt * 64 + rb * 16;
    unsigned char* ws = ws_of(p);
    f32x4 tot[4], acc[4];
#pragma unroll
    for (int cb = 0; cb < 4; ++cb) { tot[cb] = (f32x4){0.f, 0.f, 0.f, 0.f}; acc[cb] = (f32x4){0.f, 0.f, 0.f, 0.f}; }
    const int pitch = Kfull, nch = Kfull >> 8;
    const bf16_t* Ag = A + (size_t)(rt * 64 + (tid >> 5)) * pitch + (tid & 31) * 8;
    const bf16_t* Bg = Bt + (size_t)(ct * 64 + (tid >> 5)) * pitch + (tid & 31) * 8;
    const int sto = (tid >> 5) * MPITCH + (tid & 31) * 8;
    u32x4 ra[4], rbv[4];
#pragma unroll
    for (int i = 0; i < 4; ++i) { ra[i] = *(const u32x4*)(Ag + (size_t)(16 * i) * pitch); rbv[i] = *(const u32x4*)(Bg + (size_t)(16 * i) * pitch); }
    __syncthreads();
    {
        bf16_t* sa = (bf16_t*)lds; bf16_t* sb = (bf16_t*)(lds + MOPB);
#pragma unroll
        for (int i = 0; i < 4; ++i) { *(u32x4*)(sa + sto + 16 * i * MPITCH) = ra[i]; *(u32x4*)(sb + sto + 16 * i * MPITCH) = rbv[i]; }
    }
    __syncthreads();
    for (int c = 0; c < nch; ++c) {
        const bool more = (c + 1 < nch);
        if (more) {
#pragma unroll
            for (int i = 0; i < 4; ++i) { ra[i] = *(const u32x4*)(Ag + (size_t)(16 * i) * pitch + (c + 1) * 256); rbv[i] = *(const u32x4*)(Bg + (size_t)(16 * i) * pitch + (c + 1) * 256); }
        }
        const bf16_t* sa = (const bf16_t*)(lds + (c & 1) * 2 * MOPB) + (rb * 16 + fr) * MPITCH + kh * 128 + kq * 8;
        const bf16_t* sb = (const bf16_t*)(lds + (c & 1) * 2 * MOPB + MOPB) + fr * MPITCH + kh * 128 + kq * 8;
#pragma unroll
        for (int ks = 0; ks < 4; ++ks) {
            const bf16x8 a = *(const bf16x8*)(sa + ks * 32);
#pragma unroll
            for (int cb = 0; cb < 4; ++cb) { const bf16x8 bfr = *(const bf16x8*)(sb + cb * 16 * MPITCH + ks * 32); acc[cb] = __builtin_amdgcn_mfma_f32_16x16x32_bf16(bfr, a, acc[cb], 0, 0, 0); }
        }
        if (kind == 9) {
            if (c & 1) {
                const int sg = c >> 1;
                const bf16_t* gp = (const bf16_t*)(ws + WS_Z) + (size_t)(MP + r0 + fr) * ZP + 3072 + 1024 * sg + ct * 64 + 4 * kq;
#pragma unroll
                for (int cb = 0; cb < 4; ++cb) { const u32x2 g = *(const u32x2*)(gp + cb * 16);
                    tot[cb][0] += bf_lo(g.x) * acc[cb][0]; tot[cb][1] += bf_hi(g.x) * acc[cb][1]; tot[cb][2] += bf_lo(g.y) * acc[cb][2]; tot[cb][3] += bf_hi(g.y) * acc[cb][3];
                    acc[cb] = (f32x4){0.f, 0.f, 0.f, 0.f}; }
            }
        }
        if (more) {
            bf16_t* sa2 = (bf16_t*)(lds + ((c + 1) & 1) * 2 * MOPB); bf16_t* sb2 = (bf16_t*)(lds + ((c + 1) & 1) * 2 * MOPB + MOPB);
#pragma unroll
            for (int i = 0; i < 4; ++i) { *(u32x4*)(sa2 + sto + 16 * i * MPITCH) = ra[i]; *(u32x4*)(sb2 + sto + 16 * i * MPITCH) = rbv[i]; }
        }
        __syncthreads();
    }
    if (kind != 9) {
#pragma unroll
        for (int cb = 0; cb < 4; ++cb) tot[cb] = acc[cb];
    }
    float* red = (float*)lds;
    if (kh == 1) {
#pragma unroll
        for (int cb = 0; cb < 4; ++cb) *(f32x4*)(red + ((rb * 64 + lane) * 4 + cb) * 4) = tot[cb];
    }
    __syncthreads();
    if (kh == 0) {
#pragma unroll
        for (int cb = 0; cb < 4; ++cb) tot[cb] += *(const f32x4*)(red + ((rb * 64 + lane) * 4 + cb) * 4);
        const int row = MP + r0 + fr, col0 = ct * 64 + 4 * kq;
        if (kind == 8) {
            bf16_t* XB = (bf16_t*)(ws + WS_XB) + (size_t)row * DM + col0; const float* xi = xin_s ? xin_s + (size_t)(r0 + fr) * DM + col0 : nullptr;
            float ss = 0.f;
#pragma unroll
            for (int cb = 0; cb < 4; ++cb) {
                f32x4 x;
                if (xin_s) x = *(const f32x4*)(xi + cb * 16); else { const u32x2 v = *(const u32x2*)(XB + cb * 16); x = (f32x4){bf_lo(v.x), bf_hi(v.x), bf_lo(v.y), bf_hi(v.y)}; }
                x += tot[cb];
                u32x2 w; w.x = pk_bf16(x[0], x[1]); w.y = pk_bf16(x[2], x[3]); *(u32x2*)(XB + cb * 16) = w;
                const f32x4 y = (f32x4){bf_lo(w.x), bf_hi(w.x), bf_lo(w.y), bf_hi(w.y)};
                ss += (y[0] * y[0] + y[1] * y[1]) + (y[2] * y[2] + y[3] * y[3]);
            }
            ss += __shfl_xor(ss, 16); ss += __shfl_xor(ss, 32);
            if (kq == 0) ((float*)(ws + WS_SS))[(size_t)row * 16 + ct] = ss;
        } else if (kind == 0 || kind == 7) {
            const f32x4 s4 = *(const f32x4*)((const float*)(ws + WS_SS) + (size_t)row * 16 + kq * 4);
            float t = (s4[0] + s4[1]) + (s4[2] + s4[3]); t += __shfl_xor(t, 16); t += __shfl_xor(t, 32);
            const float r = __builtin_amdgcn_rsqf(t * (1.f / 1024.f) + EPS) * scale;
            bf16_t* Q = (kind == 0) ? (bf16_t*)(ws + WS_Q) + (size_t)row * DM + col0 : (bf16_t*)(ws + WS_Z) + (size_t)row * DFF + col0;
#pragma unroll
            for (int cb = 0; cb < 4; ++cb) {
                f32x4 v = tot[cb] * r;
                if (kind == 7) { v[0] = fmaxf(v[0], 0.f); v[1] = fmaxf(v[1], 0.f); v[2] = fmaxf(v[2], 0.f); v[3] = fmaxf(v[3], 0.f); v = v * v; }
                u32x2 w; w.x = pk_bf16(v[0], v[1]); w.y = pk_bf16(v[2], v[3]); *(u32x2*)(Q + cb * 16) = w; }
        } else {
            bf16_t* MG = (bf16_t*)(ws + WS_MG) + (size_t)row * DM + col0;
#pragma unroll
            for (int cb = 0; cb < 4; ++cb) { u32x2 w; w.x = pk_bf16(tot[cb][0], tot[cb][1]); w.y = pk_bf16(tot[cb][2], tot[cb][3]); *(u32x2*)(MG + cb * 16) = w; }
        }
    }
    __syncthreads();
}

#define XB_TMO      128
#define XB_XCNT(j)  (256  + 64 * (j))
#define XB_XSUB(j)  (1280 + 64 * (j))
#define XB_XGEN(j)  (2304 + 64 * (j))
#define XB_TOP      3328
#define XB_TOPGEN   3392
#define XCD_BAR_WORDS 3456
#define XB_SPIN_CAP (1u << 22)
DI unsigned xb_ld(unsigned* p)              { return __hip_atomic_load(p, __ATOMIC_RELAXED, __HIP_MEMORY_SCOPE_AGENT); }
DI unsigned xb_add(unsigned* p, unsigned v) { return __hip_atomic_fetch_add(p, v, __ATOMIC_RELAXED, __HIP_MEMORY_SCOPE_AGENT); }
DI unsigned xb_xcc_id() { return (unsigned)__builtin_amdgcn_s_getreg((3 << 11) | 20) & 0xFu; }
#define XB_SPIN(cond, bar) do { unsigned _sp = 0; while (cond) { __builtin_amdgcn_s_sleep(1); \
    if ((++_sp & 255u) == 0u) { if (xb_ld(&(bar)[XB_TMO])) break; if (_sp > XB_SPIN_CAP) { atomicAdd(&(bar)[XB_TMO], 1u); break; } } } } while (0)
struct XcdBarrier { unsigned* bar; unsigned x; volatile LAS unsigned* st; };
DI XcdBarrier xcd_barrier_post(unsigned* bar, volatile LAS unsigned* st) {
    XcdBarrier b; b.bar = bar; b.x = xb_xcc_id(); b.st = st;
    if (threadIdx.x == 0) (void)xb_add(&bar[XB_XCNT(b.x)], 1u);
    return b;
}
DI void xcd_barrier_complete(unsigned* bar, unsigned x, unsigned& nloc, unsigned& nx) {
    const unsigned G = gridDim.x * gridDim.y * gridDim.z;
    unsigned sum, cnt, mine, sp = 0u;
    for (;;) {
        sum = 0u; cnt = 0u; mine = 0u;
#pragma unroll
        for (unsigned j = 0; j < 16; ++j) { const unsigned c = xb_ld(&bar[XB_XCNT(j)]); sum += c; cnt += (c > 0u) ? 1u : 0u; mine = (j == x) ? c : mine; }
        if (sum == G) break;
        __builtin_amdgcn_s_sleep(1);
        if ((++sp & 255u) == 0u) { if (xb_ld(&bar[XB_TMO])) break; if (sp > XB_SPIN_CAP) { atomicAdd(&bar[XB_TMO], 1u); break; } }
    }
    nloc = mine > 0u ? mine : 1u; nx = cnt > 0u ? cnt : 1u;
}
DI void xcd_barrier(const XcdBarrier& b) {
    asm volatile("s_waitcnt vmcnt(0)" ::: "memory");
    __syncthreads();
    if (threadIdx.x == 0) {
        unsigned* bar = b.bar;
        __builtin_amdgcn_s_waitcnt(0);
        unsigned nloc = b.st[0], nx = b.st[1];
        if (nloc == 0u) { xcd_barrier_complete(bar, b.x, nloc, nx); b.st[0] = nloc; b.st[1] = nx; }
        const unsigned old = xb_add(&bar[XB_XSUB(b.x)], 1u);
        const unsigned gen = old / nloc;
        if (old + 1u == (gen + 1u) * nloc) {
            __builtin_amdgcn_fence(__ATOMIC_RELEASE, "agent");
            asm volatile("s_waitcnt vmcnt(0)" ::: "memory");
            const unsigned og = xb_add(&bar[XB_TOP], 1u);
            const unsigned tg = og / nx;
            if (og + 1u == (tg + 1u) * nx) xb_add(&bar[XB_TOPGEN], 1u);
            else XB_SPIN(xb_ld(&bar[XB_TOPGEN]) == tg, bar);
            __builtin_amdgcn_fence(__ATOMIC_ACQUIRE, "agent");
            xb_add(&bar[XB_XGEN(b.x)], 1u);
            asm volatile("s_waitcnt vmcnt(0)" ::: "memory");
        } else {
            XB_SPIN(xb_ld(&bar[XB_XGEN(b.x)]) == gen, bar);
            __builtin_amdgcn_fence(__ATOMIC_ACQUIRE, "agent");
            asm volatile("s_waitcnt vmcnt(0)" ::: "memory");
        }
    }
    __syncthreads();
}

__global__ void __launch_bounds__(512, 2) fwd_megakernel(Params p) {
    extern __shared__ __attribute__((aligned(16))) unsigned char lds[];
    cg::grid_group grid = cg::this_grid();
    const int G = gridDim.x;
    volatile LAS int* dsc = (volatile LAS int*)((LAS unsigned char*)lds + LDS_MISC + 2048);
    volatile LAS unsigned* bst = (volatile LAS unsigned*)((LAS unsigned char*)lds + LDS_MISC + 4096);
    if (threadIdx.x < 2) bst[threadIdx.x] = 0u;
    __syncthreads();
    const bool multi = (p.ph_hi - p.ph_lo) > 1;
    XcdBarrier xbar; xbar.bar = (unsigned*)(p.ws + WS_CTL); xbar.x = 0; xbar.st = bst;
    if (multi) xbar = xcd_barrier_post((unsigned*)(p.ws + WS_CTL), bst);
    for (int ph = p.ph_lo; ph < p.ph_hi; ++ph) {
        int is_gemm = 0, K = 1024;
        if (ph == 0) { int reps = PROBE_A ? 2 : 1; asm volatile("" : "+s"(reps)); for (int r = 0; r < reps; ++r) { if (EN_PRO) prologue(p, lds, G, r == 0 ? 7 : PROBE_A); __syncthreads(); } }
        else if (ph == NPH - 1) final_phase(p, G);
        else {
            const int l = (ph - 1) / 9, s = (ph - 1) % 9;
            if (s == 1) { int reps = PROBE_B ? 2 : 1; asm volatile("" : "+s"(reps)); for (int r = 0; r < reps; ++r) { if (EN_BR) branch_phase(p, l, lds, G, r == 0 ? 3 : PROBE_B); __syncthreads(); } }
            else if (s == 5) { int reps = PROBE_C ? 2 : 1; asm volatile("" : "+s"(reps)); for (int r = 0; r < reps; ++r) { if (EN_AT) attn_phase(p, l, lds, G, r == 0 ? 3 : PROBE_C); __syncthreads(); } }
            else {
                is_gemm = 1; K = (s == 2) ? 2048 : (s == 8) ? 4096 : 1024;
                if (threadIdx.x == 0) {
                    const float* X = (const float*)(ws_of(p) + WS_X);
                    int mode = 1, nN = 4, kind = 0, nkv = 0, ldz = 0; float scale = 1.f;
                    const void *A = nullptr, *B = nullptr, *xin_p = X, *xin_s = X + (size_t)MP * DM, *bias = nullptr, *Zout = nullptr;
                    switch (s) {
                        case 0: mode = 0; A = ws_of(p) + WS_XB; B = ws_of(p) + WS_WIN + (size_t)l * 16 * MiB; nkv = (l == 0) ? 128 : 0; Zout = ws_of(p) + WS_Z; ldz = ZP; bias = p.in[22] + (size_t)l * 4096; break;
                        case 2: mode = 2; A = ws_of(p) + WS_BR; B = ws_of(p) + WS_WB + (size_t)l * 4 * MiB; break;
                        case 3: kind = 8; A = ws_of(p) + WS_MG; B = ws_of(p) + WS_WMIX + (size_t)l * 2 * MiB; if (l == 0) { xin_p = p.in[0]; xin_s = p.in[1]; } break;
                        case 4: kind = 0; A = ws_of(p) + WS_XB; B = ws_of(p) + WS_WQ + (size_t)l * 2 * MiB; Zout = ws_of(p) + WS_Q; ldz = DM; scale = 0.0625f * LOG2E; break;
                        case 6: kind = 8; A = ws_of(p) + WS_O; B = ws_of(p) + WS_WO + (size_t)l * 2 * MiB; break;
                        case 7: kind = 7; nN = 16; A = ws_of(p) + WS_XB; B = ws_of(p) + WS_W1 + (size_t)l * 8 * MiB; Zout = ws_of(p) + WS_Z; ldz = DFF; break;
                        default: kind = 8; A = ws_of(p) + WS_Z; B = ws_of(p) + WS_W2 + (size_t)l * 8 * MiB; break;
                    }
                    dsc[0] = mode; dsc[1] = nN; dsc[2] = K; dsc[3] = kind; dsc[4] = nkv; dsc[5] = ldz; dsc[6] = __float_as_int(scale); dsc[7] = (s == 3 && l == 0) ? 1 : 0;
                    const unsigned long long pa[8] = {(unsigned long long)A, (unsigned long long)B, (unsigned long long)(ws_of(p) + WS_MB), (unsigned long long)(ws_of(p) + WS_WKV), (unsigned long long)xin_p, (unsigned long long)xin_s, (unsigned long long)bias, (unsigned long long)Zout};
#pragma unroll
                    for (int i = 0; i < 8; ++i) { dsc[8 + 2 * i] = (int)(unsigned)pa[i]; dsc[9 + 2 * i] = (int)(unsigned)(pa[i] >> 32); }
                }
                __syncthreads();
            }
        }
        int greps = 1; if (PROBE_G >= 0 && is_gemm && ((ph - 1) % 9) == PROBE_G) greps = 2; asm volatile("" : "+s"(greps));
        for (int gr = 0; gr < greps; ++gr)
        if (EN_GEMM && is_gemm) {
            pg8::SchedU S; S.d = (pg8::DescP)dsc; S.G = G; S.c = opaque_bid();
            pg8::EpiU E; E.d = (pg8::DescP)dsc; E.ws = ws_of(p); E.out = out_of(p);
            pg8::gemm_phase((LAS unsigned char*)lds, K, (ph - 1) % 9 == 2, S, E);
            const int l = (ph - 1) / 9, s = (ph - 1) % 9;
            if (s == 2 || s == 3 || s == 4 || s == 6 || s == 7 || s == 8) {
                unsigned char* ws = ws_of(p);
                int kind = 8; const bf16_t* A; const bf16_t* B; float scale = 1.f;
                const float* xin_s = (l == 0 && s == 3) ? p.in[1] : nullptr;
                if (s == 2) { kind = 9; A = (const bf16_t*)(ws + WS_BR) + (size_t)MP * 2048; B = (const bf16_t*)(ws + WS_WB + (size_t)l * 4 * MiB); }
                else if (s == 3) { A = (const bf16_t*)(ws + WS_MG) + (size_t)MP * DM; B = (const bf16_t*)(ws + WS_WMIX + (size_t)l * 2 * MiB); }
                else if (s == 4) { kind = 0; A = (const bf16_t*)(ws + WS_XB) + (size_t)MP * DM; B = (const bf16_t*)(ws + WS_WQ + (size_t)l * 2 * MiB); scale = 0.0625f * LOG2E; }
                else if (s == 6) { A = (const bf16_t*)(ws + WS_O) + (size_t)MP * DM; B = (const bf16_t*)(ws + WS_WO + (size_t)l * 2 * MiB); }
                else if (s == 7) { kind = 7; A = (const bf16_t*)(ws + WS_XB) + (size_t)MP * DM; B = (const bf16_t*)(ws + WS_W1 + (size_t)l * 8 * MiB); }
                else { A = (const bf16_t*)(ws + WS_Z) + (size_t)MP * DFF; B = (const bf16_t*)(ws + WS_W2 + (size_t)l * 8 * MiB); }
                const int nct = (s == 7) ? 64 : 16;
                for (int mu = opaque_bid(); mu < 16 * nct; mu += G) mini_unit(p, lds, kind, A, B, K, mu, nct, scale, xin_s);
            }
        }
        if (ph + 1 < p.ph_hi) {
            if (p.ph_lo < 0) grid.sync();
            else { int reps = 1 + PROBE_S; asm volatile("" : "+s"(reps)); for (int r = 0; r < reps; ++r) xcd_barrier(xbar); }
        }
    }
}

#ifndef MK_PER_PHASE
#define MK_PER_PHASE 0
#endif
extern "C" void kernel_launch(void* const* d_in, const int* in_sizes, int n_in, void* d_out, int out_size, void* d_ws, size_t ws_size, hipStream_t stream) {
    static int grid = 0;
    if (grid == 0) {
        if (n_in != 34 || out_size != (int)O_END || ws_size < WS_END) { fprintf(stderr, "kernel_launch: unexpected shapes: n_in %d out %d ws %zu\n", n_in, out_size, ws_size); grid = -1; return; }
        int dev = 0, cus = 0, per_cu = 0;
        (void)hipGetDevice(&dev); (void)hipDeviceGetAttribute(&cus, hipDeviceAttributeMultiprocessorCount, dev);
        if (hipFuncSetAttribute((const void*)fwd_megakernel, hipFuncAttributeMaxDynamicSharedMemorySize, LDS_BYTES) != hipSuccess) { fprintf(stderr, "kernel_launch: hipFuncSetAttribute failed\n"); grid = -1; return; }
        if (hipOccupancyMaxActiveBlocksPerMultiprocessor(&per_cu, (const void*)fwd_megakernel, 512, LDS_BYTES) != hipSuccess || per_cu < 1) { fprintf(stderr, "kernel_launch: occupancy query gave %d\n", per_cu); per_cu = 1; }
        (void)hipGetLastError();
        grid = cus * per_cu; if (grid > 256) grid = 256;
        if (grid <= 0) grid = 256;
    }
    if (grid < 0) return;
    Params p{};
    for (int i = 0; i < 34; ++i) p.in[i] = (const float*)d_in[i];
    p.out = (float*)d_out; p.ws = (unsigned char*)d_ws;
#if MK_PER_PHASE
    for (int ph = 0; ph < NPH; ++ph) { p.ph_lo = ph; p.ph_hi = ph + 1; hipLaunchKernelGGL(fwd_megakernel, dim3(grid), dim3(512), LDS_BYTES, stream, p); }
#else
    p.ph_lo = 0; p.ph_hi = NPH;
    (void)hipMemsetAsync((char*)d_ws + WS_CTL, 0, 65536, stream);
    void* args[] = {&p};
    hipError_t e = hipLaunchCooperativeKernel((const void*)fwd_megakernel, dim3(grid), dim3(512), args, LDS_BYTES, stream);
    if (e != hipSuccess) fprintf(stderr, "kernel_launch: cooperative launch failed: %s (grid %d)\n", hipGetErrorString(e), grid);
#endif
}
```

```cpp
#include <hip/hip_runtime.h>
#include <hip/hip_cooperative_groups.h>
#include <cstdio>
#include <cstdint>
namespace cg = cooperative_groups;
#ifndef PROBE_G
#define PROBE_G -1
#endif
#ifndef PROBE_C
#define PROBE_C 0
#endif
#ifndef PROBE_S
#define PROBE_S 0
#endif
#ifndef PROBE_A
#define PROBE_A 0
#endif
#ifndef PROBE_B
#define PROBE_B 0
#endif
#ifndef EN_SGU
#define EN_SGU 1
#endif
#ifndef EN_CP
#define EN_CP 1
#endif
#ifndef EN_CS
#define EN_CS 1
#endif
#ifndef EN_PRO
#define EN_PRO 1
#endif
#ifndef EN_BR
#define EN_BR 1
#endif
#ifndef EN_AT
#define EN_AT 1
#endif
#ifndef EN_GEMM
#define EN_GEMM 1
#endif

#define DI __device__ __forceinline__
#define LAS __attribute__((address_space(3)))
typedef unsigned short bf16_t;
typedef short bf16x8 __attribute__((ext_vector_type(8)));
typedef short s16x4 __attribute__((ext_vector_type(4)));
typedef float f32x4 __attribute__((ext_vector_type(4)));
typedef float f32x2 __attribute__((ext_vector_type(2)));
typedef unsigned u32x4 __attribute__((ext_vector_type(4)));
typedef unsigned u32x2 __attribute__((ext_vector_type(2)));
typedef __bf16 bf16x2_t __attribute__((ext_vector_type(2)));

constexpr int DM = 1024, MP = 16384, MS = 1024, MT = MP + MS, SEQ = 2048, NB = 8, NSB = 128, NSQ = 8, WBR = 512, ZP = 7168, DFF = 4096;
constexpr float EPS = 1e-6f;
constexpr float LOG2E = 1.4426950408889634f;
constexpr int NPH = 20;
constexpr size_t O_YP = 0, O_YS = 16777216, O_POOLP = 17825792, O_SCP = 17948672, O_CCP = 17965056, O_MK = 18210816, O_MV = 22405120,
                 O_POOLS = 26599424, O_SCS = 28565504, O_CCS = 28827648, O_SGUV = 32759808, O_END = 33808384;
constexpr size_t MiB = 1u << 20;
constexpr size_t WS_WIN = 0, WS_WB = 32 * MiB, WS_WMIX = 40 * MiB, WS_WQ = 44 * MiB, WS_WKV = 48 * MiB, WS_WO = 56 * MiB, WS_W1 = 60 * MiB, WS_W2 = 76 * MiB,
                 WS_SGUW = 92 * MiB, WS_SS = 93 * MiB, WS_SSM = 95 * MiB, WS_MB = 96 * MiB, WS_KP = 100 * MiB, WS_VTP = 108 * MiB, WS_X = 116 * MiB,
                 WS_XB = 184 * MiB, WS_MG = 218 * MiB, WS_Q = 252 * MiB, WS_O = 286 * MiB, WS_BR = 320 * MiB, WS_Z = 388 * MiB, WS_CTL = 627 * MiB, WS_END = 628 * MiB;
constexpr size_t BR_STRIDE = (size_t)MT * WBR * 2;
constexpr int LDS_BYTES = 147456, LDS_MISC = 139264;

DI unsigned pk_bf16(float lo, float hi) { f32x2 v = {lo, hi}; bf16x2_t b = __builtin_convertvector(v, bf16x2_t); return __builtin_bit_cast(unsigned, b); }
DI float bf_lo(unsigned v) { return __uint_as_float(v << 16); }
DI float bf_hi(unsigned v) { return __uint_as_float(v & 0xffff0000u); }
DI float sigmoidf_(float x) { return __builtin_amdgcn_rcpf(1.f + __builtin_amdgcn_exp2f(-x * LOG2E)); }
DI float gelu_tanh(float x) { const float u = 1.5957691216057308f * (x + 0.044715f * x * x * x); return x * sigmoidf_(u); }
DI float wave_sum(float v) {
#pragma unroll
    for (int o = 1; o < 64; o <<= 1) v += __shfl_xor(v, o);
    return v;
}
DI float wave_max(float v) {
#pragma unroll
    for (int o = 1; o < 64; o <<= 1) v = fmaxf(v, __shfl_xor(v, o));
    return v;
}

DI int opaque_tid() { int t = threadIdx.x; asm volatile("" : "+v"(t)); return t; }
DI int opaque_bid() { int b = blockIdx.x; asm volatile("" : "+s"(b)); return b; }
template <int N, int D> struct XReduce {
    static DI void run(float* v, int lane) {
        const bool up = (lane & D) != 0;
#pragma unroll
        for (int i = 0; i < N / 2; ++i) { const float send = up ? v[i] : v[i + N / 2], keep = up ? v[i + N / 2] : v[i]; v[i] = keep + __shfl_xor(send, D); }
        XReduce<N / 2, D / 2>::run(v, lane);
    }
};
template <int D> struct XReduce<1, D> {
    static DI void run(float* v, int lane) {
#pragma unroll
        for (int d = D; d >= 1; d >>= 1) v[0] += __shfl_xor(v[0], d);
    }
};
struct Params { const float* in[34]; float* out; unsigned char* ws; int ph_lo, ph_hi; };
DI unsigned char* ws_of(const Params& p) { unsigned char* w = p.ws; asm volatile("" : "+s"(w)); return w; }
DI float* out_of(const Params& p) { float* o = p.out; asm volatile("" : "+s"(o)); return o; }

namespace pg8 {
constexpr int BM = 256, BK = 64, HALF = 128, HTB = HALF * BK * 2, STAGE_BYTES = 8 * HTB;
DI int lds_byte(int r, int c) { const int st = (r >> 4) * 2 + (c >> 5), rr = r & 15, cc = c & 31, ob = rr * 64 + cc * 2; return st * 1024 + (ob ^ (((ob >> 9) & 1) << 5)); }
DI void stage_rc(int b, int& R, int& C) { const int st = b / 1024, sb = b % 1024, swz = sb ^ (((sb >> 9) & 1) << 5); R = (st >> 1) * 16 + swz / 64; C = (st & 1) * 32 + (swz % 64) / 2; }
DI int perm32(int rho) { const int n = rho >> 4, i = rho & 15; return 8 * (i >> 2) + 4 * n + (i & 3); }

struct Unit { int pm, pn, kind, zc; const char* a; const char* b; };

DI void tile_of(int L, int nM, int nN, int& pm, int& pn) {
    const int nwg = nM * nN; int wgid = L;
    { const int q = nwg / 8, r = nwg % 8, xcd = wgid % 8, off = wgid / 8; wgid = (xcd < r ? xcd * (q + 1) : r * (q + 1) + (xcd - r) * q) + off; }
    const int nig = 8 * nN, gid = wgid / nig, fm = gid * 8, gsz = (nM - fm) < 8 ? (nM - fm) : 8;
    pm = fm + ((wgid % nig) % gsz); pn = (wgid % nig) / gsz;
}

typedef const volatile LAS int* DescP;
DI int dsc_i(DescP d, int i) { return __builtin_amdgcn_readfirstlane(d[i]); }
DI const char* dsc_p(DescP d, int i) { const unsigned lo = (unsigned)__builtin_amdgcn_readfirstlane(d[i]), hi = (unsigned)__builtin_amdgcn_readfirstlane(d[i + 1]); return (const char*)(((unsigned long long)hi << 32) | lo); }
struct SchedU {
    DescP d; int G, c;
    DI bool next(int i, Unit& u) const {
        const int mode = dsc_i(d, 0); const char* A = dsc_p(d, 8); const char* B = dsc_p(d, 10);
        if (mode == 2) {
            const int ti = i * G + c; if (ti >= 64 * 4) return false;
            tile_of(ti, 64, 4, u.pm, u.pn); u.kind = 9; u.zc = 0;
            u.a = A + (size_t)u.pm * (256 * 2048 * 2); u.b = B + (size_t)u.pn * (256 * 2048 * 2); return true;
        }
        const int L = i * G + c;
        if (mode == 1) {
            const int nN = dsc_i(d, 1), K = dsc_i(d, 2);
            const int nM = 64;
            if (L >= nM * nN) return false;
            tile_of(L, nM, nN, u.pm, u.pn); u.kind = dsc_i(d, 3); u.zc = u.pn * 256;
            u.a = A + (size_t)u.pm * ((size_t)512 * K); u.b = B + (size_t)u.pn * ((size_t)512 * K); return true;
        }
        if (L < 68 * 32) {
            tile_of(L, 68, 32, u.pm, u.pn); u.a = A + (size_t)u.pm * (512 * 1024); u.b = B + (size_t)u.pn * (512 * 1024);
            const int pn = u.pn;
            if (pn < 2) { u.kind = 0; u.zc = pn * 256; }
            else if (pn < 6) { u.kind = 3; u.zc = 512 + (pn - 2) * 128; }
            else if (pn < 8) { u.kind = 0; u.zc = 1024 + (pn - 6) * 256; }
            else if (pn < 12) { u.kind = 1; u.zc = 1536 + (pn - 8) * 256; }
            else if (pn < 16) { u.kind = 4; u.zc = 2560 + (pn - 12) * 128; }
            else { u.kind = 2; u.zc = 3072 + (pn - 16) * 256; }
            return true;
        }
        const int j = L - 68 * 32; if (j >= dsc_i(d, 4)) return false;
        const int l = j >> 6, rem = j & 63; u.pm = rem >> 3; u.pn = rem & 7; u.kind = 5; u.zc = l;
        u.a = dsc_p(d, 12) + (size_t)u.pm * (512 * 1024); u.b = dsc_p(d, 14) + (size_t)l * (4 * MiB) + (size_t)u.pn * (512 * 1024); return true;
    }
};

struct EpiU {
    DescP d; unsigned char* ws; float* out;
    template <int ACT> DI void plain(const f32x4 (&acc)[2][2][4][2], const Unit& u, const float (&rs)[2][4], int rloc, int cloc) const {
        const float* bias = (const float*)dsc_p(d, 20); bf16_t* Zout = (bf16_t*)dsc_p(d, 22); const int ldz = dsc_i(d, 5);
        f32x4 bv[2][2];
#pragma unroll
        for (int bj = 0; bj < 2; ++bj)
#pragma unroll
            for (int n = 0; n < 2; ++n) bv[bj][n] = (ACT == 2) ? *(const f32x4*)(bias + (u.zc - 3072) + cloc + bj * 128 + 4 * n) : (f32x4){0.f, 0.f, 0.f, 0.f};
#pragma unroll
        for (int ai = 0; ai < 2; ++ai)
#pragma unroll
            for (int m = 0; m < 4; ++m) {
                const int row = u.pm * 256 + rloc + ai * 128 + m * 16; bf16_t* rowp = Zout + (size_t)row * ldz + u.zc + cloc; const float r = rs[ai][m];
#pragma unroll
                for (int bj = 0; bj < 2; ++bj) {
                    float v[8];
#pragma unroll
                    for (int n = 0; n < 2; ++n)
#pragma unroll
                        for (int j = 0; j < 4; ++j) {
                            float x = acc[ai][bj][m][n][j] * r;
                            if (ACT == 1) x = gelu_tanh(x);
                            if (ACT == 2) x = sigmoidf_(x + bv[bj][n][j]);
                            if (ACT == 7) { x = fmaxf(x, 0.f); x = x * x; }
                            v[n * 4 + j] = x;
                        }
                    u32x4 w; w.x = pk_bf16(v[0], v[1]); w.y = pk_bf16(v[2], v[3]); w.z = pk_bf16(v[4], v[5]); w.w = pk_bf16(v[6], v[7]);
                    *(u32x4*)(rowp + bj * 128) = w;
                }
            }
    }
    template <int ACT> DI void merge2(const f32x4 (&acc)[2][2][4][2], const Unit& u, const float (&rs)[2][4], int rloc, int cloc) const {
        bf16_t* Zout = (bf16_t*)dsc_p(d, 22); const int ldz = dsc_i(d, 5);
#pragma unroll
        for (int ai = 0; ai < 2; ++ai)
#pragma unroll
            for (int m = 0; m < 4; ++m) {
                const int row = u.pm * 256 + rloc + ai * 128 + m * 16; bf16_t* rowp = Zout + (size_t)row * ldz + u.zc + cloc; const float r = rs[ai][m];
                float v[8];
#pragma unroll
                for (int n = 0; n < 2; ++n)
#pragma unroll
                    for (int j = 0; j < 4; ++j) {
                        const float a = acc[ai][0][m][n][j] * r, b = acc[ai][1][m][n][j] * r;
                        v[n * 4 + j] = (ACT == 3) ? a * b : a * sigmoidf_(b);
                    }
                u32x4 w; w.x = pk_bf16(v[0], v[1]); w.y = pk_bf16(v[2], v[3]); w.z = pk_bf16(v[4], v[5]); w.w = pk_bf16(v[6], v[7]);
                *(u32x4*)rowp = w;
            }
    }
    static DI float gclamp(float g) { return fmaxf(g, 1e-20f); }
    DI void rescale(f32x4 (&acc)[2][2][4][2], const Unit& u, int k, int wr, int wc, int fr, int fq) const {
        int rloc = wr * 64 + fr, cloc = wc * 32 + 8 * fq;
        asm volatile("" : "+v"(rloc), "+v"(cloc));
        const bf16_t* Zg = (const bf16_t*)(ws + WS_Z) + 3072 + 1024 * (k - 1) + u.pn * 256 + cloc;
#pragma unroll
        for (int ai = 0; ai < 2; ++ai) {
            u32x4 gp_[4][2], gn_[4][2];
#pragma unroll
            for (int m = 0; m < 4; ++m) { const int row = u.pm * 256 + rloc + ai * 128 + m * 16; const bf16_t* gp = Zg + (size_t)row * ZP;
#pragma unroll
                for (int bj = 0; bj < 2; ++bj) { gp_[m][bj] = *(const u32x4*)(gp + bj * 128); gn_[m][bj] = *(const u32x4*)(gp + 1024 + bj * 128); } }
#pragma unroll
            for (int m = 0; m < 4; ++m) {
#pragma unroll
                for (int bj = 0; bj < 2; ++bj) {
                    const u32x4 a = gp_[m][bj], b = gn_[m][bj];
                    acc[ai][bj][m][0][0] *= gclamp(bf_lo(a.x)) * __builtin_amdgcn_rcpf(gclamp(bf_lo(b.x))); acc[ai][bj][m][0][1] *= gclamp(bf_hi(a.x)) * __builtin_amdgcn_rcpf(gclamp(bf_hi(b.x)));
                    acc[ai][bj][m][0][2] *= gclamp(bf_lo(a.y)) * __builtin_amdgcn_rcpf(gclamp(bf_lo(b.y))); acc[ai][bj][m][0][3] *= gclamp(bf_hi(a.y)) * __builtin_amdgcn_rcpf(gclamp(bf_hi(b.y)));
                    acc[ai][bj][m][1][0] *= gclamp(bf_lo(a.z)) * __builtin_amdgcn_rcpf(gclamp(bf_lo(b.z))); acc[ai][bj][m][1][1] *= gclamp(bf_hi(a.z)) * __builtin_amdgcn_rcpf(gclamp(bf_hi(b.z)));
                    acc[ai][bj][m][1][2] *= gclamp(bf_lo(a.w)) * __builtin_amdgcn_rcpf(gclamp(bf_lo(b.w))); acc[ai][bj][m][1][3] *= gclamp(bf_hi(a.w)) * __builtin_amdgcn_rcpf(gclamp(bf_hi(b.w)));
                }
            }
            asm volatile("" ::: "memory");
        }
    }
    DI void operator()(const f32x4 (&acc)[2][2][4][2], const Unit& u, int wr, int wc, int fr, int fq) const {
        const int kind = u.kind; int rloc = wr * 64 + fr, cloc = wc * 32 + 8 * fq;
        asm volatile("" : "+v"(rloc), "+v"(cloc));
        if (kind == 8) {
            const int xf32 = dsc_i(d, 7);
            const float* xin = (u.pm < 64) ? (const float*)dsc_p(d, 16) : (const float*)dsc_p(d, 18) - (size_t)MP * DM;
            bf16_t* XB = (bf16_t*)(ws + WS_XB); float* SS = (float*)(ws + WS_SS);
#pragma unroll
            for (int ai = 0; ai < 2; ++ai) {
                u32x4 xv[4][2];
                if (!xf32) {
#pragma unroll
                    for (int m = 0; m < 4; ++m) { const size_t off = (size_t)(u.pm * 256 + rloc + ai * 128 + m * 16) * DM + u.pn * 256 + cloc;
#pragma unroll
                        for (int bj = 0; bj < 2; ++bj) xv[m][bj] = *(const u32x4*)(XB + off + bj * 128); }
                }
#pragma unroll
                for (int m = 0; m < 4; ++m) {
                    const int row = u.pm * 256 + rloc + ai * 128 + m * 16; const size_t off = (size_t)row * DM + u.pn * 256 + cloc; float ss = 0.f;
#pragma unroll
                    for (int bj = 0; bj < 2; ++bj) {
                        f32x4 x0, x1;
                        if (xf32) { x0 = *(const f32x4*)(xin + off + bj * 128); x1 = *(const f32x4*)(xin + off + bj * 128 + 4); }
                        else { const u32x4 v = xv[m][bj]; x0 = (f32x4){bf_lo(v.x), bf_hi(v.x), bf_lo(v.y), bf_hi(v.y)}; x1 = (f32x4){bf_lo(v.z), bf_hi(v.z), bf_lo(v.w), bf_hi(v.w)}; }
                        x0 += acc[ai][bj][m][0]; x1 += acc[ai][bj][m][1];
                        u32x4 w; w.x = pk_bf16(x0[0], x0[1]); w.y = pk_bf16(x0[2], x0[3]); w.z = pk_bf16(x1[0], x1[1]); w.w = pk_bf16(x1[2], x1[3]);
                        *(u32x4*)(XB + off + bj * 128) = w;
                        const f32x4 y0 = (f32x4){bf_lo(w.x), bf_hi(w.x), bf_lo(w.y), bf_hi(w.y)}, y1 = (f32x4){bf_lo(w.z), bf_hi(w.z), bf_lo(w.w), bf_hi(w.w)};
                        ss += (y0[0] * y0[0] + y0[1] * y0[1]) + (y0[2] * y0[2] + y0[3] * y0[3]) + (y1[0] * y1[0] + y1[1] * y1[1]) + (y1[2] * y1[2] + y1[3] * y1[3]);
                    }
                    ss += __shfl_xor(ss, 16); ss += __shfl_xor(ss, 32);
                    if (fq == 0) SS[(size_t)row * 16 + u.pn * 4 + wc] = ss;
                    if (xf32 && (m & 1)) asm volatile("" ::: "memory");
                }
                asm volatile("" ::: "memory");
            }
            return;
        }
        if (kind == 9) {
            const bf16_t* Zg = (const bf16_t*)(ws + WS_Z) + 3072 + 1024 * 3 + u.pn * 256 + cloc; bf16_t* MG = (bf16_t*)(ws + WS_MG);
#pragma unroll
            for (int ai = 0; ai < 2; ++ai) {
                u32x4 g[4][2];
#pragma unroll
                for (int m = 0; m < 4; ++m) { const int row = u.pm * 256 + rloc + ai * 128 + m * 16; const bf16_t* gp = Zg + (size_t)row * ZP;
#pragma unroll
                    for (int bj = 0; bj < 2; ++bj) g[m][bj] = *(const u32x4*)(gp + bj * 128); }
#pragma unroll
                for (int m = 0; m < 4; ++m) {
                    const int row = u.pm * 256 + rloc + ai * 128 + m * 16; bf16_t* mp = MG + (size_t)row * DM + u.pn * 256 + cloc;
#pragma unroll
                    for (int bj = 0; bj < 2; ++bj) {
                        const u32x4 gg = g[m][bj]; const f32x4 a0 = acc[ai][bj][m][0], a1 = acc[ai][bj][m][1]; u32x4 w;
                        w.x = pk_bf16(gclamp(bf_lo(gg.x)) * a0[0], gclamp(bf_hi(gg.x)) * a0[1]); w.y = pk_bf16(gclamp(bf_lo(gg.y)) * a0[2], gclamp(bf_hi(gg.y)) * a0[3]);
                        w.z = pk_bf16(gclamp(bf_lo(gg.z)) * a1[0], gclamp(bf_hi(gg.z)) * a1[1]); w.w = pk_bf16(gclamp(bf_lo(gg.w)) * a1[2], gclamp(bf_hi(gg.w)) * a1[3]);
                        *(u32x4*)(mp + bj * 128) = w;
                    }
                }
                asm volatile("" ::: "memory");
            }
            return;
        }
        if (kind == 5) {
            const float* SSM = (const float*)(ws + WS_SSM); const int l = u.zc, b = u.pm;
#pragma unroll
            for (int ai = 0; ai < 2; ++ai)
#pragma unroll
                for (int m = 0; m < 4; ++m) {
                    const int key = rloc + ai * 128 + m * 16, row = b * 256 + key; const float r = __builtin_amdgcn_rsqf(SSM[row] * (1.f / 1024.f) + EPS);
#pragma unroll
                    for (int bj = 0; bj < 2; ++bj) {
                        const int col = u.pn * 256 + bj * 128 + cloc;
                        const f32x4 v0 = acc[ai][bj][m][0] * r, v1 = acc[ai][bj][m][1] * r;
                        float* op = out + (col < 1024 ? O_MK : O_MV) + (size_t)l * 2097152 + (size_t)row * 1024 + (col & 1023);
                        *(f32x4*)op = v0; *(f32x4*)(op + 4) = v1;
                        const int h = (col & 1023) >> 8, d = col & 255; const size_t hb = ((size_t)(l * 8 + b) * 4 + h) * 65536;
                        if (col < 1024) {
                            u32x4 w; w.x = pk_bf16(v0[0], v0[1]); w.y = pk_bf16(v0[2], v0[3]); w.z = pk_bf16(v1[0], v1[1]); w.w = pk_bf16(v1[2], v1[3]);
                            *(u32x4*)((bf16_t*)(ws + WS_KP) + hb + (size_t)key * 256 + d) = w;
                        } else {
                            bf16_t* vt = (bf16_t*)(ws + WS_VTP) + hb + (size_t)d * 256 + key;
#pragma unroll
                            for (int j = 0; j < 4; ++j) { vt[j * 256] = (bf16_t)(pk_bf16(v0[j], 0.f) & 0xffffu); vt[(4 + j) * 256] = (bf16_t)(pk_bf16(v1[j], 0.f) & 0xffffu); }
                        }
                    }
                    asm volatile("" ::: "memory");
                }
            return;
        }
        float rs[2][4]; const float* SS = (const float*)(ws + WS_SS); const float scale = __int_as_float(dsc_i(d, 6));
#pragma unroll
        for (int ai = 0; ai < 2; ++ai)
#pragma unroll
            for (int m = 0; m < 4; ++m) {
                const f32x4 s4 = *(const f32x4*)(SS + (size_t)(u.pm * 256 + rloc + ai * 128 + m * 16) * 16 + fq * 4);
                float t = (s4[0] + s4[1]) + (s4[2] + s4[3]); t += __shfl_xor(t, 16); t += __shfl_xor(t, 32);
                rs[ai][m] = __builtin_amdgcn_rsqf(t * (1.f / 1024.f) + EPS) * scale;
            }
        switch (kind) {
            case 0: plain<0>(acc, u, rs, rloc, cloc); break;
            case 1: plain<1>(acc, u, rs, rloc, cloc); break;
            case 2: plain<2>(acc, u, rs, rloc, cloc); break;
            case 7: plain<7>(acc, u, rs, rloc, cloc); break;
            case 3: merge2<3>(acc, u, rs, rloc, cloc); break;
            default: merge2<4>(acc, u, rs, rloc, cloc); break;
        }
    }
};

DI void gemm_phase(LAS unsigned char* lds, const int K, const bool hook, const SchedU& S, const EpiU& E) {
    const int tid = opaque_tid(), wid = __builtin_amdgcn_readfirstlane(tid >> 6), lane = tid & 63, wr = wid >> 2, wc = wid & 3, fr = lane & 15, fq = lane >> 4;
    const int nt = K / BK;
    unsigned voffA[2], voffB[2];
#pragma unroll
    for (int i = 0; i < 2; ++i) { int R, C; stage_rc(tid * 16 + i * 8192, R, C); const int Rb = (R & ~31) + perm32(R & 31);
        voffA[i] = (unsigned)(R * K + C) * 2u; voffB[i] = (unsigned)(Rb * K + C) * 2u; }
    const size_t kstep = (size_t)(BK * 2);
    const size_t hstep = (size_t)HALF * K * 2;
    const unsigned ldsw = (unsigned)wid * 1024u;
    const int aoff = lds_byte(wr * 64 + fr, fq * 8), boff = lds_byte(wc * 32 + fr, fq * 8);
#define PG8_SA(b, h) (((b) * 2 + (h)) * HTB)
#define PG8_SB(b, h) ((4 + (b) * 2 + (h)) * HTB)
#define PG8_STAGE(bufoff, gbase, voff) do { _Pragma("unroll") for (int _i = 0; _i < 2; ++_i) \
        __builtin_amdgcn_global_load_lds((const unsigned*)((const char*)(gbase) + (voff)[_i]), (LAS unsigned*)(lds + (bufoff) + ldsw + _i * 8192), 16, 0, 0); } while (0)
#define PG8_LDA(dst, b, h) do { _Pragma("unroll") for (int m = 0; m < 4; ++m) _Pragma("unroll") for (int k = 0; k < 2; ++k) dst[m][k] = *(const LAS bf16x8*)(lds + PG8_SA(b, h) + aoff + m * 2048 + k * 1024); } while (0)
#define PG8_LDB(dst, b, h) do { _Pragma("unroll") for (int n = 0; n < 2; ++n) _Pragma("unroll") for (int k = 0; k < 2; ++k) dst[n][k] = *(const LAS bf16x8*)(lds + PG8_SB(b, h) + boff + n * 2048 + k * 1024); } while (0)
#define PG8_MMA(ai, bj, At, Bt) do { __builtin_amdgcn_s_setprio(1); _Pragma("unroll") for (int m = 0; m < 4; ++m) _Pragma("unroll") for (int n = 0; n < 2; ++n) _Pragma("unroll") for (int k = 0; k < 2; ++k) \
        acc[ai][bj][m][n] = __builtin_amdgcn_mfma_f32_16x16x32_bf16(Bt[n][k], At[m][k], acc[ai][bj][m][n], 0, 0, 0); __builtin_amdgcn_s_setprio(0); } while (0)
#define PG8_WAIT_V(n) asm volatile("s_waitcnt vmcnt(" #n ")" ::: "memory")
#define PG8_WAIT_L(n) asm volatile("s_waitcnt lgkmcnt(" #n ")" ::: "memory")
#define PG8_BAR __builtin_amdgcn_s_barrier()
#define PG8_SCHED __builtin_amdgcn_sched_barrier(0)
    Unit cur, nxt; int ui = 0;
    if (!S.next(0, cur)) return;
    f32x4 acc[2][2][4][2];
#pragma unroll
    for (int a = 0; a < 2; ++a)
#pragma unroll
        for (int b = 0; b < 2; ++b)
#pragma unroll
            for (int m = 0; m < 4; ++m)
#pragma unroll
                for (int n = 0; n < 2; ++n) acc[a][b][m][n] = (f32x4){0.f, 0.f, 0.f, 0.f};
    bf16x8 At[4][2], B0[2][2], B1[2][2];
    const char* cA = cur.a; const char* cB = cur.b;
    PG8_STAGE(PG8_SB(0, 0), cB, voffB); PG8_STAGE(PG8_SB(0, 1), cB + hstep, voffB); PG8_STAGE(PG8_SA(0, 0), cA, voffA); PG8_STAGE(PG8_SA(0, 1), cA + hstep, voffA);
    if (wr == 1) PG8_BAR;
    PG8_WAIT_V(2); PG8_BAR;
    PG8_STAGE(PG8_SB(1, 0), cB + kstep, voffB); PG8_STAGE(PG8_SA(1, 0), cA + kstep, voffA); PG8_STAGE(PG8_SB(1, 1), cB + hstep + kstep, voffB);
    PG8_WAIT_V(6); PG8_BAR;
    for (;;) {
        const bool has_next = S.next(ui + 1, nxt);
        const char* nA = has_next ? nxt.a : cA; const char* nB = has_next ? nxt.b : cB;
        for (int t = 0; t < nt; t += 2) {
            const bool last = (t == nt - 2);
            if (hook && t != 0 && (t & 7) == 0) E.rescale(acc, cur, t >> 3, wr, wc, fr, fq);
            asm volatile("" : "+v"(voffA[0]), "+v"(voffA[1]), "+v"(voffB[0]), "+v"(voffB[1]));
            const char* a1 = cA + (size_t)(t + 1) * kstep;
            const char* a2 = last ? nA : cA + (size_t)(t + 2) * kstep; const char* b2 = last ? nB : cB + (size_t)(t + 2) * kstep;
            const char* a3 = a2 + kstep; const char* b3 = b2 + kstep;
            PG8_LDB(B0, 0, 0); PG8_LDB(B1, 0, 1); PG8_SCHED; PG8_LDA(At, 0, 0); PG8_STAGE(PG8_SA(1, 1), a1 + hstep, voffA);
            PG8_WAIT_V(8); PG8_WAIT_L(0); PG8_BAR; PG8_MMA(0, 0, At, B0); PG8_MMA(0, 1, At, B1); PG8_BAR; PG8_SCHED;
            PG8_LDA(At, 0, 1); PG8_STAGE(PG8_SB(0, 0), b2, voffB); PG8_STAGE(PG8_SB(0, 1), b2 + hstep, voffB); PG8_STAGE(PG8_SA(0, 0), a2, voffA);
            PG8_WAIT_V(8); PG8_WAIT_L(0); PG8_BAR; PG8_MMA(1, 0, At, B0); PG8_MMA(1, 1, At, B1); PG8_BAR; PG8_SCHED;
            PG8_LDB(B0, 1, 0); PG8_LDB(B1, 1, 1); PG8_SCHED; PG8_LDA(At, 1, 0); PG8_STAGE(PG8_SA(0, 1), a2 + hstep, voffA);
            PG8_WAIT_V(8); PG8_WAIT_L(0); PG8_BAR; PG8_MMA(0, 0, At, B0); PG8_MMA(0, 1, At, B1); PG8_BAR; PG8_SCHED;
            PG8_LDA(At, 1, 1); PG8_STAGE(PG8_SB(1, 0), b3, voffB); PG8_STAGE(PG8_SB(1, 1), b3 + hstep, voffB); PG8_STAGE(PG8_SA(1, 0), a3, voffA);
            PG8_WAIT_V(8); PG8_WAIT_L(0); PG8_BAR; PG8_MMA(1, 0, At, B0); PG8_MMA(1, 1, At, B1); PG8_BAR; PG8_SCHED;
        }
        if (wr == 0) PG8_BAR;
        E(acc, cur, wr, wc, fr, fq);
        if (!has_next) break;
#pragma unroll
        for (int a = 0; a < 2; ++a)
#pragma unroll
            for (int b = 0; b < 2; ++b)
#pragma unroll
                for (int m = 0; m < 4; ++m)
#pragma unroll
                    for (int n = 0; n < 2; ++n) acc[a][b][m][n] = (f32x4){0.f, 0.f, 0.f, 0.f};
        cur = nxt; cA = nA; cB = nB; ++ui;
        if (wr == 1) PG8_BAR;
    }
    PG8_WAIT_V(0);
    PG8_BAR;
#undef PG8_SA
#undef PG8_SB
#undef PG8_STAGE
#undef PG8_LDA
#undef PG8_LDB
#undef PG8_MMA
#undef PG8_WAIT_V
#undef PG8_WAIT_L
#undef PG8_BAR
#undef PG8_SCHED
}
}

DI void transpose_item(const float* W, int K, int N, bf16_t* WT, int pitch, int k0, int n0, int drow0, const float* gk, float* scr, int lane) {
#pragma unroll
    for (int i = 0; i < 32; ++i) { const int kk = 2 * i + (lane >> 5); float v = W[(size_t)(k0 + kk) * N + n0 + (lane & 31)]; if (gk) v *= gk[k0 + kk]; scr[kk * 33 + (lane & 31)] = v; }
    asm volatile("s_waitcnt lgkmcnt(0)" ::: "memory");
    const int c = lane & 7;
#pragma unroll
    for (int j = 0; j < 4; ++j) { const int n = (lane >> 3) + 8 * j; const float* s = scr + (8 * c) * 33 + n;
        u32x4 o; o.x = pk_bf16(s[0 * 33], s[1 * 33]); o.y = pk_bf16(s[2 * 33], s[3 * 33]); o.z = pk_bf16(s[4 * 33], s[5 * 33]); o.w = pk_bf16(s[6 * 33], s[7 * 33]);
        *(u32x4*)(WT + (size_t)(drow0 + n) * pitch + k0 + 8 * c) = o; }
    asm volatile("s_waitcnt lgkmcnt(0)" ::: "memory");
}
DI int win_block_map(int sb) {
    if (sb < 4) return sb;
    if (sb < 8) return 4 + 2 * (sb - 4);
    if (sb < 12) return 12 + (sb - 8);
    if (sb < 16) return 5 + 2 * (sb - 12);
    if (sb < 24) return sb;
    if (sb < 28) return 24 + 2 * (sb - 24);
    if (sb < 32) return 25 + 2 * (sb - 28);
    return sb;
}
DI float row_to_bf16(const float* xrow, bf16_t* orow, int lane) {
    const f32x4* xr = (const f32x4*)xrow + lane; float s = 0.f; f32x4 v[4];
#pragma unroll
    for (int j = 0; j < 4; ++j) { v[j] = xr[64 * j]; s += (v[j].x * v[j].x + v[j].y * v[j].y) + (v[j].z * v[j].z + v[j].w * v[j].w); }
    u32x2* o = (u32x2*)orow + lane;
#pragma unroll
    for (int j = 0; j < 4; ++j) { u32x2 w; w.x = pk_bf16(v[j].x, v[j].y); w.y = pk_bf16(v[j].z, v[j].w); o[64 * j] = w; }
    return wave_sum(s);
}

DI void prologue(const Params& p, unsigned char* lds, int G, int mask) {
    const int tid = opaque_tid(), lane = tid & 63, wave = __builtin_amdgcn_readfirstlane(tid >> 6);
    float* scr = (float*)(lds + wave * 16384);
    const int gw = opaque_bid() * 8 + wave, NGW = G * 8;
    unsigned char* ws = ws_of(p);
    {
        constexpr int T_IN = 16 * 64, T_BR = 8 * 8, T_SQ = 16 * 8, T_F1 = 16 * 32, T_F2 = 64 * 8;
        constexpr int T_L = T_IN + 3 * T_BR + 5 * T_SQ + T_F1 + T_F2;
        unsigned* Tl = (unsigned*)lds;
        const int lr = tid >> 5, lc = (tid & 31) * 4;
        f32x4 cur[4], nxt[4]; const float* gk_c = nullptr; const float* gk_n = nullptr;
        bf16_t* WT_c = nullptr; bf16_t* WT_n = nullptr; int pitch_c = 0, pitch_n = 0, k0_c = 0, k0_n = 0, dr_c = 0, dr_n = 0;
#define TR_SETUP(it_, W_, N_, WT_, pitch_, gk_, k0_, n0_, dr_) do { \
            const int l_ = (it_) / T_L; int r_ = (it_) % T_L; bool is_in_ = false; int K_; (gk_) = nullptr; (pitch_) = 0; \
            if (r_ < T_IN) { W_ = p.in[9] + (size_t)l_ * 1024 * 8192; K_ = 1024; N_ = 8192; WT_ = (bf16_t*)(ws + WS_WIN) + (size_t)l_ * 8192 * 1024; gk_ = p.in[8] + l_ * 1024; is_in_ = true; } \
            else if ((r_ -= T_IN) < 3 * T_BR) { const int k_ = 1 + r_ / T_BR; r_ %= T_BR; W_ = p.in[21] + ((size_t)l_ * 4 + k_) * 512 * 1024; K_ = 512; N_ = 1024; WT_ = (bf16_t*)(ws + WS_WB) + (size_t)l_ * 2097152 + k_ * 512; pitch_ = 2048; } \
            else if ((r_ -= 3 * T_BR) < 5 * T_SQ) { const int w_ = r_ / T_SQ; r_ %= T_SQ; K_ = 1024; N_ = 1024; \
                if (w_ == 0) { W_ = p.in[23] + (size_t)l_ * 1048576; WT_ = (bf16_t*)(ws + WS_WMIX) + (size_t)l_ * 1048576; } \
                else if (w_ == 1) { W_ = p.in[26] + (size_t)l_ * 1048576; WT_ = (bf16_t*)(ws + WS_WQ) + (size_t)l_ * 1048576; gk_ = p.in[24] + l_ * 1024; } \
                else if (w_ == 2) { W_ = p.in[27] + (size_t)l_ * 1048576; WT_ = (bf16_t*)(ws + WS_WKV) + (size_t)l_ * 2097152; gk_ = p.in[25] + l_ * 1024; } \
                else if (w_ == 3) { W_ = p.in[28] + (size_t)l_ * 1048576; WT_ = (bf16_t*)(ws + WS_WKV) + (size_t)l_ * 2097152 + 1048576; gk_ = p.in[25] + l_ * 1024; } \
                else { W_ = p.in[29] + (size_t)l_ * 1048576; WT_ = (bf16_t*)(ws + WS_WO) + (size_t)l_ * 1048576; } } \
            else if ((r_ -= 5 * T_SQ) < T_F1) { W_ = p.in[31] + (size_t)l_ * 4194304; K_ = 1024; N_ = 4096; WT_ = (bf16_t*)(ws + WS_W1) + (size_t)l_ * 4194304; gk_ = p.in[30] + l_ * 1024; } \
            else { r_ -= T_F1; W_ = p.in[32] + (size_t)l_ * 4194304; K_ = 4096; N_ = 1024; WT_ = (bf16_t*)(ws + WS_W2) + (size_t)l_ * 4194304; } \
            if (!(pitch_)) (pitch_) = K_; \
            const int nblk_ = N_ / 128; (k0_) = 64 * (r_ / nblk_); (n0_) = 128 * (r_ % nblk_); (dr_) = is_in_ ? win_block_map((n0_) >> 7) * 128 : (n0_); } while (0)
        int it = opaque_bid();
        if ((mask & 1) && it < 2 * T_L) {
            { const float* W; int N, n0; TR_SETUP(it, W, N, WT_c, pitch_c, gk_c, k0_c, n0, dr_c);
#pragma unroll
              for (int i = 0; i < 4; ++i) cur[i] = *(const f32x4*)(W + (size_t)(k0_c + lr + 16 * i) * N + n0 + lc); }
            for (; it < 2 * T_L; it += G) {
                const int itn = it + G; const bool has_n = itn < 2 * T_L;
                if (has_n) { const float* W; int N, n0; TR_SETUP(itn, W, N, WT_n, pitch_n, gk_n, k0_n, n0, dr_n);
#pragma unroll
                    for (int i = 0; i < 4; ++i) nxt[i] = *(const f32x4*)(W + (size_t)(k0_n + lr + 16 * i) * N + n0 + lc); }
                unsigned short* Th = (unsigned short*)Tl;
#pragma unroll
                for (int i = 0; i < 4; ++i) {
                    const int kk = lr + 16 * i; const float g = gk_c ? gk_c[k0_c + kk] : 1.f; const f32x4 v = cur[i] * g;
#pragma unroll
                    for (int j = 0; j < 4; ++j) Th[(lc + j) * 66 + kk] = (unsigned short)(pk_bf16(v[j], 0.f) & 0xffffu);
                }
                __syncthreads();
#pragma unroll
                for (int q = 0; q < 2; ++q) {
                    const int idx = tid + 512 * q, n = idx >> 3, c = idx & 7; const unsigned* src = Tl + n * 33 + c * 4;
                    u32x4 o; o.x = src[0]; o.y = src[1]; o.z = src[2]; o.w = src[3];
                    *(u32x4*)(WT_c + (size_t)(dr_c + n) * pitch_c + k0_c + 8 * c) = o;
                }
                __syncthreads();
#pragma unroll
                for (int i = 0; i < 4; ++i) cur[i] = nxt[i];
                gk_c = gk_n; WT_c = WT_n; pitch_c = pitch_n; k0_c = k0_n; dr_c = dr_n;
            }
        }
#undef TR_SETUP
        __syncthreads();
    }
    if (mask & 2)
    for (int it = opaque_bid(); it < 2 * 4 * 32; it += G) {
        const int l = it >> 7, g = (it >> 5) & 3, db = it & 31;
        float* pwT = (float*)lds;
        __syncthreads();
        {
            const float* pw = p.in[10] + ((size_t)l * 4 + g) * 16384; const float* sc = p.in[11] + l * 512 + g * 128;
#pragma unroll 8
            for (int e = tid; e < 16384; e += 512) { const int i = e >> 7, j = e & 127; pwT[j * 132 + i] = pw[e] * sc[j]; }
        }
        __syncthreads();
        const int d = db * 32 + (tid & 31), i0 = (tid >> 5) * 8;
        const float* wb = p.in[21] + ((size_t)l * 4) * 512 * 1024 + (size_t)(g * 128) * 1024 + d;
        float a[8];
#pragma unroll
        for (int r = 0; r < 8; ++r) a[r] = 0.f;
#pragma unroll 16
        for (int j = 0; j < 128; ++j) {
            const float w = wb[(size_t)j * 1024];
            const f32x4 p0 = *(const f32x4*)(pwT + j * 132 + i0), p1 = *(const f32x4*)(pwT + j * 132 + i0 + 4);
            a[0] += p0[0] * w; a[1] += p0[1] * w; a[2] += p0[2] * w; a[3] += p0[3] * w; a[4] += p1[0] * w; a[5] += p1[1] * w; a[6] += p1[2] * w; a[7] += p1[3] * w;
        }
        bf16_t* o = (bf16_t*)(ws + WS_WB) + (size_t)l * 2097152 + (size_t)d * 2048 + g * 128 + i0;
        u32x4 w0; w0.x = pk_bf16(a[0], a[1]); w0.y = pk_bf16(a[2], a[3]); w0.z = pk_bf16(a[4], a[5]); w0.w = pk_bf16(a[6], a[7]);
        *(u32x4*)o = w0;
    }
    __syncthreads();
    if (mask & 4) {
    for (int e = opaque_bid() * 512 + tid; e < 2 * 4 * 128 * 128; e += G * 512) {
        const int t = (e >> 7) & 127, s = e & 127; const float v = (s <= t) ? p.in[15][e] : 0.f;
        ((bf16_t*)(ws + WS_SGUW))[e] = (bf16_t)(pk_bf16(v, 0.f) & 0xffffu);
    }
    float* SS = (float*)(ws + WS_SS);
    for (int m0 = gw; m0 < MT; m0 += 2 * NGW) {
        const int m1 = m0 + NGW; const bool two = m1 < MT;
        const float* x0 = (m0 < MP) ? p.in[0] + (size_t)m0 * DM : p.in[1] + (size_t)(m0 - MP) * DM;
        const float* x1 = two ? ((m1 < MP) ? p.in[0] + (size_t)m1 * DM : p.in[1] + (size_t)(m1 - MP) * DM) : x0;
        f32x4 v0[4], v1[4];
#pragma unroll
        for (int j = 0; j < 4; ++j) { v0[j] = ((const f32x4*)x0)[lane + 64 * j]; v1[j] = ((const f32x4*)x1)[lane + 64 * j]; }
        float s0 = 0.f, s1 = 0.f;
#pragma unroll
        for (int j = 0; j < 4; ++j) { s0 += (v0[j].x * v0[j].x + v0[j].y * v0[j].y) + (v0[j].z * v0[j].z + v0[j].w * v0[j].w); s1 += (v1[j].x * v1[j].x + v1[j].y * v1[j].y) + (v1[j].z * v1[j].z + v1[j].w * v1[j].w); }
        u32x2* o0 = (u32x2*)((bf16_t*)(ws + WS_XB) + (size_t)m0 * DM) + lane;
#pragma unroll
        for (int j = 0; j < 4; ++j) { u32x2 w; w.x = pk_bf16(v0[j].x, v0[j].y); w.y = pk_bf16(v0[j].z, v0[j].w); o0[64 * j] = w; }
        s0 = wave_sum(s0);
        if (lane < 16) SS[(size_t)m0 * 16 + lane] = (lane == 0) ? s0 : 0.f;
        if (two) {
            u32x2* o1 = (u32x2*)((bf16_t*)(ws + WS_XB) + (size_t)m1 * DM) + lane;
#pragma unroll
            for (int j = 0; j < 4; ++j) { u32x2 w; w.x = pk_bf16(v1[j].x, v1[j].y); w.y = pk_bf16(v1[j].z, v1[j].w); o1[64 * j] = w; }
            s1 = wave_sum(s1);
            if (lane < 16) SS[(size_t)m1 * 16 + lane] = (lane == 0) ? s1 : 0.f;
        }
    }
    for (int m = gw; m < 2048; m += NGW) {
        const float s = row_to_bf16(p.in[7] + (size_t)m * DM, (bf16_t*)(ws + WS_MB) + (size_t)m * DM, lane);
        if (lane == 0) ((float*)(ws + WS_SSM))[m] = s;
    }
    }
}

template <bool SAMPLE, int NROWS>
DI void stage_rows(float* tile, int hist, const float* state, const bf16_t* Zcol, int rowbase, int tt0, float* outp, int ncarry, bool write_carry, int tid) {
    constexpr int ITER = (NROWS * 64 + 511) / 512;
    u32x4 vb[ITER]; f32x4 slo[ITER], shi[ITER];
#pragma unroll
    for (int i = 0; i < ITER; ++i) {
        const int c = tid + 512 * i, k = c >> 6, cc = (c & 63) * 8;
        vb[i] = (u32x4){0u, 0u, 0u, 0u}; slo[i] = (f32x4){0.f, 0.f, 0.f, 0.f}; shi[i] = (f32x4){0.f, 0.f, 0.f, 0.f};
        if (c < NROWS * 64) {
            if (SAMPLE) {
                if (k < hist) { slo[i] = *(const f32x4*)(state + (size_t)k * WBR + cc); shi[i] = *(const f32x4*)(state + (size_t)k * WBR + cc + 4); }
                else vb[i] = *(const u32x4*)(Zcol + (size_t)(rowbase + k - hist) * ZP + cc);
            } else {
                const int t = tt0 - hist + k;
                if (t >= 0) vb[i] = *(const u32x4*)(Zcol + (size_t)(rowbase + t) * ZP + cc);
            }
        }
    }
#pragma unroll
    for (int i = 0; i < ITER; ++i) {
        const int c = tid + 512 * i, k = c >> 6, cc = (c & 63) * 8;
        if (c < NROWS * 64) {
            f32x4 lo, hi; int ci;
            const u32x4 v = vb[i];
            lo = (f32x4){bf_lo(v.x), bf_hi(v.x), bf_lo(v.y), bf_hi(v.y)}; hi = (f32x4){bf_lo(v.z), bf_hi(v.z), bf_lo(v.w), bf_hi(v.w)};
            if (SAMPLE) { if (k < hist) { lo = slo[i]; hi = shi[i]; } ci = k - (NROWS - ncarry); }
            else ci = (tt0 - hist + k) - (SEQ - ncarry);
            *(f32x4*)(tile + k * WBR + cc) = lo; *(f32x4*)(tile + k * WBR + cc + 4) = hi;
            if (write_carry && ci >= 0) { *(f32x4*)(outp + (size_t)ci * WBR + cc) = lo; *(f32x4*)(outp + (size_t)ci * WBR + cc + 4) = hi; }
        }
    }
}
template <int NT, int W> DI void pool_compute(const float* tile, int ch, int tt0, bool sample, float (&o)[NT]) {
    float e[NT + 15];
#pragma unroll
    for (int k = 0; k < NT + 15; ++k) e[k] = tile[k * WBR + ch];
#pragma unroll
    for (int j = 0; j < NT; ++j) {
        float s = 0.f;
#pragma unroll
        for (int i = 0; i < W; ++i) s += e[j + 15 - i];
        const int pos = tt0 + j; const float inv = (sample || pos + 1 >= W) ? 1.f / (float)W : 1.f / (float)(pos + 1);
        o[j] = s * inv - e[j + 15];
    }
}
struct ConvConst { float cw[31]; float cb, lng, lnb, sw0, sw1, sw2, sg, sb; };
template <int NT, bool SAMPLE>
DI void conv_item(const Params& p, int l, int b, int tt0, const ConvConst& cc, float* tile, float* red, int tid, int lane, int wave) {
    const bf16_t* Z = (const bf16_t*)(ws_of(p) + WS_Z); const int ch = tid;
    const int rowbase = SAMPLE ? MP + b * NSQ : b * SEQ; const int row0 = SAMPLE ? rowbase : rowbase + tt0;
    const bool lastp = SAMPLE || (tt0 + NT == SEQ);
    stage_rows<SAMPLE, NT + 15>(tile, 15, SAMPLE ? p.in[2] + ((size_t)l * NSB + b) * 15 * WBR : nullptr, Z, rowbase, tt0,
                       SAMPLE ? out_of(p) + O_POOLS + ((size_t)l * NSB + b) * 15 * WBR : out_of(p) + O_POOLP + ((size_t)l * NB + b) * 15 * WBR, 15, lastp, tid);
    __syncthreads();
    {
        float o[NT];
        switch (wave >> 1) {
            case 0: pool_compute<NT, 2>(tile, ch, tt0, SAMPLE, o); break;
            case 1: pool_compute<NT, 4>(tile, ch, tt0, SAMPLE, o); break;
            case 2: pool_compute<NT, 8>(tile, ch, tt0, SAMPLE, o); break;
            default: pool_compute<NT, 16>(tile, ch, tt0, SAMPLE, o); break;
        }
        bf16_t* BR0 = (bf16_t*)(ws_of(p) + WS_BR) + (size_t)row0 * 2048 + ch;
#pragma unroll
        for (int j = 0; j < NT; ++j) BR0[j * 2048] = (bf16_t)(pk_bf16(o[j], 0.f) & 0xffffu);
    }
    __syncthreads();
    stage_rows<SAMPLE, NT + 2>(tile, 2, SAMPLE ? p.in[3] + ((size_t)l * NSB + b) * 2 * WBR : nullptr, Z + 512, rowbase, tt0,
                       SAMPLE ? out_of(p) + O_SCS + ((size_t)l * NSB + b) * 2 * WBR : out_of(p) + O_SCP + ((size_t)l * NB + b) * 2 * WBR, 2, lastp, tid);
    stage_rows<false, NT>(tile + (NT + 2) * WBR, 0, nullptr, Z + 1024, row0, 0, nullptr, 0, false, tid);
    __syncthreads();
    {
        bf16_t* BR1 = (bf16_t*)(ws_of(p) + WS_BR) + (size_t)row0 * 2048 + 512 + ch;
#pragma unroll
        for (int j = 0; j < NT; ++j) {
            const float c = cc.sw0 * tile[j * WBR + ch] + cc.sw1 * tile[(j + 1) * WBR + ch] + cc.sw2 * tile[(j + 2) * WBR + ch];
            BR1[j * 2048] = (bf16_t)(pk_bf16(tile[(NT + 2 + j) * WBR + ch] * c, 0.f) & 0xffffu);
        }
    }
    __syncthreads();
    stage_rows<SAMPLE, NT + 30>(tile, 30, SAMPLE ? p.in[4] + ((size_t)l * NSB + b) * 30 * WBR : nullptr, Z + 2560, rowbase, tt0,
                       SAMPLE ? out_of(p) + O_CCS + ((size_t)l * NSB + b) * 30 * WBR : out_of(p) + O_CCP + ((size_t)l * NB + b) * 30 * WBR, 30, lastp, tid);
    __syncthreads();
    float a[NT];
#pragma unroll
    for (int j = 0; j < NT; ++j) a[j] = cc.cb;
#pragma unroll
    for (int k = 0; k < NT + 30; ++k) {
        const float v = tile[k * WBR + ch];
#pragma unroll
        for (int j = 0; j < NT; ++j) { const int tap = k - j; if (tap >= 0 && tap <= 30) a[j] += cc.cw[tap] * v; }
    }
#pragma unroll
    for (int j = 0; j < NT; ++j) {
        const float s1 = wave_sum(a[j]), s2 = wave_sum(a[j] * a[j]);
        if (lane == 0) { red[(wave * NT + j) * 2] = s1; red[(wave * NT + j) * 2 + 1] = s2; }
    }
    __syncthreads();
    {
        bf16_t* BR3 = (bf16_t*)(ws_of(p) + WS_BR) + (size_t)row0 * 2048 + 1536 + ch;
#pragma unroll
        for (int j = 0; j < NT; ++j) {
            float s1 = 0.f, s2 = 0.f;
#pragma unroll
            for (int w = 0; w < 8; ++w) { s1 += red[(w * NT + j) * 2]; s2 += red[(w * NT + j) * 2 + 1]; }
            const float mean = s1 * (1.f / 512.f), var = fmaxf(s2 * (1.f / 512.f) - mean * mean, 0.f), rstd = __builtin_amdgcn_rsqf(var + EPS);
            const float y = (a[j] - mean) * rstd * cc.lng + cc.lnb;
            BR3[j * 2048] = (bf16_t)(pk_bf16(y * sigmoidf_(y), 0.f) & 0xffffu);
        }
    }
    __syncthreads();
    if (SAMPLE) {
        stage_rows<false, NT>(tile, 0, nullptr, Z + 2048, row0, 0, nullptr, 0, false, tid);
        stage_rows<false, NT>(tile + NT * WBR, 0, nullptr, Z + 1536, row0, 0, nullptr, 0, false, tid);
        __syncthreads();
        float v[NT];
#pragma unroll
        for (int j = 0; j < NT; ++j) {
            v[j] = tile[j * WBR + ch];
            const float s1 = wave_sum(v[j]), s2 = wave_sum(v[j] * v[j]);
            if (lane == 0) { red[(wave * NT + j) * 2] = s1; red[(wave * NT + j) * 2 + 1] = s2; }
        }
        __syncthreads();
        float* ov = out_of(p) + O_SGUV + (((size_t)l * NSB + b) * NSQ) * WBR + ch;
#pragma unroll
        for (int j = 0; j < NT; ++j) {
            float s1 = 0.f, s2 = 0.f;
#pragma unroll
            for (int w = 0; w < 8; ++w) { s1 += red[(w * NT + j) * 2]; s2 += red[(w * NT + j) * 2 + 1]; }
            const float mean = s1 * (1.f / 512.f), var = fmaxf(s2 * (1.f / 512.f) - mean * mean, 0.f), rstd = __builtin_amdgcn_rsqf(var + EPS);
            v[j] = (v[j] - mean) * rstd * cc.sg + cc.sb;
            ov[j * WBR] = v[j];
        }
        const int g = wave >> 1;
        const float* Wg = p.in[15] + ((size_t)l * 4 + g) * 128 * 128; const float* bs = p.in[16] + ((size_t)l * 4 + g) * 128;
        bf16_t* BR2 = (bf16_t*)(ws_of(p) + WS_BR) + (size_t)row0 * 2048 + 1024 + ch;
#pragma unroll
        for (int t = 0; t < NT; ++t) {
            float s0 = bs[t];
#pragma unroll
            for (int s = 0; s <= t; ++s) s0 += Wg[t * 128 + s] * v[s];
            BR2[t * 2048] = (bf16_t)(pk_bf16(tile[(NT + t) * WBR + ch] * s0, 0.f) & 0xffffu);
        }
        __syncthreads();
    }
}

DI float ldh(const bf16_t* t, int idx) { return __uint_as_float((unsigned)t[idx] << 16); }
template <int W> DI void pool_compute_h(const bf16_t* tile, int ch, int tt0, float (&o)[16]) {
    float e[31];
#pragma unroll
    for (int k = 0; k < 31; ++k) e[k] = ldh(tile, k * WBR + ch);
#pragma unroll
    for (int j = 0; j < 16; ++j) {
        float s = 0.f;
#pragma unroll
        for (int i = 0; i < W; ++i) s += e[j + 15 - i];
        const int pos = tt0 + j; const float inv = (pos + 1 >= W) ? 1.f / (float)W : 1.f / (float)(pos + 1);
        o[j] = s * inv - e[j + 15];
    }
}
DI void conv_item_p(const Params& p, int l, int b, int tt0, const ConvConst& cc, unsigned char* lds, float* red, int tid, int lane, int wave) {
    constexpr int NT = 16, RA = 0, RB = 31, RBB = 49, RD = 65, NR = 111;
    const bf16_t* Z = (const bf16_t*)(ws_of(p) + WS_Z); const int ch = tid;
    const int rowbase = b * SEQ, row0 = rowbase + tt0; const bool lastp = (tt0 + NT == SEQ);
    bf16_t* tile = (bf16_t*)lds;
    {
        constexpr int ITER = (NR * 64 + 511) / 512, HB = ITER / 2;
#pragma unroll 1
        for (int h = 0; h < 2; ++h) {
            u32x4 vb[HB];
#pragma unroll
            for (int i = 0; i < HB; ++i) {
                const int c = tid + 512 * (h * HB + i), r = c >> 6, cc8 = (c & 63) * 8; vb[i] = (u32x4){0u, 0u, 0u, 0u};
                if (c < NR * 64) {
                    int hist, col, kk;
                    if (r < RB) { hist = 15; col = 0; kk = r; } else if (r < RBB) { hist = 2; col = 512; kk = r - RB; } else if (r < RD) { hist = 0; col = 1024; kk = r - RBB; } else { hist = 30; col = 2560; kk = r - RD; }
                    const int t = tt0 - hist + kk;
                    if (t >= 0) vb[i] = *(const u32x4*)(Z + (size_t)(rowbase + t) * ZP + col + cc8);
                }
            }
#pragma unroll
            for (int i = 0; i < HB; ++i) {
                const int c = tid + 512 * (h * HB + i), r = c >> 6, cc8 = (c & 63) * 8;
                if (c < NR * 64) *(u32x4*)(tile + r * WBR + cc8) = vb[i];
            }
        }
    }
    __syncthreads();
    if (lastp) {
#pragma unroll 1
        for (int c = tid; c < NR * 64; c += 512) {
            const int r = c >> 6, cc8 = (c & 63) * 8;
            if (r < RBB || r >= RD) {
                int hist, kk, nc; size_t ob;
                if (r < RB) { hist = 15; kk = r; nc = 15; ob = O_POOLP + ((size_t)l * NB + b) * 15 * WBR; }
                else if (r < RBB) { hist = 2; kk = r - RB; nc = 2; ob = O_SCP + ((size_t)l * NB + b) * 2 * WBR; }
                else { hist = 30; kk = r - RD; nc = 30; ob = O_CCP + ((size_t)l * NB + b) * 30 * WBR; }
                const int ci = (tt0 - hist + kk) - (SEQ - nc);
                if (ci >= 0) { const u32x4 v = *(const u32x4*)(tile + r * WBR + cc8); float* o = out_of(p) + ob + (size_t)ci * WBR + cc8;
                    *(f32x4*)o = (f32x4){bf_lo(v.x), bf_hi(v.x), bf_lo(v.y), bf_hi(v.y)}; *(f32x4*)(o + 4) = (f32x4){bf_lo(v.z), bf_hi(v.z), bf_lo(v.w), bf_hi(v.w)}; }
            }
        }
    }
    float oA[NT], oB[NT];
    switch (wave >> 1) {
        case 0: pool_compute_h<2>(tile + RA * WBR, ch, tt0, oA); break;
        case 1: pool_compute_h<4>(tile + RA * WBR, ch, tt0, oA); break;
        case 2: pool_compute_h<8>(tile + RA * WBR, ch, tt0, oA); break;
        default: pool_compute_h<16>(tile + RA * WBR, ch, tt0, oA); break;
    }
    {
        const bf16_t* tb = tile + RB * WBR; const bf16_t* tbb = tile + RBB * WBR;
#pragma unroll
        for (int j = 0; j < NT; ++j) {
            const float c = cc.sw0 * ldh(tb, j * WBR + ch) + cc.sw1 * ldh(tb, (j + 1) * WBR + ch) + cc.sw2 * ldh(tb, (j + 2) * WBR + ch);
            oB[j] = ldh(tbb, j * WBR + ch) * c;
        }
    }
    float a[NT];
#pragma unroll
    for (int j = 0; j < NT; ++j) a[j] = cc.cb;
    {
        const bf16_t* td = tile + RD * WBR;
#pragma unroll
        for (int k = 0; k < NT + 30; ++k) {
            const float v = ldh(td, k * WBR + ch);
#pragma unroll
            for (int j = 0; j < NT; ++j) { const int tap = k - j; if (tap >= 0 && tap <= 30) a[j] += cc.cw[tap] * v; }
        }
    }
    {
        float v[2 * NT];
#pragma unroll
        for (int j = 0; j < NT; ++j) { v[2 * j] = a[j]; v[2 * j + 1] = a[j] * a[j]; }
        XReduce<2 * NT, 32>::run(v, lane);
        const int idx = lane >> 1;
        if ((lane & 1) == 0) red[((idx >> 1) * 8 + wave) * 2 + (idx & 1)] = v[0];
    }
    __syncthreads();
#pragma unroll
    for (int j = 0; j < NT; ++j) {
        const f32x4* rp = (const f32x4*)(red + j * 16); const f32x4 r0 = rp[0], r1 = rp[1], r2 = rp[2], r3 = rp[3];
        const float s1 = (r0[0] + r0[2]) + (r1[0] + r1[2]) + (r2[0] + r2[2]) + (r3[0] + r3[2]), s2 = (r0[1] + r0[3]) + (r1[1] + r1[3]) + (r2[1] + r2[3]) + (r3[1] + r3[3]);
        const float mean = s1 * (1.f / 512.f), var = fmaxf(s2 * (1.f / 512.f) - mean * mean, 0.f), rstd = __builtin_amdgcn_rsqf(var + EPS);
        const float y = (a[j] - mean) * rstd * cc.lng + cc.lnb;
        tile[(0 * NT + j) * WBR + ch] = (bf16_t)(pk_bf16(oA[j], 0.f) & 0xffffu);
        tile[(1 * NT + j) * WBR + ch] = (bf16_t)(pk_bf16(oB[j], 0.f) & 0xffffu);
        tile[(2 * NT + j) * WBR + ch] = (bf16_t)(pk_bf16(y * sigmoidf_(y), 0.f) & 0xffffu);
    }
    __syncthreads();
    {
        bf16_t* BRb = (bf16_t*)(ws_of(p) + WS_BR) + (size_t)row0 * 2048;
#pragma unroll
        for (int q = 0; q < 6; ++q) {
            const int idx = tid + 512 * q, br = idx >> 10, j = (idx >> 6) & 15, c8 = (idx & 63) * 8;
            const u32x4 v = *(const u32x4*)(tile + (br * NT + j) * WBR + c8);
            *(u32x4*)(BRb + (size_t)j * 2048 + (br == 2 ? 1536 : br * 512) + c8) = v;
        }
    }
    __syncthreads();
}

DI void sgu_item(const Params& p, int l, int it, unsigned char* lds) {
    const int tid = opaque_tid(), lane = tid & 63, wave = __builtin_amdgcn_readfirstlane(tid >> 6);
    const int g = it & 3, chunk = (it >> 2) & 15, b = it >> 6;
    const int rowbase = b * SEQ + chunk * 128;
    const bf16_t* Z = (const bf16_t*)(ws_of(p) + WS_Z);
    bf16_t* vnT = (bf16_t*)lds;
    float* Sb = (float*)(lds + 36864);
    {
        u32x4 v[16];
#pragma unroll
        for (int r = 0; r < 16; ++r) v[r] = *(const u32x4*)(Z + (size_t)(rowbase + wave * 16 + r) * ZP + 2048 + lane * 8);
        float s1[16], s2[16];
#pragma unroll
        for (int r = 0; r < 16; ++r) {
            const float x[8] = {bf_lo(v[r].x), bf_hi(v[r].x), bf_lo(v[r].y), bf_hi(v[r].y), bf_lo(v[r].z), bf_hi(v[r].z), bf_lo(v[r].w), bf_hi(v[r].w)};
            float a = 0.f, q = 0.f;
#pragma unroll
            for (int i = 0; i < 8; ++i) { a += x[i]; q += x[i] * x[i]; }
            s1[r] = a; s2[r] = q;
        }
        {
            float vv[32];
#pragma unroll
            for (int r = 0; r < 16; ++r) { vv[2 * r] = s1[r]; vv[2 * r + 1] = s2[r]; }
            XReduce<32, 32>::run(vv, lane);
            float* sb = (float*)(lds + LDS_MISC + 1024) + wave * 32;
            if ((lane & 1) == 0) sb[lane >> 1] = vv[0];
            asm volatile("s_waitcnt lgkmcnt(0)" ::: "memory");
#pragma unroll
            for (int r = 0; r < 16; ++r) { s1[r] = sb[2 * r]; s2[r] = sb[2 * r + 1]; }
            asm volatile("" ::: "memory");
        }
        if ((lane >> 4) == g) {
            const int c0 = (lane & 15) * 8;
            const f32x4 gA = *(const f32x4*)(p.in[13] + l * WBR + lane * 8), gB = *(const f32x4*)(p.in[13] + l * WBR + lane * 8 + 4);
            const f32x4 bA = *(const f32x4*)(p.in[14] + l * WBR + lane * 8), bB = *(const f32x4*)(p.in[14] + l * WBR + lane * 8 + 4);
            const float gg[8] = {gA.x, gA.y, gA.z, gA.w, gB.x, gB.y, gB.z, gB.w}, bb[8] = {bA.x, bA.y, bA.z, bA.w, bB.x, bB.y, bB.z, bB.w};
#pragma unroll
            for (int r = 0; r < 16; ++r) {
                const int s = wave * 16 + r;
                const float mean = s1[r] * (1.f / 512.f), var = fmaxf(s2[r] * (1.f / 512.f) - mean * mean, 0.f), rstd = __builtin_amdgcn_rsqf(var + EPS);
                const float x[8] = {bf_lo(v[r].x), bf_hi(v[r].x), bf_lo(v[r].y), bf_hi(v[r].y), bf_lo(v[r].z), bf_hi(v[r].z), bf_lo(v[r].w), bf_hi(v[r].w)};
#pragma unroll
                for (int i = 0; i < 8; ++i) { const float y = (x[i] - mean) * rstd * gg[i] + bb[i]; vnT[(c0 + i) * 136 + s] = (bf16_t)(pk_bf16(y, 0.f) & 0xffffu); }
            }
        }
    }
    __syncthreads();
    {
        const int fr = lane & 15, kq = lane >> 4;
        f32x4 acc[8];
#pragma unroll
        for (int cb = 0; cb < 8; ++cb) acc[cb] = (f32x4){0.f, 0.f, 0.f, 0.f};
        const bf16_t* Wt = (const bf16_t*)(ws_of(p) + WS_SGUW) + ((size_t)l * 4 + g) * 16384 + (size_t)(wave * 16 + fr) * 128 + kq * 8;
        const int nks = (wave >> 1) + 1;
        for (int ks = 0; ks < nks; ++ks) {
            const bf16x8 a = *(const bf16x8*)(Wt + ks * 32);
#pragma unroll
            for (int cb = 0; cb < 8; ++cb) {
                const bf16x8 bfr = *(const bf16x8*)(vnT + (cb * 16 + fr) * 136 + ks * 32 + kq * 8);
                acc[cb] = __builtin_amdgcn_mfma_f32_16x16x32_bf16(a, bfr, acc[cb], 0, 0, 0);
            }
        }
        const float* bs = p.in[16] + ((size_t)l * 4 + g) * 128;
#pragma unroll
        for (int j = 0; j < 4; ++j) {
            const int t = wave * 16 + kq * 4 + j; const float bt = bs[t];
#pragma unroll
            for (int cb = 0; cb < 8; ++cb) Sb[t * 132 + cb * 16 + fr] = acc[cb][j] + bt;
        }
    }
    __syncthreads();
    {
        bf16_t* BR2 = (bf16_t*)(ws_of(p) + WS_BR) + 1024 + g * 128;
        u32x4 cu[4];
#pragma unroll
        for (int q = 0; q < 4; ++q) { const int idx = tid + 512 * q, t = idx >> 4, c8 = (idx & 15) * 8; cu[q] = *(const u32x4*)(Z + (size_t)(rowbase + t) * ZP + 1536 + g * 128 + c8); }
#pragma unroll
        for (int q = 0; q < 4; ++q) {
            const int idx = tid + 512 * q, t = idx >> 4, c8 = (idx & 15) * 8;
            const f32x4 sa = *(const f32x4*)(Sb + t * 132 + c8), sb = *(const f32x4*)(Sb + t * 132 + c8 + 4); const u32x4 u = cu[q]; u32x4 w;
            w.x = pk_bf16(bf_lo(u.x) * sa[0], bf_hi(u.x) * sa[1]); w.y = pk_bf16(bf_lo(u.y) * sa[2], bf_hi(u.y) * sa[3]);
            w.z = pk_bf16(bf_lo(u.z) * sb[0], bf_hi(u.z) * sb[1]); w.w = pk_bf16(bf_lo(u.w) * sb[2], bf_hi(u.w) * sb[3]);
            *(u32x4*)(BR2 + (size_t)(rowbase + t) * 2048 + c8) = w;
        }
    }
    __syncthreads();
}

DI void branch_phase(const Params& p, int l, unsigned char* lds, int G, int mask) {
    const int tid = opaque_tid(), lane = tid & 63, wave = __builtin_amdgcn_readfirstlane(tid >> 6);
    float* red = (float*)(lds + LDS_MISC); float* tile = (float*)lds;
    if (mask & 1) {
        const int bid = opaque_bid();
        if (G == 256) {
            if (bid < 128) { if (EN_SGU) sgu_item(p, l, bid * 4, lds); }
            else for (int k = 0; k < 3; ++k) { if (EN_SGU) sgu_item(p, l, (bid - 128) * 4 + 1 + k, lds); }
        } else for (int it = bid; it < 512; it += G) { if (EN_SGU) sgu_item(p, l, it, lds); }
    }
    if (!(mask & 2)) return;
    ConvConst cc;
#pragma unroll
    for (int t = 0; t < 31; ++t) cc.cw[t] = p.in[17][((size_t)l * 31 + t) * WBR + tid];
    cc.cb = p.in[18][l * WBR + tid]; cc.lng = p.in[19][l * WBR + tid]; cc.lnb = p.in[20][l * WBR + tid];
    cc.sw0 = p.in[12][(size_t)l * 3 * WBR + tid]; cc.sw1 = p.in[12][(size_t)l * 3 * WBR + WBR + tid]; cc.sw2 = p.in[12][(size_t)l * 3 * WBR + 2 * WBR + tid];
    cc.sg = p.in[13][l * WBR + tid]; cc.sb = p.in[14][l * WBR + tid];
    if (G == 256) {
        const int bid = opaque_bid();
        for (int k = 0; k < 4; ++k) { const int it = bid * 4 + k; if (EN_CP) conv_item_p(p, l, it >> 7, (it & 127) * 16, cc, lds, red, tid, lane, wave); }
        if (bid < 128) { if (EN_CS) conv_item<8, true>(p, l, bid, 0, cc, tile, red, tid, lane, wave); }
    } else
    for (int it = opaque_bid(); it < 1152; it += G) {
        if (it < 1024) { if (EN_CP) conv_item_p(p, l, it >> 7, (it & 127) * 16, cc, lds, red, tid, lane, wave); }
        else { if (EN_CS) conv_item<8, true>(p, l, it - 1024, 0, cc, tile, red, tid, lane, wave); }
    }
}

constexpr int KPITCH = 264;
DI void attn_prompt_unit(const Params& p, int l, int u, unsigned char* lds) {
    const int tid = opaque_tid(), lane = tid & 63, wave = tid >> 6, fr = lane & 15, kq = lane >> 4;
    const int b = u >> 6, h = (u >> 4) & 3, qb = u & 15;
    const size_t hb = ((size_t)(l * 8 + b) * 4 + h) * 65536;
    const bf16_t* Kg = (const bf16_t*)(ws_of(p) + WS_KP) + hb; const bf16_t* Vg = (const bf16_t*)(ws_of(p) + WS_VTP) + hb;
    bf16_t* img = (bf16_t*)lds;
    const int qrow = b * SEQ + qb * 128 + wave * 16 + fr;
    const bf16_t* Qg = (const bf16_t*)(ws_of(p) + WS_Q) + (size_t)qrow * DM + h * 256 + kq * 8;
    bf16x8 qf[8];
#pragma unroll
    for (int ks = 0; ks < 8; ++ks) qf[ks] = *(const bf16x8*)(Qg + ks * 32);
    {
        u32x4 st[16];
#pragma unroll
        for (int i = 0; i < 16; ++i) { const int c = tid + 512 * i, r = c >> 5, c16 = c & 31; st[i] = *(const u32x4*)(Kg + r * 256 + c16 * 8); }
#pragma unroll
        for (int i = 0; i < 16; ++i) { const int c = tid + 512 * i, r = c >> 5, c16 = c & 31; *(u32x4*)(img + r * KPITCH + c16 * 8) = st[i]; }
    }
    __syncthreads();
    f32x4 s[16];
#pragma unroll
    for (int kb = 0; kb < 16; kb += 2) {
        bf16x8 kf0[8], kf1[8];
#pragma unroll
        for (int ks = 0; ks < 8; ++ks) { kf0[ks] = *(const bf16x8*)(img + (kb * 16 + fr) * KPITCH + ks * 32 + kq * 8); kf1[ks] = *(const bf16x8*)(img + ((kb + 1) * 16 + fr) * KPITCH + ks * 32 + kq * 8); }
        s[kb] = (f32x4){0.f, 0.f, 0.f, 0.f}; s[kb + 1] = (f32x4){0.f, 0.f, 0.f, 0.f};
#pragma unroll
        for (int ks = 0; ks < 8; ++ks) {
            s[kb] = __builtin_amdgcn_mfma_f32_16x16x32_bf16(kf0[ks], qf[ks], s[kb], 0, 0, 0);
            s[kb + 1] = __builtin_amdgcn_mfma_f32_16x16x32_bf16(kf1[ks], qf[ks], s[kb + 1], 0, 0, 0);
        }
    }
    u32x4 vst[16];
#pragma unroll
    for (int i = 0; i < 16; ++i) { const int c = tid + 512 * i, r = c >> 5, c16 = c & 31; vst[i] = *(const u32x4*)(Vg + r * 256 + c16 * 8); }
    float mx = -INFINITY;
#pragma unroll
    for (int kb = 0; kb < 16; ++kb) mx = fmaxf(fmaxf(fmaxf(mx, s[kb][0]), fmaxf(s[kb][1], s[kb][2])), s[kb][3]);
    mx = fmaxf(mx, __shfl_xor(mx, 16)); mx = fmaxf(mx, __shfl_xor(mx, 32));
    float sum = 0.f;
#pragma unroll
    for (int kb = 0; kb < 16; ++kb)
#pragma unroll
        for (int j = 0; j < 4; ++j) { const float e = __builtin_amdgcn_exp2f(s[kb][j] - mx); s[kb][j] = e; sum += e; }
    sum += __shfl_xor(sum, 16); sum += __shfl_xor(sum, 32);
    const float inv = __builtin_amdgcn_rcpf(sum);
    bf16x8 pb[8];
#pragma unroll
    for (int k2 = 0; k2 < 8; ++k2) {
        u32x4 w; w.x = pk_bf16(s[2 * k2][0], s[2 * k2][1]); w.y = pk_bf16(s[2 * k2][2], s[2 * k2][3]); w.z = pk_bf16(s[2 * k2 + 1][0], s[2 * k2 + 1][1]); w.w = pk_bf16(s[2 * k2 + 1][2], s[2 * k2 + 1][3]);
        pb[k2] = __builtin_bit_cast(bf16x8, w);
    }
    __syncthreads();
#pragma unroll
    for (int i = 0; i < 16; ++i) { const int c = tid + 512 * i, r = c >> 5, c16 = c & 31; *(u32x4*)(img + r * KPITCH + c16 * 8) = vst[i]; }
    __syncthreads();
    bf16_t* Og = (bf16_t*)(ws_of(p) + WS_O) + (size_t)qrow * DM + h * 256 + kq * 4;
#pragma unroll 2
    for (int db = 0; db < 16; db += 2) {
        f32x4 o0 = (f32x4){0.f, 0.f, 0.f, 0.f}, o1 = (f32x4){0.f, 0.f, 0.f, 0.f};
        bf16x8 vf0[8], vf1[8];
#pragma unroll
        for (int k2 = 0; k2 < 8; ++k2) {
            const bf16_t* vp = img + (db * 16 + fr) * KPITCH + k2 * 32 + kq * 4;
            const s16x4 lo = *(const s16x4*)vp, hi = *(const s16x4*)(vp + 16), lo1 = *(const s16x4*)(vp + 16 * KPITCH), hi1 = *(const s16x4*)(vp + 16 * KPITCH + 16);
            vf0[k2] = (bf16x8){lo[0], lo[1], lo[2], lo[3], hi[0], hi[1], hi[2], hi[3]};
            vf1[k2] = (bf16x8){lo1[0], lo1[1], lo1[2], lo1[3], hi1[0], hi1[1], hi1[2], hi1[3]};
        }
#pragma unroll
        for (int k2 = 0; k2 < 8; ++k2) {
            o0 = __builtin_amdgcn_mfma_f32_16x16x32_bf16(vf0[k2], pb[k2], o0, 0, 0, 0);
            o1 = __builtin_amdgcn_mfma_f32_16x16x32_bf16(vf1[k2], pb[k2], o1, 0, 0, 0);
        }
        u32x2 w; w.x = pk_bf16(o0[0] * inv, o0[1] * inv); w.y = pk_bf16(o0[2] * inv, o0[3] * inv);
        *(u32x2*)(Og + db * 16) = w;
        w.x = pk_bf16(o1[0] * inv, o1[1] * inv); w.y = pk_bf16(o1[2] * inv, o1[3] * inv);
        *(u32x2*)(Og + db * 16 + 16) = w;
    }
    __syncthreads();
}

DI void attn_sample_item(const Params& p, int l, int it, unsigned char* lds) {
    const int tid = opaque_tid(), lane = tid & 63, wave = tid >> 6, fr = lane & 15, kq = lane >> 4;
    const int b = it >> 2, h = it & 3;
    const float* Kc = p.in[5] + (((size_t)l * NSB + b) * 256) * 1024 + h * 256;
    const float* Vc = p.in[6] + (((size_t)l * NSB + b) * 256) * 1024 + h * 256;
    float* sS = (float*)lds;
    float* red = (float*)(lds + 8192);
    const int qrow = MP + b * NSQ + (fr & 7);
    const bf16_t* Qg = (const bf16_t*)(ws_of(p) + WS_Q) + (size_t)qrow * DM + h * 256 + kq * 8;
    bf16x8 qf[8];
#pragma unroll
    for (int ks = 0; ks < 8; ++ks) { qf[ks] = *(const bf16x8*)(Qg + ks * 32); if (fr >= 8) qf[ks] = (bf16x8){0, 0, 0, 0, 0, 0, 0, 0}; }
    {
        f32x4 ka[2][8], kbv[2][8];
#pragma unroll
        for (int kb = 0; kb < 2; ++kb) {
            const float* kp = Kc + (size_t)(wave * 32 + kb * 16 + fr) * 1024 + kq * 8;
#pragma unroll
            for (int ks = 0; ks < 8; ++ks) { ka[kb][ks] = *(const f32x4*)(kp + ks * 32); kbv[kb][ks] = *(const f32x4*)(kp + ks * 32 + 4); }
        }
#pragma unroll
        for (int kb = 0; kb < 2; ++kb) {
            f32x4 s = (f32x4){0.f, 0.f, 0.f, 0.f};
#pragma unroll
            for (int ks = 0; ks < 8; ++ks) {
                u32x4 w; w.x = pk_bf16(ka[kb][ks][0], ka[kb][ks][1]); w.y = pk_bf16(ka[kb][ks][2], ka[kb][ks][3]); w.z = pk_bf16(kbv[kb][ks][0], kbv[kb][ks][1]); w.w = pk_bf16(kbv[kb][ks][2], kbv[kb][ks][3]);
                s = __builtin_amdgcn_mfma_f32_16x16x32_bf16(__builtin_bit_cast(bf16x8, w), qf[ks], s, 0, 0, 0);
            }
            if (fr < 8) {
#pragma unroll
                for (int j = 0; j < 4; ++j) sS[(wave * 32 + kb * 16 + kq * 4 + j) * 8 + fr] = s[j];
            }
        }
    }
    __syncthreads();
    {
        float v[4]; float mx = -INFINITY;
#pragma unroll
        for (int i = 0; i < 4; ++i) { v[i] = sS[(lane + 64 * i) * 8 + wave]; mx = fmaxf(mx, v[i]); }
        mx = wave_max(mx); float sum = 0.f;
#pragma unroll
        for (int i = 0; i < 4; ++i) { v[i] = __builtin_amdgcn_exp2f(v[i] - mx); sum += v[i]; }
        sum = wave_sum(sum); const float inv = 1.f / sum;
#pragma unroll
        for (int i = 0; i < 4; ++i) sS[(lane + 64 * i) * 8 + wave] = v[i] * inv;
    }
    __syncthreads();
    {
        f32x4 o[8];
#pragma unroll
        for (int q = 0; q < 8; ++q) o[q] = (f32x4){0.f, 0.f, 0.f, 0.f};
        const float* vp = Vc + (size_t)(wave * 32) * 1024 + lane * 4;
        f32x4 vr[32];
#pragma unroll
        for (int k = 0; k < 32; ++k) vr[k] = *(const f32x4*)(vp + (size_t)k * 1024);
#pragma unroll
        for (int k = 0; k < 32; ++k) {
            const f32x4 v = vr[k];
            const f32x4 p0 = *(const f32x4*)(sS + (wave * 32 + k) * 8), p1 = *(const f32x4*)(sS + (wave * 32 + k) * 8 + 4);
            o[0] += v * p0[0]; o[1] += v * p0[1]; o[2] += v * p0[2]; o[3] += v * p0[3];
            o[4] += v * p1[0]; o[5] += v * p1[1]; o[6] += v * p1[2]; o[7] += v * p1[3];
        }
#pragma unroll
        for (int q = 0; q < 8; ++q) *(f32x4*)(red + ((wave * 8 + q) * 256) + lane * 4) = o[q];
    }
    __syncthreads();
    {
        const int q = tid >> 6; f32x4 a = (f32x4){0.f, 0.f, 0.f, 0.f};
#pragma unroll
        for (int w = 0; w < 8; ++w) a += *(const f32x4*)(red + ((w * 8 + q) * 256) + lane * 4);
        bf16_t* Og = (bf16_t*)(ws_of(p) + WS_O) + (size_t)(MP + b * NSQ + q) * DM + h * 256 + lane * 4;
        u32x2 w; w.x = pk_bf16(a[0], a[1]); w.y = pk_bf16(a[2], a[3]); *(u32x2*)Og = w;
    }
    __syncthreads();
}

DI void attn_phase(const Params& p, int l, unsigned char* lds, int G, int mask) {
    const int bid = opaque_bid(); const bool sample_first = ((bid >> 3) & 1) != 0;
    for (int pass = 0; pass < 2; ++pass) {
        const bool do_sample = (pass == 0) == sample_first;
        if (do_sample) { if (mask & 2) for (int it = bid; it < 512; it += G) attn_sample_item(p, l, it, lds); }
        else if (mask & 1) for (int it = bid; it < 512; it += G) {
            int u = it;
            if (G == 256) { const int c = it & 255; u = (it & 256) + (c & 7) * 32 + (c >> 3); }
            attn_prompt_unit(p, l, u, lds);
        }
    }
}

DI void final_phase(const Params& p, int G) {
    const int tid = opaque_tid(), lane = tid & 63, wave = tid >> 6;
    const bf16_t* XBf = (const bf16_t*)(ws_of(p) + WS_XB); const float* SS = (const float*)(ws_of(p) + WS_SS); const float* g = p.in[33];
    f32x4 gv[4];
#pragma unroll
    for (int j = 0; j < 4; ++j) gv[j] = ((const f32x4*)g)[lane + 64 * j];
    const int NW = G * 8;
    for (int m0 = opaque_bid() * 8 + wave; m0 < MT; m0 += 4 * NW) {
        u32x2 xv[4][4]; float sv[4];
#pragma unroll
        for (int r = 0; r < 4; ++r) {
            const int m = m0 + r * NW; const bool ok = m < MT; const int mm = ok ? m : m0;
            sv[r] = (lane < 16) ? SS[(size_t)mm * 16 + lane] : 0.f;
            const u32x2* xr = (const u32x2*)(XBf + (size_t)mm * DM) + lane;
#pragma unroll
            for (int j = 0; j < 4; ++j) xv[r][j] = xr[64 * j];
        }
#pragma unroll
        for (int r = 0; r < 4; ++r) {
            const int m = m0 + r * NW; if (m >= MT) break;
            const float rs = __builtin_amdgcn_rsqf(wave_sum(sv[r]) * (1.f / 1024.f) + EPS);
            f32x4* o = (f32x4*)(out_of(p) + (size_t)m * DM) + lane;
#pragma unroll
            for (int j = 0; j < 4; ++j) { const u32x2 v = xv[r][j]; o[64 * j] = (f32x4){bf_lo(v.x), bf_hi(v.x), bf_lo(v.y), bf_hi(v.y)} * rs * gv[j]; }
        }
    }
}

constexpr int MPITCH = 264, MOPB = 64 * MPITCH * 2;
DI void mini_unit(const Params& p, unsigned char* lds, int kind, const bf16_t* A, const bf16_t* Bt, int Kfull, int mu, int nct, float scale, const float* xin_s) {
    const int tid = opaque_tid(), lane = tid & 63, wave = __builtin_amdgcn_readfirstlane(tid >> 6), fr = lane & 15, kq = lane >> 4, rb = wave & 3, kh = wave >> 2;
    const int rt = mu / nct, ct = mu % nct, r0 = rt * 64 + rb * 16;
    unsigned char* ws = ws_of(p);
    f32x4 tot[4], acc[4];
#pragma unroll
    for (int cb = 0; cb < 4; ++cb) { tot[cb] = (f32x4){0.f, 0.f, 0.f, 0.f}; acc[cb] = (f32x4){0.f, 0.f, 0.f, 0.f}; }
    const int pitch = Kfull, nch = Kfull >> 8;
    const bf16_t* Ag = A + (size_t)(rt * 64 + (tid >> 5)) * pitch + (tid & 31) * 8;
    const bf16_t* Bg = Bt + (size_t)(ct * 64 + (tid >> 5)) * pitch + (tid & 31) * 8;
    const int sto = (tid >> 5) * MPITCH + (tid & 31) * 8;
    u32x4 ra[4], rbv[4];
#pragma unroll
    for (int i = 0; i < 4; ++i) { ra[i] = *(const u32x4*)(Ag + (size_t)(16 * i) * pitch); rbv[i] = *(const u32x4*)(Bg + (size_t)(16 * i) * pitch); }
    __syncthreads();
    {
        bf16_t* sa = (bf16_t*)lds; bf16_t* sb = (bf16_t*)(lds + MOPB);
#pragma unroll
        for (int i = 0; i < 4; ++i) { *(u32x4*)(sa + sto + 16 * i * MPITCH) = ra[i]; *(u32x4*)(sb + sto + 16 * i * MPITCH) = rbv[i]; }
    }
    __syncthreads();
    for (int c = 0; c < nch; ++c) {
        const bool more = (c + 1 < nch);
        if (more) {
#pragma unroll
            for (int i = 0; i < 4; ++i) { ra[i] = *(const u32x4*)(Ag + (size_t)(16 * i) * pitch + (c + 1) * 256); rbv[i] = *(const u32x4*)(Bg + (size_t)(16 * i) * pitch + (c + 1) * 256); }
        }
        const bf16_t* sa = (const bf16_t*)(lds + (c & 1) * 2 * MOPB) + (rb * 16 + fr) * MPITCH + kh * 128 + kq * 8;
        const bf16_t* sb = (const bf16_t*)(lds + (c & 1) * 2 * MOPB + MOPB) + fr * MPITCH + kh * 128 + kq * 8;
#pragma unroll
        for (int ks = 0; ks < 4; ++ks) {
            const bf16x8 a = *(const bf16x8*)(sa + ks * 32);
#pragma unroll
            for (int cb = 0; cb < 4; ++cb) { const bf16x8 bfr = *(const bf16x8*)(sb + cb * 16 * MPITCH + ks * 32); acc[cb] = __builtin_amdgcn_mfma_f32_16x16x32_bf16(bfr, a, acc[cb], 0, 0, 0); }
        }
        if (kind == 9) {
            if (c & 1) {
                const int sg = c >> 1;
                const bf16_t* gp = (const bf16_t*)(ws + WS_Z) + (size_t)(MP + r0 + fr) * ZP + 3072 + 1024 * sg + ct * 64 + 4 * kq;
#pragma unroll
                for (int cb = 0; cb < 4; ++cb) { const u32x2 g = *(const u32x2*)(gp + cb * 16);
                    tot[cb][0] += bf_lo(g.x) * acc[cb][0]; tot[cb][1] += bf_hi(g.x) * acc[cb][1]; tot[cb][2] += bf_lo(g.y) * acc[cb][2]; tot[cb][3] += bf_hi(g.y) * acc[cb][3];
                    acc[cb] = (f32x4){0.f, 0.f, 0.f, 0.f}; }
            }
        }
        if (more) {
            bf16_t* sa2 = (bf16_t*)(lds + ((c + 1) & 1) * 2 * MOPB); bf16_t* sb2 = (bf16_t*)(lds + ((c + 1) & 1) * 2 * MOPB + MOPB);
#pragma unroll
            for (int i = 0; i < 4; ++i) { *(u32x4*)(sa2 + sto + 16 * i * MPITCH) = ra[i]; *(u32x4*)(sb2 + sto + 16 * i * MPITCH) = rbv[i]; }
        }
        __syncthreads();
    }
    if (kind != 9) {
#pragma unroll
        for (int cb = 0; cb < 4; ++cb) tot[cb] = acc[cb];
    }
    float* red = (float*)lds;
    if (kh == 1) {
#pragma unroll
        for (int cb = 0; cb < 4; ++cb) *(f32x4*)(red + ((rb * 64 + lane) * 4 + cb) * 4) = tot[cb];
    }
    __syncthreads();
    if (kh == 0) {
#pragma unroll
        for (int cb = 0; cb < 4; ++cb) tot[cb] += *(const f32x4*)(red + ((rb * 64 + lane) * 4 + cb) * 4);
        const int row = MP + r0 + fr, col0 = ct * 64 + 4 * kq;
        if (kind == 8) {
            bf16_t* XB = (bf16_t*)(ws + WS_XB) + (size_t)row * DM + col0; const float* xi = xin_s ? xin_s + (size_t)(r0 + fr) * DM + col0 : nullptr;
            float ss = 0.f;
#pragma unroll
            for (int cb = 0; cb < 4; ++cb) {
                f32x4 x;
                if (xin_s) x = *(const f32x4*)(xi + cb * 16); else { const u32x2 v = *(const u32x2*)(XB + cb * 16); x = (f32x4){bf_lo(v.x), bf_hi(v.x), bf_lo(v.y), bf_hi(v.y)}; }
                x += tot[cb];
                u32x2 w; w.x = pk_bf16(x[0], x[1]); w.y = pk_bf16(x[2], x[3]); *(u32x2*)(XB + cb * 16) = w;
                const f32x4 y = (f32x4){bf_lo(w.x), bf_hi(w.x), bf_lo(w.y), bf_hi(w.y)};
                ss += (y[0] * y[0] + y[1] * y[1]) + (y[2] * y[2] + y[3] * y[3]);
            }
            ss += __shfl_xor(ss, 16); ss += __shfl_xor(ss, 32);
            if (kq == 0) ((float*)(ws + WS_SS))[(size_t)row * 16 + ct] = ss;
        } else if (kind == 0 || kind == 7) {
            const f32x4 s4 = *(const f32x4*)((const float*)(ws + WS_SS) + (size_t)row * 16 + kq * 4);
            float t = (s4[0] + s4[1]) + (s4[2] + s4[3]); t += __shfl_xor(t, 16); t += __shfl_xor(t, 32);
            const float r = __builtin_amdgcn_rsqf(t * (1.f / 1024.f) + EPS) * scale;
            bf16_t* Q = (kind == 0) ? (bf16_t*)(ws + WS_Q) + (size_t)row * DM + col0 : (bf16_t*)(ws + WS_Z) + (size_t)row * DFF + col0;
#pragma unroll
            for (int cb = 0; cb < 4; ++cb) {
                f32x4 v = tot[cb] * r;
                if (kind == 7) { v[0] = fmaxf(v[0], 0.f); v[1] = fmaxf(v[1], 0.f); v[2] = fmaxf(v[2], 0.f); v[3] = fmaxf(v[3], 0.f); v = v * v; }
                u32x2 w; w.x = pk_bf16(v[0], v[1]); w.y = pk_bf16(v[2], v[3]); *(u32x2*)(Q + cb * 16) = w; }
        } else {
            bf16_t* MG = (bf16_t*)(ws + WS_MG) + (size_t)row * DM + col0;
#pragma unroll
            for (int cb = 0; cb < 4; ++cb) { u32x2 w; w.x = pk_bf16(tot[cb][0], tot[cb][1]); w.y = pk_bf16(tot[cb][2], tot[cb][3]); *(u32x2*)(MG + cb * 16) = w; }
        }
    }
    __syncthreads();
}

#define XB_TMO      128
#define XB_XCNT(j)  (256  + 64 * (j))
#define XB_XSUB(j)  (1280 + 64 * (j))
#define XB_XGEN(j)  (2304 + 64 * (j))
#define XB_TOP      3328
#define XB_TOPGEN   3392
#define XCD_BAR_WORDS 3456
#define XB_SPIN_CAP (1u << 22)
DI unsigned xb_ld(unsigned* p)              { return __hip_atomic_load(p, __ATOMIC_RELAXED, __HIP_MEMORY_SCOPE_AGENT); }
DI unsigned xb_add(unsigned* p, unsigned v) { return __hip_atomic_fetch_add(p, v, __ATOMIC_RELAXED, __HIP_MEMORY_SCOPE_AGENT); }
DI unsigned xb_xcc_id() { return (unsigned)__builtin_amdgcn_s_getreg((3 << 11) | 20) & 0xFu; }
#define XB_SPIN(cond, bar) do { unsigned _sp = 0; while (cond) { __builtin_amdgcn_s_sleep(1); \
    if ((++_sp & 255u) == 0u) { if (xb_ld(&(bar)[XB_TMO])) break; if (_sp > XB_SPIN_CAP) { atomicAdd(&(bar)[XB_TMO], 1u); break; } } } } while (0)
struct XcdBarrier { unsigned* bar; unsigned x; volatile LAS unsigned* st; };
DI XcdBarrier xcd_barrier_post(unsigned* bar, volatile LAS unsigned* st) {
    XcdBarrier b; b.bar = bar; b.x = xb_xcc_id(); b.st = st;
    if (threadIdx.x == 0) (void)xb_add(&bar[XB_XCNT(b.x)], 1u);
    return b;
}
DI void xcd_barrier_complete(unsigned* bar, unsigned x, unsigned& nloc, unsigned& nx) {
    const unsigned G = gridDim.x * gridDim.y * gridDim.z;
    unsigned sum, cnt, mine, sp = 0u;
    for (;;) {
        sum = 0u; cnt = 0u; mine = 0u;
#pragma unroll
        for (unsigned j = 0; j < 16; ++j) { const unsigned c = xb_ld(&bar[XB_XCNT(j)]); sum += c; cnt += (c > 0u) ? 1u : 0u; mine = (j == x) ? c : mine; }
        if (sum == G) break;
        __builtin_amdgcn_s_sleep(1);
        if ((++sp & 255u) == 0u) { if (xb_ld(&bar[XB_TMO])) break; if (sp > XB_SPIN_CAP) { atomicAdd(&bar[XB_TMO], 1u); break; } }
    }
    nloc = mine > 0u ? mine : 1u; nx = cnt > 0u ? cnt : 1u;
}
DI void xcd_barrier(const XcdBarrier& b) {
    asm volatile("s_waitcnt vmcnt(0)" ::: "memory");
    __syncthreads();
    if (threadIdx.x == 0) {
        unsigned* bar = b.bar;
        __builtin_amdgcn_s_waitcnt(0);
        unsigned nloc = b.st[0], nx = b.st[1];
        if (nloc == 0u) { xcd_barrier_complete(bar, b.x, nloc, nx); b.st[0] = nloc; b.st[1] = nx; }
        const unsigned old = xb_add(&bar[XB_XSUB(b.x)], 1u);
        const unsigned gen = old / nloc;
        if (old + 1u == (gen + 1u) * nloc) {
            __builtin_amdgcn_fence(__ATOMIC_RELEASE, "agent");
            asm volatile("s_waitcnt vmcnt(0)" ::: "memory");
            const unsigned og = xb_add(&bar[XB_TOP], 1u);
            const unsigned tg = og / nx;
            if (og + 1u == (tg + 1u) * nx) xb_add(&bar[XB_TOPGEN], 1u);
            else XB_SPIN(xb_ld(&bar[XB_TOPGEN]) == tg, bar);
            __builtin_amdgcn_fence(__ATOMIC_ACQUIRE, "agent");
            xb_add(&bar[XB_XGEN(b.x)], 1u);
            asm volatile("s_waitcnt vmcnt(0)" ::: "memory");
        } else {
            XB_SPIN(xb_ld(&bar[XB_XGEN(b.x)]) == gen, bar);
            __builtin_amdgcn_fence(__ATOMIC_ACQUIRE, "agent");
            asm volatile("s_waitcnt vmcnt(0)" ::: "memory");
        }
    }
    __syncthreads();
}

__global__ void __launch_bounds__(512, 2) fwd_megakernel(Params p) {
    extern __shared__ __attribute__((aligned(16))) unsigned char lds[];
    cg::grid_group grid = cg::this_grid();
    const int G = gridDim.x;
    volatile LAS int* dsc = (volatile LAS int*)((LAS unsigned char*)lds + LDS_MISC + 2048);
    volatile LAS unsigned* bst = (volatile LAS unsigned*)((LAS unsigned char*)lds + LDS_MISC + 4096);
    if (threadIdx.x < 2) bst[threadIdx.x] = 0u;
    __syncthreads();
    const bool multi = (p.ph_hi - p.ph_lo) > 1;
    XcdBarrier xbar; xbar.bar = (unsigned*)(p.ws + WS_CTL); xbar.x = 0; xbar.st = bst;
    if (multi) xbar = xcd_barrier_post((unsigned*)(p.ws + WS_CTL), bst);
    for (int ph = p.ph_lo; ph < p.ph_hi; ++ph) {
        int is_gemm = 0, K = 1024;
        if (ph == 0) { int reps = PROBE_A ? 2 : 1; asm volatile("" : "+s"(reps)); for (int r = 0; r < reps; ++r) { if (EN_PRO) prologue(p, lds, G, r == 0 ? 7 : PROBE_A); __syncthreads(); } }
        else if (ph == NPH - 1) final_phase(p, G);
        else {
            const int l = (ph - 1) / 9, s = (ph - 1) % 9;
            if (s == 1) { int reps = PROBE_B ? 2 : 1; asm volatile("" : "+s"(reps)); for (int r = 0; r < reps; ++r) { if (EN_BR) branch_phase(p, l, lds, G, r == 0 ? 3 : PROBE_B); __syncthreads(); } }
            else if (s == 5) { int reps = PROBE_C ? 2 : 1; asm volatile("" : "+s"(reps)); for (int r = 0; r < reps; ++r) { if (EN_AT) attn_phase(p, l, lds, G, r == 0 ? 3 : PROBE_C); __syncthreads(); } }
            else {
                is_gemm = 1; K = (s == 2) ? 2048 : (s == 8) ? 4096 : 1024;
                if (threadIdx.x == 0) {
                    const float* X = (const float*)(ws_of(p) + WS_X);
                    int mode = 1, nN = 4, kind = 0, nkv = 0, ldz = 0; float scale = 1.f;
                    const void *A = nullptr, *B = nullptr, *xin_p = X, *xin_s = X + (size_t)MP * DM, *bias = nullptr, *Zout = nullptr;
                    switch (s) {
                        case 0: mode = 0; A = ws_of(p) + WS_XB; B = ws_of(p) + WS_WIN + (size_t)l * 16 * MiB; nkv = (l == 0) ? 128 : 0; Zout = ws_of(p) + WS_Z; ldz = ZP; bias = p.in[22] + (size_t)l * 4096; break;
                        case 2: mode = 2; A = ws_of(p) + WS_BR; B = ws_of(p) + WS_WB + (size_t)l * 4 * MiB; break;
                        case 3: kind = 8; A = ws_of(p) + WS_MG; B = ws_of(p) + WS_WMIX + (size_t)l * 2 * MiB; if (l == 0) { xin_p = p.in[0]; xin_s = p.in[1]; } break;
                        case 4: kind = 0; A = ws_of(p) + WS_XB; B = ws_of(p) + WS_WQ + (size_t)l * 2 * MiB; Zout = ws_of(p) + WS_Q; ldz = DM; scale = 0.0625f * LOG2E; break;
                        case 6: kind = 8; A = ws_of(p) + WS_O; B = ws_of(p) + WS_WO + (size_t)l * 2 * MiB; break;
                        case 7: kind = 7; nN = 16; A = ws_of(p) + WS_XB; B = ws_of(p) + WS_W1 + (size_t)l * 8 * MiB; Zout = ws_of(p) + WS_Z; ldz = DFF; break;
                        default: kind = 8; A = ws_of(p) + WS_Z; B = ws_of(p) + WS_W2 + (size_t)l * 8 * MiB; break;
                    }
                    dsc[0] = mode; dsc[1] = nN; dsc[2] = K; dsc[3] = kind; dsc[4] = nkv; dsc[5] = ldz; dsc[6] = __float_as_int(scale); dsc[7] = (s == 3 && l == 0) ? 1 : 0;
                    const unsigned long long pa[8] = {(unsigned long long)A, (unsigned long long)B, (unsigned long long)(ws_of(p) + WS_MB), (unsigned long long)(ws_of(p) + WS_WKV), (unsigned long long)xin_p, (unsigned long long)xin_s, (unsigned long long)bias, (unsigned long long)Zout};
#pragma unroll
                    for (int i = 0; i < 8; ++i) { dsc[8 + 2 * i] = (int)(unsigned)pa[i]; dsc[9 + 2 * i] = (int)(unsigned)(pa[i] >> 32); }
                }
                __syncthreads();
            }
        }
        int greps = 1; if (PROBE_G >= 0 && is_gemm && ((ph - 1) % 9) == PROBE_G) greps = 2; asm volatile("" : "+s"(greps));
        for (int gr = 0; gr < greps; ++gr)
        if (EN_GEMM && is_gemm) {
            pg8::SchedU S; S.d = (pg8::DescP)dsc; S.G = G; S.c = opaque_bid();
            pg8::EpiU E; E.d = (pg8::DescP)dsc; E.ws = ws_of(p); E.out = out_of(p);
            pg8::gemm_phase((LAS unsigned char*)lds, K, (ph - 1) % 9 == 2, S, E);
            const int l = (ph - 1) / 9, s = (ph - 1) % 9;
            if (s == 2 || s == 3 || s == 4 || s == 6 || s == 7 || s == 8) {
                unsigned char* ws = ws_of(p);
                int kind = 8; const bf16_t* A; const bf16_t* B; float scale = 1.f;
                const float* xin_s = (l == 0 && s == 3) ? p.in[1] : nullptr;
                if (s == 2) { kind = 9; A = (const bf16_t*)(ws + WS_BR) + (size_t)MP * 2048; B = (const bf16_t*)(ws + WS_WB + (size_t)l * 4 * MiB); }
                else if (s == 3) { A = (const bf16_t*)(ws + WS_MG) + (size_t)MP * DM; B = (const bf16_t*)(ws + WS_WMIX + (size_t)l * 2 * MiB); }
                else if (s == 4) { kind = 0; A = (const bf16_t*)(ws + WS_XB) + (size_t)MP * DM; B = (const bf16_t*)(ws + WS_WQ + (size_t)l * 2 * MiB); scale = 0.0625f * LOG2E; }
                else if (s == 6) { A = (const bf16_t*)(ws + WS_O) + (size_t)MP * DM; B = (const bf16_t*)(ws + WS_WO + (size_t)l * 2 * MiB); }
                else if (s == 7) { kind = 7; A = (const bf16_t*)(ws + WS_XB) + (size_t)MP * DM; B = (const bf16_t*)(ws + WS_W1 + (size_t)l * 8 * MiB); }
                else { A = (const bf16_t*)(ws + WS_Z) + (size_t)MP * DFF; B = (const bf16_t*)(ws + WS_W2 + (size_t)l * 8 * MiB); }
                const int nct = (s == 7) ? 64 : 16;
                for (int mu = opaque_bid(); mu < 16 * nct; mu += G) mini_unit(p, lds, kind, A, B, K, mu, nct, scale, xin_s);
            }
        }
        if (ph + 1 < p.ph_hi) {
            if (p.ph_lo < 0) grid.sync();
            else { int reps = 1 + PROBE_S; asm volatile("" : "+s"(reps)); for (int r = 0; r < reps; ++r) xcd_barrier(xbar); }
        }
    }
}

#ifndef MK_PER_PHASE
#define MK_PER_PHASE 0
#endif
extern "C" void kernel_launch(void* const* d_in, const int* in_sizes, int n_in, void* d_out, int out_size, void* d_ws, size_t ws_size, hipStream_t stream) {
    static int grid = 0;
    if (grid == 0) {
        if (n_in != 34 || out_size != (int)O_END || ws_size < WS_END) { fprintf(stderr, "kernel_launch: unexpected shapes: n_in %d out %d ws %zu\n", n_in, out_size, ws_size); grid = -1; return; }
        int dev = 0, cus = 0, per_cu = 0;
        (void)hipGetDevice(&dev); (void)hipDeviceGetAttribute(&cus, hipDeviceAttributeMultiprocessorCount, dev);
        if (hipFuncSetAttribute((const void*)fwd_megakernel, hipFuncAttributeMaxDynamicSharedMemorySize, LDS_BYTES) != hipSuccess) { fprintf(stderr, "kernel_launch: hipFuncSetAttribute failed\n"); grid = -1; return; }
        if (hipOccupancyMaxActiveBlocksPerMultiprocessor(&per_cu, (const void*)fwd_megakernel, 512, LDS_BYTES) != hipSuccess || per_cu < 1) { fprintf(stderr, "kernel_launch: occupancy query gave %d\n", per_cu); per_cu = 1; }
        (void)hipGetLastError();
        grid = cus * per_cu; if (grid > 256) grid = 256;
        if (grid <= 0) grid = 256;
    }
    if (grid < 0) return;
    Params p{};
    for (int i = 0; i < 34; ++i) p.in[i] = (const float*)d_in[i];
    p.out = (float*)d_out; p.ws = (unsigned char*)d_ws;
#if MK_PER_PHASE
    for (int ph = 0; ph < NPH; ++ph) { p.ph_lo = ph; p.ph_hi = ph + 1; hipLaunchKernelGGL(fwd_megakernel, dim3(grid), dim3(512), LDS_BYTES, stream, p); }
#else
    p.ph_lo = 0; p.ph_hi = NPH;
    (void)hipMemsetAsync((char*)d_ws + WS_CTL, 0, 65536, stream);
    void* args[] = {&p};
    hipError_t e = hipLaunchCooperativeKernel((const void*)fwd_megakernel, dim3(grid), dim3(512), args, LDS_BYTES, stream);
    if (e != hipSuccess) fprintf(stderr, "kernel_launch: cooperative launch failed: %s (grid %d)\n", hipGetErrorString(e), grid);
#endif
}
```

```cpp
#include <hip/hip_runtime.h>
#include <hip/hip_cooperative_groups.h>
#include <cstdio>
#include <cstdint>
namespace cg = cooperative_groups;
#ifndef PROBE_G
#define PROBE_G -1
#endif
#ifndef PROBE_C
#define PROBE_C 0
#endif
#ifndef PROBE_S
#define PROBE_S 0
#endif
#ifndef PROBE_A
#define PROBE_A 0
#endif
#ifndef PROBE_B
#define PROBE_B 0
#endif
#ifndef EN_SGU
#define EN_SGU 1
#endif
#ifndef EN_CP
#define EN_CP 1
#endif
#ifndef EN_CS
#define EN_CS 1
#endif
#ifndef EN_PRO
#define EN_PRO 1
#endif
#ifndef EN_BR
#define EN_BR 1
#endif
#ifndef EN_AT
#define EN_AT 1
#endif
#ifndef EN_GEMM
#define EN_GEMM 1
#endif

#define DI __device__ __forceinline__
#define LAS __attribute__((address_space(3)))
typedef unsigned short bf16_t;
typedef short bf16x8 __attribute__((ext_vector_type(8)));
typedef short s16x4 __attribute__((ext_vector_type(4)));
typedef float f32x4 __attribute__((ext_vector_type(4)));
typedef float f32x2 __attribute__((ext_vector_type(2)));
typedef unsigned u32x4 __attribute__((ext_vector_type(4)));
typedef unsigned u32x2 __attribute__((ext_vector_type(2)));
typedef __bf16 bf16x2_t __attribute__((ext_vector_type(2)));

constexpr int DM = 1024, MP = 16384, MS = 1024, MT = MP + MS, SEQ = 2048, NB = 8, NSB = 128, NSQ = 8, WBR = 512, ZP = 7168, DFF = 4096;
constexpr float EPS = 1e-6f;
constexpr float LOG2E = 1.4426950408889634f;
constexpr int NPH = 20;
constexpr size_t O_YP = 0, O_YS = 16777216, O_POOLP = 17825792, O_SCP = 17948672, O_CCP = 17965056, O_MK = 18210816, O_MV = 22405120,
                 O_POOLS = 26599424, O_SCS = 28565504, O_CCS = 28827648, O_SGUV = 32759808, O_END = 33808384;
constexpr size_t MiB = 1u << 20;
constexpr size_t WS_WIN = 0, WS_WB = 32 * MiB, WS_WMIX = 40 * MiB, WS_WQ = 44 * MiB, WS_WKV = 48 * MiB, WS_WO = 56 * MiB, WS_W1 = 60 * MiB, WS_W2 = 76 * MiB,
                 WS_SGUW = 92 * MiB, WS_SS = 93 * MiB, WS_SSM = 95 * MiB, WS_MB = 96 * MiB, WS_KP = 100 * MiB, WS_VTP = 108 * MiB, WS_X = 116 * MiB,
                 WS_XB = 184 * MiB, WS_MG = 218 * MiB, WS_Q = 252 * MiB, WS_O = 286 * MiB, WS_BR = 320 * MiB, WS_Z = 388 * MiB, WS_CTL = 627 * MiB, WS_END = 628 * MiB;
constexpr size_t BR_STRIDE = (size_t)MT * WBR * 2;
constexpr int LDS_BYTES = 147456, LDS_MISC = 139264;

DI unsigned pk_bf16(float lo, float hi) { f32x2 v = {lo, hi}; bf16x2_t b = __builtin_convertvector(v, bf16x2_t); return __builtin_bit_cast(unsigned, b); }
DI float bf_lo(unsigned v) { return __uint_as_float(v << 16); }
DI float bf_hi(unsigned v) { return __uint_as_float(v & 0xffff0000u); }
DI float sigmoidf_(float x) { return __builtin_amdgcn_rcpf(1.f + __builtin_amdgcn_exp2f(-x * LOG2E)); }
DI float gelu_tanh(float x) { const float u = 1.5957691216057308f * (x + 0.044715f * x * x * x); return x * sigmoidf_(u); }
DI float wave_sum(float v) {
#pragma unroll
    for (int o = 1; o < 64; o <<= 1) v += __shfl_xor(v, o);
    return v;
}
DI float wave_max(float v) {
#pragma unroll
    for (int o = 1; o < 64; o <<= 1) v = fmaxf(v, __shfl_xor(v, o));
    return v;
}

DI int opaque_tid() { int t = threadIdx.x; asm volatile("" : "+v"(t)); return t; }
DI int opaque_bid() { int b = blockIdx.x; asm volatile("" : "+s"(b)); return b; }
template <int N, int D> struct XReduce {
    static DI void run(float* v, int lane) {
        const bool up = (lane & D) != 0;
#pragma unroll
        for (int i = 0; i < N / 2; ++i) { const float send = up ? v[i] : v[i + N / 2], keep = up ? v[i + N / 2] : v[i]; v[i] = keep + __shfl_xor(send, D); }
        XReduce<N / 2, D / 2>::run(v, lane);
    }
};
template <int D> struct XReduce<1, D> {
    static DI void run(float* v, int lane) {
#pragma unroll
        for (int d = D; d >= 1; d >>= 1) v[0] += __shfl_xor(v[0], d);
    }
};
struct Params { const float* in[34]; float* out; unsigned char* ws; int ph_lo, ph_hi; };
DI unsigned char* ws_of(const Params& p) { unsigned char* w = p.ws; asm volatile("" : "+s"(w)); return w; }
DI float* out_of(const Params& p) { float* o = p.out; asm volatile("" : "+s"(o)); return o; }

namespace pg8 {
constexpr int BM = 256, BK = 64, HALF = 128, HTB = HALF * BK * 2, STAGE_BYTES = 8 * HTB;
DI int lds_byte(int r, int c) { const int st = (r >> 4) * 2 + (c >> 5), rr = r & 15, cc = c & 31, ob = rr * 64 + cc * 2; return st * 1024 + (ob ^ (((ob >> 9) & 1) << 5)); }
DI void stage_rc(int b, int& R, int& C) { const int st = b / 1024, sb = b % 1024, swz = sb ^ (((sb >> 9) & 1) << 5); R = (st >> 1) * 16 + swz / 64; C = (st & 1) * 32 + (swz % 64) / 2; }
DI int perm32(int rho) { const int n = rho >> 4, i = rho & 15; return 8 * (i >> 2) + 4 * n + (i & 3); }

struct Unit { int pm, pn, kind, zc; const char* a; const char* b; };

DI void tile_of(int L, int nM, int nN, int& pm, int& pn) {
    const int nwg = nM * nN; int wgid = L;
    { const int q = nwg / 8, r = nwg % 8, xcd = wgid % 8, off = wgid / 8; wgid = (xcd < r ? xcd * (q + 1) : r * (q + 1) + (xcd - r) * q) + off; }
    const int nig = 8 * nN, gid = wgid / nig, fm = gid * 8, gsz = (nM - fm) < 8 ? (nM - fm) : 8;
    pm = fm + ((wgid % nig) % gsz); pn = (wgid % nig) / gsz;
}

typedef const volatile LAS int* DescP;
DI int dsc_i(DescP d, int i) { return __builtin_amdgcn_readfirstlane(d[i]); }
DI const char* dsc_p(DescP d, int i) { const unsigned lo = (unsigned)__builtin_amdgcn_readfirstlane(d[i]), hi = (unsigned)__builtin_amdgcn_readfirstlane(d[i + 1]); return (const char*)(((unsigned long long)hi << 32) | lo); }
struct SchedU {
    DescP d; int G, c;
    DI bool next(int i, Unit& u) const {
        const int mode = dsc_i(d, 0); const char* A = dsc_p(d, 8); const char* B = dsc_p(d, 10);
        if (mode == 2) {
            const int ti = i * G + c; if (ti >= 64 * 4) return false;
            tile_of(ti, 64, 4, u.pm, u.pn); u.kind = 9; u.zc = 0;
            u.a = A + (size_t)u.pm * (256 * 2048 * 2); u.b = B + (size_t)u.pn * (256 * 2048 * 2); return true;
        }
        const int L = i * G + c;
        if (mode == 1) {
            const int nN = dsc_i(d, 1), K = dsc_i(d, 2);
            const int nM = 64;
            if (L >= nM * nN) return false;
            tile_of(L, nM, nN, u.pm, u.pn); u.kind = dsc_i(d, 3); u.zc = u.pn * 256;
            u.a = A + (size_t)u.pm * ((size_t)512 * K); u.b = B + (size_t)u.pn * ((size_t)512 * K); return true;
        }
        if (L < 68 * 32) {
            tile_of(L, 68, 32, u.pm, u.pn); u.a = A + (size_t)u.pm * (512 * 1024); u.b = B + (size_t)u.pn * (512 * 1024);
            const int pn = u.pn;
            if (pn < 2) { u.kind = 0; u.zc = pn * 256; }
            else if (pn < 6) { u.kind = 3; u.zc = 512 + (pn - 2) * 128; }
            else if (pn < 8) { u.kind = 0; u.zc = 1024 + (pn - 6) * 256; }
            else if (pn < 12) { u.kind = 1; u.zc = 1536 + (pn - 8) * 256; }
            else if (pn < 16) { u.kind = 4; u.zc = 2560 + (pn - 12) * 128; }
            else { u.kind = 2; u.zc = 3072 + (pn - 16) * 256; }
            return true;
        }
        const int j = L - 68 * 32; if (j >= dsc_i(d, 4)) return false;
        const int l = j >> 6, rem = j & 63; u.pm = rem >> 3; u.pn = rem & 7; u.kind = 5; u.zc = l;
        u.a = dsc_p(d, 12) + (size_t)u.pm * (512 * 1024); u.b = dsc_p(d, 14) + (size_t)l * (4 * MiB) + (size_t)u.pn * (512 * 1024); return true;
    }
};

struct EpiU {
    DescP d; unsigned char* ws; float* out;
    template <int ACT> DI void plain(const f32x4 (&acc)[2][2][4][2], const Unit& u, const float (&rs)[2][4], int rloc, int cloc) const {
        const float* bias = (const float*)dsc_p(d, 20); bf16_t* Zout = (bf16_t*)dsc_p(d, 22); const int ldz = dsc_i(d, 5);
        f32x4 bv[2][2];
#pragma unroll
        for (int bj = 0; bj < 2; ++bj)
#pragma unroll
            for (int n = 0; n < 2; ++n) bv[bj][n] = (ACT == 2) ? *(const f32x4*)(bias + (u.zc - 3072) + cloc + bj * 128 + 4 * n) : (f32x4){0.f, 0.f, 0.f, 0.f};
#pragma unroll
        for (int ai = 0; ai < 2; ++ai)
#pragma unroll
            for (int m = 0; m < 4; ++m) {
                const int row = u.pm * 256 + rloc + ai * 128 + m * 16; bf16_t* rowp = Zout + (size_t)row * ldz + u.zc + cloc; const float r = rs[ai][m];
#pragma unroll
                for (int bj = 0; bj < 2; ++bj) {
                    float v[8];
#pragma unroll
                    for (int n = 0; n < 2; ++n)
#pragma unroll
                        for (int j = 0; j < 4; ++j) {
                            float x = acc[ai][bj][m][n][j] * r;
                            if (ACT == 1) x = gelu_tanh(x);
                            if (ACT == 2) x = sigmoidf_(x + bv[bj][n][j]);
                            if (ACT == 7) { x = fmaxf(x, 0.f); x = x * x; }
                            v[n * 4 + j] = x;
                        }
                    u32x4 w; w.x = pk_bf16(v[0], v[1]); w.y = pk_bf16(v[2], v[3]); w.z = pk_bf16(v[4], v[5]); w.w = pk_bf16(v[6], v[7]);
                    *(u32x4*)(rowp + bj * 128) = w;
                }
            }
    }
    template <int ACT> DI void merge2(const f32x4 (&acc)[2][2][4][2], const Unit& u, const float (&rs)[2][4], int rloc, int cloc) const {
        bf16_t* Zout = (bf16_t*)dsc_p(d, 22); const int ldz = dsc_i(d, 5);
#pragma unroll
        for (int ai = 0; ai < 2; ++ai)
#pragma unroll
            for (int m = 0; m < 4; ++m) {
                const int row = u.pm * 256 + rloc + ai * 128 + m * 16; bf16_t* rowp = Zout + (size_t)row * ldz + u.zc + cloc; const float r = rs[ai][m];
                float v[8];
#pragma unroll
                for (int n = 0; n < 2; ++n)
#pragma unroll
                    for (int j = 0; j < 4; ++j) {
                        const float a = acc[ai][0][m][n][j] * r, b = acc[ai][1][m][n][j] * r;
                        v[n * 4 + j] = (ACT == 3) ? a * b : a * sigmoidf_(b);
                    }
                u32x4 w; w.x = pk_bf16(v[0], v[1]); w.y = pk_bf16(v[2], v[3]); w.z = pk_bf16(v[4], v[5]); w.w = pk_bf16(v[6], v[7]);
                *(u32x4*)rowp = w;
            }
    }
    static DI float gclamp(float g) { return fmaxf(g, 1e-20f); }
    DI void rescale(f32x4 (&acc)[2][2][4][2], const Unit& u, int k, int wr, int wc, int fr, int fq) const {
        int rloc = wr * 64 + fr, cloc = wc * 32 + 8 * fq;
        asm volatile("" : "+v"(rloc), "+v"(cloc));
        const bf16_t* Zg = (const bf16_t*)(ws + WS_Z) + 3072 + 1024 * (k - 1) + u.pn * 256 + cloc;
#pragma unroll
        for (int ai = 0; ai < 2; ++ai) {
            u32x4 gp_[4][2], gn_[4][2];
#pragma unroll
            for (int m = 0; m < 4; ++m) { const int row = u.pm * 256 + rloc + ai * 128 + m * 16; const bf16_t* gp = Zg + (size_t)row * ZP;
#pragma unroll
                for (int bj = 0; bj < 2; ++bj) { gp_[m][bj] = *(const u32x4*)(gp + bj * 128); gn_[m][bj] = *(const u32x4*)(gp + 1024 + bj * 128); } }
#pragma unroll
            for (int m = 0; m < 4; ++m) {
#pragma unroll
                for (int bj = 0; bj < 2; ++bj) {
                    const u32x4 a = gp_[m][bj], b = gn_[m][bj];
                    acc[ai][bj][m][0][0] *= gclamp(bf_lo(a.x)) * __builtin_amdgcn_rcpf(gclamp(bf_lo(b.x))); acc[ai][bj][m][0][1] *= gclamp(bf_hi(a.x)) * __builtin_amdgcn_rcpf(gclamp(bf_hi(b.x)));
                    acc[ai][bj][m][0][2] *= gclamp(bf_lo(a.y)) * __builtin_amdgcn_rcpf(gclamp(bf_lo(b.y))); acc[ai][bj][m][0][3] *= gclamp(bf_hi(a.y)) * __builtin_amdgcn_rcpf(gclamp(bf_hi(b.y)));
                    acc[ai][bj][m][1][0] *= gclamp(bf_lo(a.z)) * __builtin_amdgcn_rcpf(gclamp(bf_lo(b.z))); acc[ai][bj][m][1][1] *= gclamp(bf_hi(a.z)) * __builtin_amdgcn_rcpf(gclamp(bf_hi(b.z)));
                    acc[ai][bj][m][1][2] *= gclamp(bf_lo(a.w)) * __builtin_amdgcn_rcpf(gclamp(bf_lo(b.w))); acc[ai][bj][m][1][3] *= gclamp(bf_hi(a.w)) * __builtin_amdgcn_rcpf(gclamp(bf_hi(b.w)));
                }
            }
            asm volatile("" ::: "memory");
        }
    }
    DI void operator()(const f32x4 (&acc)[2][2][4][2], const Unit& u, int wr, int wc, int fr, int fq) const {
        const int kind = u.kind; int rloc = wr * 64 + fr, cloc = wc * 32 + 8 * fq;
        asm volatile("" : "+v"(rloc), "+v"(cloc));
        if (kind == 8) {
            const int xf32 = dsc_i(d, 7);
            const float* xin = (u.pm < 64) ? (const float*)dsc_p(d, 16) : (const float*)dsc_p(d, 18) - (size_t)MP * DM;
            bf16_t* XB = (bf16_t*)(ws + WS_XB); float* SS = (float*)(ws + WS_SS);
#pragma unroll
            for (int ai = 0; ai < 2; ++ai) {
                u32x4 xv[4][2];
                if (!xf32) {
#pragma unroll
                    for (int m = 0; m < 4; ++m) { const size_t off = (size_t)(u.pm * 256 + rloc + ai * 128 + m * 16) * DM + u.pn * 256 + cloc;
#pragma unroll
                        for (int bj = 0; bj < 2; ++bj) xv[m][bj] = *(const u32x4*)(XB + off + bj * 128); }
                }
#pragma unroll
                for (int m = 0; m < 4; ++m) {
                    const int row = u.pm * 256 + rloc + ai * 128 + m * 16; const size_t off = (size_t)row * DM + u.pn * 256 + cloc; float ss = 0.f;
#pragma unroll
                    for (int bj = 0; bj < 2; ++bj) {
                        f32x4 x0, x1;
                        if (xf32) { x0 = *(const f32x4*)(xin + off + bj * 128); x1 = *(const f32x4*)(xin + off + bj * 128 + 4); }
                        else { const u32x4 v = xv[m][bj]; x0 = (f32x4){bf_lo(v.x), bf_hi(v.x), bf_lo(v.y), bf_hi(v.y)}; x1 = (f32x4){bf_lo(v.z), bf_hi(v.z), bf_lo(v.w), bf_hi(v.w)}; }
                        x0 += acc[ai][bj][m][0]; x1 += acc[ai][bj][m][1];
                        u32x4 w; w.x = pk_bf16(x0[0], x0[1]); w.y = pk_bf16(x0[2], x0[3]); w.z = pk_bf16(x1[0], x1[1]); w.w = pk_bf16(x1[2], x1[3]);
                        *(u32x4*)(XB + off + bj * 128) = w;
                        const f32x4 y0 = (f32x4){bf_lo(w.x), bf_hi(w.x), bf_lo(w.y), bf_hi(w.y)}, y1 = (f32x4){bf_lo(w.z), bf_hi(w.z), bf_lo(w.w), bf_hi(w.w)};
                        ss += (y0[0] * y0[0] + y0[1] * y0[1]) + (y0[2] * y0[2] + y0[3] * y0[3]) + (y1[0] * y1[0] + y1[1] * y1[1]) + (y1[2] * y1[2] + y1[3] * y1[3]);
                    }
                    ss += __shfl_xor(ss, 16); ss += __shfl_xor(ss, 32);
                    if (fq == 0) SS[(size_t)row * 16 + u.pn * 4 + wc] = ss;
                    if (xf32 && (m & 1)) asm volatile("" ::: "memory");
                }
                asm volatile("" ::: "memory");
            }
            return;
        }
        if (kind == 9) {
            const bf16_t* Zg = (const bf16_t*)(ws + WS_Z) + 3072 + 1024 * 3 + u.pn * 256 + cloc; bf16_t* MG = (bf16_t*)(ws + WS_MG);
#pragma unroll
            for (int ai = 0; ai < 2; ++ai) {
                u32x4 g[4][2];
#pragma unroll
                for (int m = 0; m < 4; ++m) { const int row = u.pm * 256 + rloc + ai * 128 + m * 16; const bf16_t* gp = Zg + (size_t)row * ZP;
#pragma unroll
                    for (int bj = 0; bj < 2; ++bj) g[m][bj] = *(const u32x4*)(gp + bj * 128); }
#pragma unroll
                for (int m = 0; m < 4; ++m) {
                    const int row = u.pm * 256 + rloc + ai * 128 + m * 16; bf16_t* mp = MG + (size_t)row * DM + u.pn * 256 + cloc;
#pragma unroll
                    for (int bj = 0; bj < 2; ++bj) {
                        const u32x4 gg = g[m][bj]; const f32x4 a0 = acc[ai][bj][m][0], a1 = acc[ai][bj][m][1]; u32x4 w;
                        w.x = pk_bf16(gclamp(bf_lo(gg.x)) * a0[0], gclamp(bf_hi(gg.x)) * a0[1]); w.y = pk_bf16(gclamp(bf_lo(gg.y)) * a0[2], gclamp(bf_hi(gg.y)) * a0[3]);
                        w.z = pk_bf16(gclamp(bf_lo(gg.z)) * a1[0], gclamp(bf_hi(gg.z)) * a1[1]); w.w = pk_bf16(gclamp(bf_lo(gg.w)) * a1[2], gclamp(bf_hi(gg.w)) * a1[3]);
                        *(u32x4*)(mp + bj * 128) = w;
                    }
                }
                asm volatile("" ::: "memory");
            }
            return;
        }
        if (kind == 5) {
            const float* SSM = (const float*)(ws + WS_SSM); const int l = u.zc, b = u.pm;
#pragma unroll
            for (int ai = 0; ai < 2; ++ai)
#pragma unroll
                for (int m = 0; m < 4; ++m) {
                    const int key = rloc + ai * 128 + m * 16, row = b * 256 + key; const float r = __builtin_amdgcn_rsqf(SSM[row] * (1.f / 1024.f) + EPS);
#pragma unroll
                    for (int bj = 0; bj < 2; ++bj) {
                        const int col = u.pn * 256 + bj * 128 + cloc;
                        const f32x4 v0 = acc[ai][bj][m][0] * r, v1 = acc[ai][bj][m][1] * r;
                        float* op = out + (col < 1024 ? O_MK : O_MV) + (size_t)l * 2097152 + (size_t)row * 1024 + (col & 1023);
                        *(f32x4*)op = v0; *(f32x4*)(op + 4) = v1;
                        const int h = (col & 1023) >> 8, d = col & 255; const size_t hb = ((size_t)(l * 8 + b) * 4 + h) * 65536;
                        if (col < 1024) {
                            u32x4 w; w.x = pk_bf16(v0[0], v0[1]); w.y = pk_bf16(v0[2], v0[3]); w.z = pk_bf16(v1[0], v1[1]); w.w = pk_bf16(v1[2], v1[3]);
                            *(u32x4*)((bf16_t*)(ws + WS_KP) + hb + (size_t)key * 256 + d) = w;
                        } else {
                            bf16_t* vt = (bf16_t*)(ws + WS_VTP) + hb + (size_t)d * 256 + key;
#pragma unroll
                            for (int j = 0; j < 4; ++j) { vt[j * 256] = (bf16_t)(pk_bf16(v0[j], 0.f) & 0xffffu); vt[(4 + j) * 256] = (bf16_t)(pk_bf16(v1[j], 0.f) & 0xffffu); }
                        }
                    }
                    asm volatile("" ::: "memory");
                }
            return;
        }
        float rs[2][4]; const float* SS = (const float*)(ws + WS_SS); const float scale = __int_as_float(dsc_i(d, 6));
#pragma unroll
        for (int ai = 0; ai < 2; ++ai)
#pragma unroll
            for (int m = 0; m < 4; ++m) {
                const f32x4 s4 = *(const f32x4*)(SS + (size_t)(u.pm * 256 + rloc + ai * 128 + m * 16) * 16 + fq * 4);
                float t = (s4[0] + s4[1]) + (s4[2] + s4[3]); t += __shfl_xor(t, 16); t += __shfl_xor(t, 32);
                rs[ai][m] = __builtin_amdgcn_rsqf(t * (1.f / 1024.f) + EPS) * scale;
            }
        switch (kind) {
            case 0: plain<0>(acc, u, rs, rloc, cloc); break;
            case 1: plain<1>(acc, u, rs, rloc, cloc); break;
            case 2: plain<2>(acc, u, rs, rloc, cloc); break;
            case 7: plain<7>(acc, u, rs, rloc, cloc); break;
            case 3: merge2<3>(acc, u, rs, rloc, cloc); break;
            default: merge2<4>(acc, u, rs, rloc, cloc); break;
        }
    }
};

DI void gemm_phase(LAS unsigned char* lds, const int K, const bool hook, const SchedU& S, const EpiU& E) {
    const int tid = opaque_tid(), wid = __builtin_amdgcn_readfirstlane(tid >> 6), lane = tid & 63, wr = wid >> 2, wc = wid & 3, fr = lane & 15, fq = lane >> 4;
    const int nt = K / BK;
    unsigned voffA[2], voffB[2];
#pragma unroll
    for (int i = 0; i < 2; ++i) { int R, C; stage_rc(tid * 16 + i * 8192, R, C); const int Rb = (R & ~31) + perm32(R & 31);
        voffA[i] = (unsigned)(R * K + C) * 2u; voffB[i] = (unsigned)(Rb * K + C) * 2u; }
    const size_t kstep = (size_t)(BK * 2);
    const size_t hstep = (size_t)HALF * K * 2;
    const unsigned ldsw = (unsigned)wid * 1024u;
    const int aoff = lds_byte(wr * 64 + fr, fq * 8), boff = lds_byte(wc * 32 + fr, fq * 8);
#define PG8_SA(b, h) (((b) * 2 + (h)) * HTB)
#define PG8_SB(b, h) ((4 + (b) * 2 + (h)) * HTB)
#define PG8_STAGE(bufoff, gbase, voff) do { _Pragma("unroll") for (int _i = 0; _i < 2; ++_i) \
        __builtin_amdgcn_global_load_lds((const unsigned*)((const char*)(gbase) + (voff)[_i]), (LAS unsigned*)(lds + (bufoff) + ldsw + _i * 8192), 16, 0, 0); } while (0)
#define PG8_LDA(dst, b, h) do { _Pragma("unroll") for (int m = 0; m < 4; ++m) _Pragma("unroll") for (int k = 0; k < 2; ++k) dst[m][k] = *(const LAS bf16x8*)(lds + PG8_SA(b, h) + aoff + m * 2048 + k * 1024); } while (0)
#define PG8_LDB(dst, b, h) do { _Pragma("unroll") for (int n = 0; n < 2; ++n) _Pragma("unroll") for (int k = 0; k < 2; ++k) dst[n][k] = *(const LAS bf16x8*)(lds + PG8_SB(b, h) + boff + n * 2048 + k * 1024); } while (0)
#define PG8_MMA(ai, bj, At, Bt) do { __builtin_amdgcn_s_setprio(1); _Pragma("unroll") for (int m = 0; m < 4; ++m) _Pragma("unroll") for (int n = 0; n < 2; ++n) _Pragma("unroll") for (int k = 0; k < 2; ++k) \
        acc[ai][bj][m][n] = __builtin_amdgcn_mfma_f32_16x16x32_bf16(Bt[n][k], At[m][k], acc[ai][bj][m][n], 0, 0, 0); __builtin_amdgcn_s_setprio(0); } while (0)
#define PG8_WAIT_V(n) asm volatile("s_waitcnt vmcnt(" #n ")" ::: "memory")
#define PG8_WAIT_L(n) asm volatile("s_waitcnt lgkmcnt(" #n ")" ::: "memory")
#define PG8_BAR __builtin_amdgcn_s_barrier()
#define PG8_SCHED __builtin_amdgcn_sched_barrier(0)
    Unit cur, nxt; int ui = 0;
    if (!S.next(0, cur)) return;
    f32x4 acc[2][2][4][2];
#pragma unroll
    for (int a = 0; a < 2; ++a)
#pragma unroll
        for (int b = 0; b < 2; ++b)
#pragma unroll
            for (int m = 0; m < 4; ++m)
#pragma unroll
                for (int n = 0; n < 2; ++n) acc[a][b][m][n] = (f32x4){0.f, 0.f, 0.f, 0.f};
    bf16x8 At[4][2], B0[2][2], B1[2][2];
    const char* cA = cur.a; const char* cB = cur.b;
    PG8_STAGE(PG8_SB(0, 0), cB, voffB); PG8_STAGE(PG8_SB(0, 1), cB + hstep, voffB); PG8_STAGE(PG8_SA(0, 0), cA, voffA); PG8_STAGE(PG8_SA(0, 1), cA + hstep, voffA);
    if (wr == 1) PG8_BAR;
    PG8_WAIT_V(2); PG8_BAR;
    PG8_STAGE(PG8_SB(1, 0), cB + kstep, voffB); PG8_STAGE(PG8_SA(1, 0), cA + kstep, voffA); PG8_STAGE(PG8_SB(1, 1), cB + hstep + kstep, voffB);
    PG8_WAIT_V(6); PG8_BAR;
    for (;;) {
        const bool has_next = S.next(ui + 1, nxt);
        const char* nA = has_next ? nxt.a : cA; const char* nB = has_next ? nxt.b : cB;
        for (int t = 0; t < nt; t += 2) {
            const bool last = (t == nt - 2);
            if (hook && t != 0 && (t & 7) == 0) E.rescale(acc, cur, t >> 3, wr, wc, fr, fq);
            asm volatile("" : "+v"(voffA[0]), "+v"(voffA[1]), "+v"(voffB[0]), "+v"(voffB[1]));
            const char* a1 = cA + (size_t)(t + 1) * kstep;
            const char* a2 = last ? nA : cA + (size_t)(t + 2) * kstep; const char* b2 = last ? nB : cB + (size_t)(t + 2) * kstep;
            const char* a3 = a2 + kstep; const char* b3 = b2 + kstep;
            PG8_LDB(B0, 0, 0); PG8_LDB(B1, 0, 1); PG8_SCHED; PG8_LDA(At, 0, 0); PG8_STAGE(PG8_SA(1, 1), a1 + hstep, voffA);
            PG8_WAIT_V(8); PG8_WAIT_L(0); PG8_BAR; PG8_MMA(0, 0, At, B0); PG8_MMA(0, 1, At, B1); PG8_BAR; PG8_SCHED;
            PG8_LDA(At, 0, 1); PG8_STAGE(PG8_SB(0, 0), b2, voffB); PG8_STAGE(PG8_SB(0, 1), b2 + hstep, voffB); PG8_STAGE(PG8_SA(0, 0), a2, voffA);
            PG8_WAIT_V(8); PG8_WAIT_L(0); PG8_BAR; PG8_MMA(1, 0, At, B0); PG8_MMA(1, 1, At, B1); PG8_BAR; PG8_SCHED;
            PG8_LDB(B0, 1, 0); PG8_LDB(B1, 1, 1); PG8_SCHED; PG8_LDA(At, 1, 0); PG8_STAGE(PG8_SA(0, 1), a2 + hstep, voffA);
            PG8_WAIT_V(8); PG8_WAIT_L(0); PG8_BAR; PG8_MMA(0, 0, At, B0); PG8_MMA(0, 1, At, B1); PG8_BAR; PG8_SCHED;
            PG8_LDA(At, 1, 1); PG8_STAGE(PG8_SB(1, 0), b3, voffB); PG8_STAGE(PG8_SB(1, 1), b3 + hstep, voffB); PG8_STAGE(PG8_SA(1, 0), a3, voffA);
            PG8_WAIT_V(8); PG8_WAIT_L(0); PG8_BAR; PG8_MMA(1, 0, At, B0); PG8_MMA(1, 1, At, B1); PG8_BAR; PG8_SCHED;
        }
        if (wr == 0) PG8_BAR;
        E(acc, cur, wr, wc, fr, fq);
        if (!has_next) break;
#pragma unroll
        for (int a = 0; a < 2; ++a)
#pragma unroll
            for (int b = 0; b < 2; ++b)
#pragma unroll
                for (int m = 0; m < 4; ++m)
#pragma unroll
                    for (int n = 0; n < 2; ++n) acc[a][b][m][n] = (f32x4){0.f, 0.f, 0.f, 0.f};
        cur = nxt; cA = nA; cB = nB; ++ui;
        if (wr == 1) PG8_BAR;
    }
    PG8_WAIT_V(0);
    PG8_BAR;
#undef PG8_SA
#undef PG8_SB
#undef PG8_STAGE
#undef PG8_LDA
#undef PG8_LDB
#undef PG8_MMA
#undef PG8_WAIT_V
#undef PG8_WAIT_L
#undef PG8_BAR
#undef PG8_SCHED
}
}

DI void transpose_item(const float* W, int K, int N, bf16_t* WT, int pitch, int k0, int n0, int drow0, const float* gk, float* scr, int lane) {
#pragma unroll
    for (int i = 0; i < 32; ++i) { const int kk = 2 * i + (lane >> 5); float v = W[(size_t)(k0 + kk) * N + n0 + (lane & 31)]; if (gk) v *= gk[k0 + kk]; scr[kk * 33 + (lane & 31)] = v; }
    asm volatile("s_waitcnt lgkmcnt(0)" ::: "memory");
    const int c = lane & 7;
#pragma unroll
    for (int j = 0; j < 4; ++j) { const int n = (lane >> 3) + 8 * j; const float* s = scr + (8 * c) * 33 + n;
        u32x4 o; o.x = pk_bf16(s[0 * 33], s[1 * 33]); o.y = pk_bf16(s[2 * 33], s[3 * 33]); o.z = pk_bf16(s[4 * 33], s[5 * 33]); o.w = pk_bf16(s[6 * 33], s[7 * 33]);
        *(u32x4*)(WT + (size_t)(drow0 + n) * pitch + k0 + 8 * c) = o; }
    asm volatile("s_waitcnt lgkmcnt(0)" ::: "memory");
}
DI int win_block_map(int sb) {
    if (sb < 4) return sb;
    if (sb < 8) return 4 + 2 * (sb - 4);
    if (sb < 12) return 12 + (sb - 8);
    if (sb < 16) return 5 + 2 * (sb - 12);
    if (sb < 24) return sb;
    if (sb < 28) return 24 + 2 * (sb - 24);
    if (sb < 32) return 25 + 2 * (sb - 28);
    return sb;
}
DI float row_to_bf16(const float* xrow, bf16_t* orow, int lane) {
    const f32x4* xr = (const f32x4*)xrow + lane; float s = 0.f; f32x4 v[4];
#pragma unroll
    for (int j = 0; j < 4; ++j) { v[j] = xr[64 * j]; s += (v[j].x * v[j].x + v[j].y * v[j].y) + (v[j].z * v[j].z + v[j].w * v[j].w); }
    u32x2* o = (u32x2*)orow + lane;
#pragma unroll
    for (int j = 0; j < 4; ++j) { u32x2 w; w.x = pk_bf16(v[j].x, v[j].y); w.y = pk_bf16(v[j].z, v[j].w); o[64 * j] = w; }
    return wave_sum(s);
}

DI void prologue(const Params& p, unsigned char* lds, int G, int mask) {
    const int tid = opaque_tid(), lane = tid & 63, wave = __builtin_amdgcn_readfirstlane(tid >> 6);
    float* scr = (float*)(lds + wave * 16384);
    const int gw = opaque_bid() * 8 + wave, NGW = G * 8;
    unsigned char* ws = ws_of(p);
    {
        constexpr int T_IN = 16 * 64, T_BR = 8 * 8, T_SQ = 16 * 8, T_F1 = 16 * 32, T_F2 = 64 * 8;
        constexpr int T_L = T_IN + 3 * T_BR + 5 * T_SQ + T_F1 + T_F2;
        unsigned* Tl = (unsigned*)lds;
        const int lr = tid >> 5, lc = (tid & 31) * 4;
        f32x4 cur[4], nxt[4]; const float* gk_c = nullptr; const float* gk_n = nullptr;
        bf16_t* WT_c = nullptr; bf16_t* WT_n = nullptr; int pitch_c = 0, pitch_n = 0, k0_c = 0, k0_n = 0, dr_c = 0, dr_n = 0;
#define TR_SETUP(it_, W_, N_, WT_, pitch_, gk_, k0_, n0_, dr_) do { \
            const int l_ = (it_) / T_L; int r_ = (it_) % T_L; bool is_in_ = false; int K_; (gk_) = nullptr; (pitch_) = 0; \
            if (r_ < T_IN) { W_ = p.in[9] + (size_t)l_ * 1024 * 8192; K_ = 1024; N_ = 8192; WT_ = (bf16_t*)(ws + WS_WIN) + (size_t)l_ * 8192 * 1024; gk_ = p.in[8] + l_ * 1024; is_in_ = true; } \
            else if ((r_ -= T_IN) < 3 * T_BR) { const int k_ = 1 + r_ / T_BR; r_ %= T_BR; W_ = p.in[21] + ((size_t)l_ * 4 + k_) * 512 * 1024; K_ = 512; N_ = 1024; WT_ = (bf16_t*)(ws + WS_WB) + (size_t)l_ * 2097152 + k_ * 512; pitch_ = 2048; } \
            else if ((r_ -= 3 * T_BR) < 5 * T_SQ) { const int w_ = r_ / T_SQ; r_ %= T_SQ; K_ = 1024; N_ = 1024; \
                if (w_ == 0) { W_ = p.in[23] + (size_t)l_ * 1048576; WT_ = (bf16_t*)(ws + WS_WMIX) + (size_t)l_ * 1048576; } \
                else if (w_ == 1) { W_ = p.in[26] + (size_t)l_ * 1048576; WT_ = (bf16_t*)(ws + WS_WQ) + (size_t)l_ * 1048576; gk_ = p.in[24] + l_ * 1024; } \
                else if (w_ == 2) { W_ = p.in[27] + (size_t)l_ * 1048576; WT_ = (bf16_t*)(ws + WS_WKV) + (size_t)l_ * 2097152; gk_ = p.in[25] + l_ * 1024; } \
                else if (w_ == 3) { W_ = p.in[28] + (size_t)l_ * 1048576; WT_ = (bf16_t*)(ws + WS_WKV) + (size_t)l_ * 2097152 + 1048576; gk_ = p.in[25] + l_ * 1024; } \
                else { W_ = p.in[29] + (size_t)l_ * 1048576; WT_ = (bf16_t*)(ws + WS_WO) + (size_t)l_ * 1048576; } } \
            else if ((r_ -= 5 * T_SQ) < T_F1) { W_ = p.in[31] + (size_t)l_ * 4194304; K_ = 1024; N_ = 4096; WT_ = (bf16_t*)(ws + WS_W1) + (size_t)l_ * 4194304; gk_ = p.in[30] + l_ * 1024; } \
            else { r_ -= T_F1; W_ = p.in[32] + (size_t)l_ * 4194304; K_ = 4096; N_ = 1024; WT_ = (bf16_t*)(ws + WS_W2) + (size_t)l_ * 4194304; } \
            if (!(pitch_)) (pitch_) = K_; \
            const int nblk_ = N_ / 128; (k0_) = 64 * (r_ / nblk_); (n0_) = 128 * (r_ % nblk_); (dr_) = is_in_ ? win_block_map((n0_) >> 7) * 128 : (n0_); } while (0)
        int it = opaque_bid();
        if ((mask & 1) && it < 2 * T_L) {
            { const float* W; int N, n0; TR_SETUP(it, W, N, WT_c, pitch_c, gk_c, k0_c, n0, dr_c);
#pragma unroll
              for (int i = 0; i < 4; ++i) cur[i] = *(const f32x4*)(W + (size_t)(k0_c + lr + 16 * i) * N + n0 + lc); }
            for (; it < 2 * T_L; it += G) {
                const int itn = it + G; const bool has_n = itn < 2 * T_L;
                if (has_n) { const float* W; int N, n0; TR_SETUP(itn, W, N, WT_n, pitch_n, gk_n, k0_n, n0, dr_n);
#pragma unroll
                    for (int i = 0; i < 4; ++i) nxt[i] = *(const f32x4*)(W + (size_t)(k0_n + lr + 16 * i) * N + n0 + lc); }
                unsigned short* Th = (unsigned short*)Tl;
#pragma unroll
                for (int i = 0; i < 4; ++i) {
                    const int kk = lr + 16 * i; const float g = gk_c ? gk_c[k0_c + kk] : 1.f; const f32x4 v = cur[i] * g;
#pragma unroll
                    for (int j = 0; j < 4; ++j) Th[(lc + j) * 66 + kk] = (unsigned short)(pk_bf16(v[j], 0.f) & 0xffffu);
                }
                __syncthreads();
#pragma unroll
                for (int q = 0; q < 2; ++q) {
                    const int idx = tid + 512 * q, n = idx >> 3, c = idx & 7; const unsigned* src = Tl + n * 33 + c * 4;
                    u32x4 o; o.x = src[0]; o.y = src[1]; o.z = src[2]; o.w = src[3];
                    *(u32x4*)(WT_c + (size_t)(dr_c + n) * pitch_c + k0_c + 8 * c) = o;
                }
                __syncthreads();
#pragma unroll
                for (int i = 0; i < 4; ++i) cur[i] = nxt[i];
                gk_c = gk_n; WT_c = WT_n; pitch_c = pitch_n; k0_c = k0_n; dr_c = dr_n;
            }
        }
#undef TR_SETUP
        __syncthreads();
    }
    if (mask & 2)
    for (int it = opaque_bid(); it < 2 * 4 * 32; it += G) {
        const int l = it >> 7, g = (it >> 5) & 3, db = it & 31;
        float* pwT = (float*)lds;
        __syncthreads();
        {
            const float* pw = p.in[10] + ((size_t)l * 4 + g) * 16384; const float* sc = p.in[11] + l * 512 + g * 128;
#pragma unroll 8
            for (int e = tid; e < 16384; e += 512) { const int i = e >> 7, j = e & 127; pwT[j * 132 + i] = pw[e] * sc[j]; }
        }
        __syncthreads();
        const int d = db * 32 + (tid & 31), i0 = (tid >> 5) * 8;
        const float* wb = p.in[21] + ((size_t)l * 4) * 512 * 1024 + (size_t)(g * 128) * 1024 + d;
        float a[8];
#pragma unroll
        for (int r = 0; r < 8; ++r) a[r] = 0.f;
#pragma unroll 16
        for (int j = 0; j < 128; ++j) {
            const float w = wb[(size_t)j * 1024];
            const f32x4 p0 = *(const f32x4*)(pwT + j * 132 + i0), p1 = *(const f32x4*)(pwT + j * 132 + i0 + 4);
            a[0] += p0[0] * w; a[1] += p0[1] * w; a[2] += p0[2] * w; a[3] += p0[3] * w; a[4] += p1[0] * w; a[5] += p1[1] * w; a[6] += p1[2] * w; a[7] += p1[3] * w;
        }
        bf16_t* o = (bf16_t*)(ws + WS_WB) + (size_t)l * 2097152 + (size_t)d * 2048 + g * 128 + i0;
        u32x4 w0; w0.x = pk_bf16(a[0], a[1]); w0.y = pk_bf16(a[2], a[3]); w0.z = pk_bf16(a[4], a[5]); w0.w = pk_bf16(a[6], a[7]);
        *(u32x4*)o = w0;
    }
    __syncthreads();
    if (mask & 4) {
    for (int e = opaque_bid() * 512 + tid; e < 2 * 4 * 128 * 128; e += G * 512) {
        const int t = (e >> 7) & 127, s = e & 127; const float v = (s <= t) ? p.in[15][e] : 0.f;
        ((bf16_t*)(ws + WS_SGUW))[e] = (bf16_t)(pk_bf16(v, 0.f) & 0xffffu);
    }
    float* SS = (float*)(ws + WS_SS);
    for (int m0 = gw; m0 < MT; m0 += 2 * NGW) {
        const int m1 = m0 + NGW; const bool two = m1 < MT;
        const float* x0 = (m0 < MP) ? p.in[0] + (size_t)m0 * DM : p.in[1] + (size_t)(m0 - MP) * DM;
        const float* x1 = two ? ((m1 < MP) ? p.in[0] + (size_t)m1 * DM : p.in[1] + (size_t)(m1 - MP) * DM) : x0;
        f32x4 v0[4], v1[4];
#pragma unroll
        for (int j = 0; j < 4; ++j) { v0[j] = ((const f32x4*)x0)[lane + 64 * j]; v1[j] = ((const f32x4*)x1)[lane + 64 * j]; }
        float s0 = 0.f, s1 = 0.f;
#pragma unroll
        for (int j = 0; j < 4; ++j) { s0 += (v0[j].x * v0[j].x + v0[j].y * v0[j].y) + (v0[j].z * v0[j].z + v0[j].w * v0[j].w); s1 += (v1[j].x * v1[j].x + v1[j].y * v1[j].y) + (v1[j].z * v1[j].z + v1[j].w * v1[j].w); }
        u32x2* o0 = (u32x2*)((bf16_t*)(ws + WS_XB) + (size_t)m0 * DM) + lane;
#pragma unroll
        for (int j = 0; j < 4; ++j) { u32x2 w; w.x = pk_bf16(v0[j].x, v0[j].y); w.y = pk_bf16(v0[j].z, v0[j].w); o0[64 * j] = w; }
        s0 = wave_sum(s0);
        if (lane < 16) SS[(size_t)m0 * 16 + lane] = (lane == 0) ? s0 : 0.f;
        if (two) {
            u32x2* o1 = (u32x2*)((bf16_t*)(ws + WS_XB) + (size_t)m1 * DM) + lane;
#pragma unroll
            for (int j = 0; j < 4; ++j) { u32x2 w; w.x = pk_bf16(v1[j].x, v1[j].y); w.y = pk_bf16(v1[j].z, v1[j].w); o1[64 * j] = w; }
            s1 = wave_sum(s1);
            if (lane < 16) SS[(size_t)m1 * 16 + lane] = (lane == 0) ? s1 : 0.f;
        }
    }
    for (int m = gw; m < 2048; m += NGW) {
        const float s = row_to_bf16(p.in[7] + (size_t)m * DM, (bf16_t*)(ws + WS_MB) + (size_t)m * DM, lane);
        if (lane == 0) ((float*)(ws + WS_SSM))[m] = s;
    }
    }
}

template <bool SAMPLE, int NROWS>
DI void stage_rows(float* tile, int hist, const float* state, const bf16_t* Zcol, int rowbase, int tt0, float* outp, int ncarry, bool write_carry, int tid) {
    constexpr int ITER = (NROWS * 64 + 511) / 512;
    u32x4 vb[ITER]; f32x4 slo[ITER], shi[ITER];
#pragma unroll
    for (int i = 0; i < ITER; ++i) {
        const int c = tid + 512 * i, k = c >> 6, cc = (c & 63) * 8;
        vb[i] = (u32x4){0u, 0u, 0u, 0u}; slo[i] = (f32x4){0.f, 0.f, 0.f, 0.f}; shi[i] = (f32x4){0.f, 0.f, 0.f, 0.f};
        if (c < NROWS * 64) {
            if (SAMPLE) {
                if (k < hist) { slo[i] = *(const f32x4*)(state + (size_t)k * WBR + cc); shi[i] = *(const f32x4*)(state + (size_t)k * WBR + cc + 4); }
                else vb[i] = *(const u32x4*)(Zcol + (size_t)(rowbase + k - hist) * ZP + cc);
            } else {
                const int t = tt0 - hist + k;
                if (t >= 0) vb[i] = *(const u32x4*)(Zcol + (size_t)(rowbase + t) * ZP + cc);
            }
        }
    }
#pragma unroll
    for (int i = 0; i < ITER; ++i) {
        const int c = tid + 512 * i, k = c >> 6, cc = (c & 63) * 8;
        if (c < NROWS * 64) {
            f32x4 lo, hi; int ci;
            const u32x4 v = vb[i];
            lo = (f32x4){bf_lo(v.x), bf_hi(v.x), bf_lo(v.y), bf_hi(v.y)}; hi = (f32x4){bf_lo(v.z), bf_hi(v.z), bf_lo(v.w), bf_hi(v.w)};
            if (SAMPLE) { if (k < hist) { lo = slo[i]; hi = shi[i]; } ci = k - (NROWS - ncarry); }
            else ci = (tt0 - hist + k) - (SEQ - ncarry);
            *(f32x4*)(tile + k * WBR + cc) = lo; *(f32x4*)(tile + k * WBR + cc + 4) = hi;
            if (write_carry && ci >= 0) { *(f32x4*)(outp + (size_t)ci * WBR + cc) = lo; *(f32x4*)(outp + (size_t)ci * WBR + cc + 4) = hi; }
        }
    }
}
template <int NT, int W> DI void pool_compute(const float* tile, int ch, int tt0, bool sample, float (&o)[NT]) {
    float e[NT + 15];
#pragma unroll
    for (int k = 0; k < NT + 15; ++k) e[k] = tile[k * WBR + ch];
#pragma unroll
    for (int j = 0; j < NT; ++j) {
        float s = 0.f;
#pragma unroll
        for (int i = 0; i < W; ++i) s += e[j + 15 - i];
        const int pos = tt0 + j; const float inv = (sample || pos + 1 >= W) ? 1.f / (float)W : 1.f / (float)(pos + 1);
        o[j] = s * inv - e[j + 15];
    }
}
struct ConvConst { float cw[31]; float cb, lng, lnb, sw0, sw1, sw2, sg, sb; };
template <int NT, bool SAMPLE>
DI void conv_item(const Params& p, int l, int b, int tt0, const ConvConst& cc, float* tile, float* red, int tid, int lane, int wave) {
    const bf16_t* Z = (const bf16_t*)(ws_of(p) + WS_Z); const int ch = tid;
    const int rowbase = SAMPLE ? MP + b * NSQ : b * SEQ; const int row0 = SAMPLE ? rowbase : rowbase + tt0;
    const bool lastp = SAMPLE || (tt0 + NT == SEQ);
    stage_rows<SAMPLE, NT + 15>(tile, 15, SAMPLE ? p.in[2] + ((size_t)l * NSB + b) * 15 * WBR : nullptr, Z, rowbase, tt0,
                       SAMPLE ? out_of(p) + O_POOLS + ((size_t)l * NSB + b) * 15 * WBR : out_of(p) + O_POOLP + ((size_t)l * NB + b) * 15 * WBR, 15, lastp, tid);
    __syncthreads();
    {
        float o[NT];
        switch (wave >> 1) {
            case 0: pool_compute<NT, 2>(tile, ch, tt0, SAMPLE, o); break;
            case 1: pool_compute<NT, 4>(tile, ch, tt0, SAMPLE, o); break;
            case 2: pool_compute<NT, 8>(tile, ch, tt0, SAMPLE, o); break;
            default: pool_compute<NT, 16>(tile, ch, tt0, SAMPLE, o); break;
        }
        bf16_t* BR0 = (bf16_t*)(ws_of(p) + WS_BR) + (size_t)row0 * 2048 + ch;
#pragma unroll
        for (int j = 0; j < NT; ++j) BR0[j * 2048] = (bf16_t)(pk_bf16(o[j], 0.f) & 0xffffu);
    }
    __syncthreads();
    stage_rows<SAMPLE, NT + 2>(tile, 2, SAMPLE ? p.in[3] + ((size_t)l * NSB + b) * 2 * WBR : nullptr, Z + 512, rowbase, tt0,
                       SAMPLE ? out_of(p) + O_SCS + ((size_t)l * NSB + b) * 2 * WBR : out_of(p) + O_SCP + ((size_t)l * NB + b) * 2 * WBR, 2, lastp, tid);
    stage_rows<false, NT>(tile + (NT + 2) * WBR, 0, nullptr, Z + 1024, row0, 0, nullptr, 0, false, tid);
    __syncthreads();
    {
        bf16_t* BR1 = (bf16_t*)(ws_of(p) + WS_BR) + (size_t)row0 * 2048 + 512 + ch;
#pragma unroll
        for (int j = 0; j < NT; ++j) {
            const float c = cc.sw0 * tile[j * WBR + ch] + cc.sw1 * tile[(j + 1) * WBR + ch] + cc.sw2 * tile[(j + 2) * WBR + ch];
            BR1[j * 2048] = (bf16_t)(pk_bf16(tile[(NT + 2 + j) * WBR + ch] * c, 0.f) & 0xffffu);
        }
    }
    __syncthreads();
    stage_rows<SAMPLE, NT + 30>(tile, 30, SAMPLE ? p.in[4] + ((size_t)l * NSB + b) * 30 * WBR : nullptr, Z + 2560, rowbase, tt0,
                       SAMPLE ? out_of(p) + O_CCS + ((size_t)l * NSB + b) * 30 * WBR : out_of(p) + O_CCP + ((size_t)l * NB + b) * 30 * WBR, 30, lastp, tid);
    __syncthreads();
    float a[NT];
#pragma unroll
    for (int j = 0; j < NT; ++j) a[j] = cc.cb;
#pragma unroll
    for (int k = 0; k < NT + 30; ++k) {
        const float v = tile[k * WBR + ch];
#pragma unroll
        for (int j = 0; j < NT; ++j) { const int tap = k - j; if (tap >= 0 && tap <= 30) a[j] += cc.cw[tap] * v; }
    }
#pragma unroll
    for (int j = 0; j < NT; ++j) {
        const float s1 = wave_sum(a[j]), s2 = wave_sum(a[j] * a[j]);
        if (lane == 0) { red[(wave * NT + j) * 2] = s1; red[(wave * NT + j) * 2 + 1] = s2; }
    }
    __syncthreads();
    {
        bf16_t* BR3 = (bf16_t*)(ws_of(p) + WS_BR) + (size_t)row0 * 2048 + 1536 + ch;
#pragma unroll
        for (int j = 0; j < NT; ++j) {
            float s1 = 0.f, s2 = 0.f;
#pragma unroll
            for (int w = 0; w < 8; ++w) { s1 += red[(w * NT + j) * 2]; s2 += red[(w * NT + j) * 2 + 1]; }
            const float mean = s1 * (1.f / 512.f), var = fmaxf(s2 * (1.f / 512.f) - mean * mean, 0.f), rstd = __builtin_amdgcn_rsqf(var + EPS);
            const float y = (a[j] - mean) * rstd * cc.lng + cc.lnb;
            BR3[j * 2048] = (bf16_t)(pk_bf16(y * sigmoidf_(y), 0.f) & 0xffffu);
        }
    }
    __syncthreads();
    if (SAMPLE) {
        stage_rows<false, NT>(tile, 0, nullptr, Z + 2048, row0, 0, nullptr, 0, false, tid);
        stage_rows<false, NT>(tile + NT * WBR, 0, nullptr, Z + 1536, row0, 0, nullptr, 0, false, tid);
        __syncthreads();
        float v[NT];
#pragma unroll
        for (int j = 0; j < NT; ++j) {
            v[j] = tile[j * WBR + ch];
            const float s1 = wave_sum(v[j]), s2 = wave_sum(v[j] * v[j]);
            if (lane == 0) { red[(wave * NT + j) * 2] = s1; red[(wave * NT + j) * 2 + 1] = s2; }
        }
        __syncthreads();
        float* ov = out_of(p) + O_SGUV + (((size_t)l * NSB + b) * NSQ) * WBR + ch;
#pragma unroll
        for (int j = 0; j < NT; ++j) {
            float s1 = 0.f, s2 = 0.f;
#pragma unroll
            for (int w = 0; w < 8; ++w) { s1 += red[(w * NT + j) * 2]; s2 += red[(w * NT + j) * 2 + 1]; }
            const float mean = s1 * (1.f / 512.f), var = fmaxf(s2 * (1.f / 512.f) - mean * mean, 0.f), rstd = __builtin_amdgcn_rsqf(var + EPS);
            v[j] = (v[j] - mean) * rstd * cc.sg + cc.sb;
            ov[j * WBR] = v[j];
        }
        const int g = wave >> 1;
        const float* Wg = p.in[15] + ((size_t)l * 4 + g) * 128 * 128; const float* bs = p.in[16] + ((size_t)l * 4 + g) * 128;
        bf16_t* BR2 = (bf16_t*)(ws_of(p) + WS_BR) + (size_t)row0 * 2048 + 1024 + ch;
#pragma unroll
        for (int t = 0; t < NT; ++t) {
            float s0 = bs[t];
#pragma unroll
            for (int s = 0; s <= t; ++s) s0 += Wg[t * 128 + s] * v[s];
            BR2[t * 2048] = (bf16_t)(pk_bf16(tile[(NT + t) * WBR + ch] * s0, 0.f) & 0xffffu);
        }
        __syncthreads();
    }
}

DI float ldh(const bf16_t* t, int idx) { return __uint_as_float((unsigned)t[idx] << 16); }
template <int W> DI void pool_compute_h(const bf16_t* tile, int ch, int tt0, float (&o)[16]) {
    float e[31];
#pragma unroll
    for (int k = 0; k < 31; ++k) e[k] = ldh(tile, k * WBR + ch);
#pragma unroll
    for (int j = 0; j < 16; ++j) {
        float s = 0.f;
#pragma unroll
        for (int i = 0; i < W; ++i) s += e[j + 15 - i];
        const int pos = tt0 + j; const float inv = (pos + 1 >= W) ? 1.f / (float)W : 1.f / (float)(pos + 1);
        o[j] = s * inv - e[j + 15];
    }
}
DI void conv_item_p(const Params& p, int l, int b, int tt0, const ConvConst& cc, unsigned char* lds, float* red, int tid, int lane, int wave) {
    constexpr int NT = 16, RA = 0, RB = 31, RBB = 49, RD = 65, NR = 111;
    const bf16_t* Z = (const bf16_t*)(ws_of(p) + WS_Z); const int ch = tid;
    const int rowbase = b * SEQ, row0 = rowbase + tt0; const bool lastp = (tt0 + NT == SEQ);
    bf16_t* tile = (bf16_t*)lds;
    {
        constexpr int ITER = (NR * 64 + 511) / 512, HB = ITER / 2;
#pragma unroll 1
        for (int h = 0; h < 2; ++h) {
            u32x4 vb[HB];
#pragma unroll
            for (int i = 0; i < HB; ++i) {
                const int c = tid + 512 * (h * HB + i), r = c >> 6, cc8 = (c & 63) * 8; vb[i] = (u32x4){0u, 0u, 0u, 0u};
                if (c < NR * 64) {
                    int hist, col, kk;
                    if (r < RB) { hist = 15; col = 0; kk = r; } else if (r < RBB) { hist = 2; col = 512; kk = r - RB; } else if (r < RD) { hist = 0; col = 1024; kk = r - RBB; } else { hist = 30; col = 2560; kk = r - RD; }
                    const int t = tt0 - hist + kk;
                    if (t >= 0) vb[i] = *(const u32x4*)(Z + (size_t)(rowbase + t) * ZP + col + cc8);
                }
            }
#pragma unroll
            for (int i = 0; i < HB; ++i) {
                const int c = tid + 512 * (h * HB + i), r = c >> 6, cc8 = (c & 63) * 8;
                if (c < NR * 64) *(u32x4*)(tile + r * WBR + cc8) = vb[i];
            }
        }
    }
    __syncthreads();
    if (lastp) {
#pragma unroll 1
        for (int c = tid; c < NR * 64; c += 512) {
            const int r = c >> 6, cc8 = (c & 63) * 8;
            if (r < RBB || r >= RD) {
                int hist, kk, nc; size_t ob;
                if (r < RB) { hist = 15; kk = r; nc = 15; ob = O_POOLP + ((size_t)l * NB + b) * 15 * WBR; }
                else if (r < RBB) { hist = 2; kk = r - RB; nc = 2; ob = O_SCP + ((size_t)l * NB + b) * 2 * WBR; }
                else { hist = 30; kk = r - RD; nc = 30; ob = O_CCP + ((size_t)l * NB + b) * 30 * WBR; }
                const int ci = (tt0 - hist + kk) - (SEQ - nc);
                if (ci >= 0) { const u32x4 v = *(const u32x4*)(tile + r * WBR + cc8); float* o = out_of(p) + ob + (size_t)ci * WBR + cc8;
                    *(f32x4*)o = (f32x4){bf_lo(v.x), bf_hi(v.x), bf_lo(v.y), bf_hi(v.y)}; *(f32x4*)(o + 4) = (f32x4){bf_lo(v.z), bf_hi(v.z), bf_lo(v.w), bf_hi(v.w)}; }
            }
        }
    }
    float oA[NT], oB[NT];
    switch (wave >> 1) {
        case 0: pool_compute_h<2>(tile + RA * WBR, ch, tt0, oA); break;
        case 1: pool_compute_h<4>(tile + RA * WBR, ch, tt0, oA); break;
        case 2: pool_compute_h<8>(tile + RA * WBR, ch, tt0, oA); break;
        default: pool_compute_h<16>(tile + RA * WBR, ch, tt0, oA); break;
    }
    {
        const bf16_t* tb = tile + RB * WBR; const bf16_t* tbb = tile + RBB * WBR;
#pragma unroll
        for (int j = 0; j < NT; ++j) {
            const float c = cc.sw0 * ldh(tb, j * WBR + ch) + cc.sw1 * ldh(tb, (j + 1) * WBR + ch) + cc.sw2 * ldh(tb, (j + 2) * WBR + ch);
            oB[j] = ldh(tbb, j * WBR + ch) * c;
        }
    }
    float a[NT];
#pragma unroll
    for (int j = 0; j < NT; ++j) a[j] = cc.cb;
    {
        const bf16_t* td = tile + RD * WBR;
#pragma unroll
        for (int k = 0; k < NT + 30; ++k) {
            const float v = ldh(td, k * WBR + ch);
#pragma unroll
            for (int j = 0; j < NT; ++j) { const int tap = k - j; if (tap >= 0 && tap <= 30) a[j] += cc.cw[tap] * v; }
        }
    }
    {
        float v[2 * NT];
#pragma unroll
        for (int j = 0; j < NT; ++j) { v[2 * j] = a[j]; v[2 * j + 1] = a[j] * a[j]; }
        XReduce<2 * NT, 32>::run(v, lane);
        const int idx = lane >> 1;
        if ((lane & 1) == 0) red[((idx >> 1) * 8 + wave) * 2 + (idx & 1)] = v[0];
    }
    __syncthreads();
#pragma unroll
    for (int j = 0; j < NT; ++j) {
        const f32x4* rp = (const f32x4*)(red + j * 16); const f32x4 r0 = rp[0], r1 = rp[1], r2 = rp[2], r3 = rp[3];
        const float s1 = (r0[0] + r0[2]) + (r1[0] + r1[2]) + (r2[0] + r2[2]) + (r3[0] + r3[2]), s2 = (r0[1] + r0[3]) + (r1[1] + r1[3]) + (r2[1] + r2[3]) + (r3[1] + r3[3]);
        const float mean = s1 * (1.f / 512.f), var = fmaxf(s2 * (1.f / 512.f) - mean * mean, 0.f), rstd = __builtin_amdgcn_rsqf(var + EPS);
        const float y = (a[j] - mean) * rstd * cc.lng + cc.lnb;
        tile[(0 * NT + j) * WBR + ch] = (bf16_t)(pk_bf16(oA[j], 0.f) & 0xffffu);
        tile[(1 * NT + j) * WBR + ch] = (bf16_t)(pk_bf16(oB[j], 0.f) & 0xffffu);
        tile[(2 * NT + j) * WBR + ch] = (bf16_t)(pk_bf16(y * sigmoidf_(y), 0.f) & 0xffffu);
    }
    __syncthreads();
    {
        bf16_t* BRb = (bf16_t*)(ws_of(p) + WS_BR) + (size_t)row0 * 2048;
#pragma unroll
        for (int q = 0; q < 6; ++q) {
            const int idx = tid + 512 * q, br = idx >> 10, j = (idx >> 6) & 15, c8 = (idx & 63) * 8;
            const u32x4 v = *(const u32x4*)(tile + (br * NT + j) * WBR + c8);
            *(u32x4*)(BRb + (size_t)j * 2048 + (br == 2 ? 1536 : br * 512) + c8) = v;
        }
    }
    __syncthreads();
}

DI void sgu_item(const Params& p, int l, int it, unsigned char* lds) {
    const int tid = opaque_tid(), lane = tid & 63, wave = __builtin_amdgcn_readfirstlane(tid >> 6);
    const int g = it & 3, chunk = (it >> 2) & 15, b = it >> 6;
    const int rowbase = b * SEQ + chunk * 128;
    const bf16_t* Z = (const bf16_t*)(ws_of(p) + WS_Z);
    bf16_t* vnT = (bf16_t*)lds;
    float* Sb = (float*)(lds + 36864);
    {
        u32x4 v[16];
#pragma unroll
        for (int r = 0; r < 16; ++r) v[r] = *(const u32x4*)(Z + (size_t)(rowbase + wave * 16 + r) * ZP + 2048 + lane * 8);
        float s1[16], s2[16];
#pragma unroll
        for (int r = 0; r < 16; ++r) {
            const float x[8] = {bf_lo(v[r].x), bf_hi(v[r].x), bf_lo(v[r].y), bf_hi(v[r].y), bf_lo(v[r].z), bf_hi(v[r].z), bf_lo(v[r].w), bf_hi(v[r].w)};
            float a = 0.f, q = 0.f;
#pragma unroll
            for (int i = 0; i < 8; ++i) { a += x[i]; q += x[i] * x[i]; }
            s1[r] = a; s2[r] = q;
        }
        {
            float vv[32];
#pragma unroll
            for (int r = 0; r < 16; ++r) { vv[2 * r] = s1[r]; vv[2 * r + 1] = s2[r]; }
            XReduce<32, 32>::run(vv, lane);
            float* sb = (float*)(lds + LDS_MISC + 1024) + wave * 32;
            if ((lane & 1) == 0) sb[lane >> 1] = vv[0];
            asm volatile("s_waitcnt lgkmcnt(0)" ::: "memory");
#pragma unroll
            for (int r = 0; r < 16; ++r) { s1[r] = sb[2 * r]; s2[r] = sb[2 * r + 1]; }
            asm volatile("" ::: "memory");
        }
        if ((lane >> 4) == g) {
            const int c0 = (lane & 15) * 8;
            const f32x4 gA = *(const f32x4*)(p.in[13] + l * WBR + lane * 8), gB = *(const f32x4*)(p.in[13] + l * WBR + lane * 8 + 4);
            const f32x4 bA = *(const f32x4*)(p.in[14] + l * WBR + lane * 8), bB = *(const f32x4*)(p.in[14] + l * WBR + lane * 8 + 4);
            const float gg[8] = {gA.x, gA.y, gA.z, gA.w, gB.x, gB.y, gB.z, gB.w}, bb[8] = {bA.x, bA.y, bA.z, bA.w, bB.x, bB.y, bB.z, bB.w};
#pragma unroll
            for (int r = 0; r < 16; ++r) {
                const int s = wave * 16 + r;
                const float mean = s1[r] * (1.f / 512.f), var = fmaxf(s2[r] * (1.f / 512.f) - mean * mean, 0.f), rstd = __builtin_amdgcn_rsqf(var + EPS);
                const float x[8] = {bf_lo(v[r].x), bf_hi(v[r].x), bf_lo(v[r].y), bf_hi(v[r].y), bf_lo(v[r].z), bf_hi(v[r].z), bf_lo(v[r].w), bf_hi(v[r].w)};
#pragma unroll
                for (int i = 0; i < 8; ++i) { const float y = (x[i] - mean) * rstd * gg[i] + bb[i]; vnT[(c0 + i) * 136 + s] = (bf16_t)(pk_bf16(y, 0.f) & 0xffffu); }
            }
        }
    }
    __syncthreads();
    {
        const int fr = lane & 15, kq = lane >> 4;
        f32x4 acc[8];
#pragma unroll
        for (int cb = 0; cb < 8; ++cb) acc[cb] = (f32x4){0.f, 0.f, 0.f, 0.f};
        const bf16_t* Wt = (const bf16_t*)(ws_of(p) + WS_SGUW) + ((size_t)l * 4 + g) * 16384 + (size_t)(wave * 16 + fr) * 128 + kq * 8;
        const int nks = (wave >> 1) + 1;
        for (int ks = 0; ks < nks; ++ks) {
            const bf16x8 a = *(const bf16x8*)(Wt + ks * 32);
#pragma unroll
            for (int cb = 0; cb < 8; ++cb) {
                const bf16x8 bfr = *(const bf16x8*)(vnT + (cb * 16 + fr) * 136 + ks * 32 + kq * 8);
                acc[cb] = __builtin_amdgcn_mfma_f32_16x16x32_bf16(a, bfr, acc[cb], 0, 0, 0);
            }
        }
        const float* bs = p.in[16] + ((size_t)l * 4 + g) * 128;
#pragma unroll
        for (int j = 0; j < 4; ++j) {
            const int t = wave * 16 + kq * 4 + j; const float bt = bs[t];
#pragma unroll
            for (int cb = 0; cb < 8; ++cb) Sb[t * 132 + cb * 16 + fr] = acc[cb][j] + bt;
        }
    }
    __syncthreads();
    {
        bf16_t* BR2 = (bf16_t*)(ws_of(p) + WS_BR) + 1024 + g * 128;
        u32x4 cu[4];
#pragma unroll
        for (int q = 0; q < 4; ++q) { const int idx = tid + 512 * q, t = idx >> 4, c8 = (idx & 15) * 8; cu[q] = *(const u32x4*)(Z + (size_t)(rowbase + t) * ZP + 1536 + g * 128 + c8); }
#pragma unroll
        for (int q = 0; q < 4; ++q) {
            const int idx = tid + 512 * q, t = idx >> 4, c8 = (idx & 15) * 8;
            const f32x4 sa = *(const f32x4*)(Sb + t * 132 + c8), sb = *(const f32x4*)(Sb + t * 132 + c8 + 4); const u32x4 u = cu[q]; u32x4 w;
            w.x = pk_bf16(bf_lo(u.x) * sa[0], bf_hi(u.x) * sa[1]); w.y = pk_bf16(bf_lo(u.y) * sa[2], bf_hi(u.y) * sa[3]);
            w.z = pk_bf16(bf_lo(u.z) * sb[0], bf_hi(u.z) * sb[1]); w.w = pk_bf16(bf_lo(u.w) * sb[2], bf_hi(u.w) * sb[3]);
            *(u32x4*)(BR2 + (size_t)(rowbase + t) * 2048 + c8) = w;
        }
    }
    __syncthreads();
}

DI void branch_phase(const Params& p, int l, unsigned char* lds, int G, int mask) {
    const int tid = opaque_tid(), lane = tid & 63, wave = __builtin_amdgcn_readfirstlane(tid >> 6);
    float* red = (float*)(lds + LDS_MISC); float* tile = (float*)lds;
    if (mask & 1) {
        const int bid = opaque_bid();
        if (G == 256) {
            if (bid < 128) { if (EN_SGU) sgu_item(p, l, bid * 4, lds); }
            else for (int k = 0; k < 3; ++k) { if (EN_SGU) sgu_item(p, l, (bid - 128) * 4 + 1 + k, lds); }
        } else for (int it = bid; it < 512; it += G) { if (EN_SGU) sgu_item(p, l, it, lds); }
    }
    if (!(mask & 2)) return;
    ConvConst cc;
#pragma unroll
    for (int t = 0; t < 31; ++t) cc.cw[t] = p.in[17][((size_t)l * 31 + t) * WBR + tid];
    cc.cb = p.in[18][l * WBR + tid]; cc.lng = p.in[19][l * WBR + tid]; cc.lnb = p.in[20][l * WBR + tid];
    cc.sw0 = p.in[12][(size_t)l * 3 * WBR + tid]; cc.sw1 = p.in[12][(size_t)l * 3 * WBR + WBR + tid]; cc.sw2 = p.in[12][(size_t)l * 3 * WBR + 2 * WBR + tid];
    cc.sg = p.in[13][l * WBR + tid]; cc.sb = p.in[14][l * WBR + tid];
    if (G == 256) {
        const int bid = opaque_bid();
        for (int k = 0; k < 4; ++k) { const int it = bid * 4 + k; if (EN_CP) conv_item_p(p, l, it >> 7, (it & 127) * 16, cc, lds, red, tid, lane, wave); }
        if (bid < 128) { if (EN_CS) conv_item<8, true>(p, l, bid, 0, cc, tile, red, tid, lane, wave); }
    } else
    for (int it = opaque_bid(); it < 1152; it += G) {
        if (it < 1024) { if (EN_CP) conv_item_p(p, l, it >> 7, (it & 127) * 16, cc, lds, red, tid, lane, wave); }
        else { if (EN_CS) conv_item<8, true>(p, l, it - 1024, 0, cc, tile, red, tid, lane, wave); }
    }
}

constexpr int KPITCH = 264;
DI void attn_prompt_unit(const Params& p, int l, int u, unsigned char* lds) {
    const int tid = opaque_tid(), lane = tid & 63, wave = tid >> 6, fr = lane & 15, kq = lane >> 4;
    const int b = u >> 6, h = (u >> 4) & 3, qb = u & 15;
    const size_t hb = ((size_t)(l * 8 + b) * 4 + h) * 65536;
    const bf16_t* Kg = (const bf16_t*)(ws_of(p) + WS_KP) + hb; const bf16_t* Vg = (const bf16_t*)(ws_of(p) + WS_VTP) + hb;
    bf16_t* img = (bf16_t*)lds;
    const int qrow = b * SEQ + qb * 128 + wave * 16 + fr;
    const bf16_t* Qg = (const bf16_t*)(ws_of(p) + WS_Q) + (size_t)qrow * DM + h * 256 + kq * 8;
    bf16x8 qf[8];
#pragma unroll
    for (int ks = 0; ks < 8; ++ks) qf[ks] = *(const bf16x8*)(Qg + ks * 32);
    {
        u32x4 st[16];
#pragma unroll
        for (int i = 0; i < 16; ++i) { const int c = tid + 512 * i, r = c >> 5, c16 = c & 31; st[i] = *(const u32x4*)(Kg + r * 256 + c16 * 8); }
#pragma unroll
        for (int i = 0; i < 16; ++i) { const int c = tid + 512 * i, r = c >> 5, c16 = c & 31; *(u32x4*)(img + r * KPITCH + c16 * 8) = st[i]; }
    }
    __syncthreads();
    f32x4 s[16];
#pragma unroll
    for (int kb = 0; kb < 16; kb += 2) {
        bf16x8 kf0[8], kf1[8];
#pragma unroll
        for (int ks = 0; ks < 8; ++ks) { kf0[ks] = *(const bf16x8*)(img + (kb * 16 + fr) * KPITCH + ks * 32 + kq * 8); kf1[ks] = *(const bf16x8*)(img + ((kb + 1) * 16 + fr) * KPITCH + ks * 32 + kq * 8); }
        s[kb] = (f32x4){0.f, 0.f, 0.f, 0.f}; s[kb + 1] = (f32x4){0.f, 0.f, 0.f, 0.f};
#pragma unroll
        for (int ks = 0; ks < 8; ++ks) {
            s[kb] = __builtin_amdgcn_mfma_f32_16x16x32_bf16(kf0[ks], qf[ks], s[kb], 0, 0, 0);
            s[kb + 1] = __builtin_amdgcn_mfma_f32_16x16x32_bf16(kf1[ks], qf[ks], s[kb + 1], 0, 0, 0);
        }
    }
    u32x4 vst[16];
#pragma unroll
    for (int i = 0; i < 16; ++i) { const int c = tid + 512 * i, r = c >> 5, c16 = c & 31; vst[i] = *(const u32x4*)(Vg + r * 256 + c16 * 8); }
    float mx = -INFINITY;
#pragma unroll
    for (int kb = 0; kb < 16; ++kb) mx = fmaxf(fmaxf(fmaxf(mx, s[kb][0]), fmaxf(s[kb][1], s[kb][2])), s[kb][3]);
    mx = fmaxf(mx, __shfl_xor(mx, 16)); mx = fmaxf(mx, __shfl_xor(mx, 32));
    float sum = 0.f;
#pragma unroll
    for (int kb = 0; kb < 16; ++kb)
#pragma unroll
        for (int j = 0; j < 4; ++j) { const float e = __builtin_amdgcn_exp2f(s[kb][j] - mx); s[kb][j] = e; sum += e; }
    sum += __shfl_xor(sum, 16); sum += __shfl_xor(sum, 32);
    const float inv = __builtin_amdgcn_rcpf(sum);
    bf16x8 pb[8];
#pragma unroll
    for (int k2 = 0; k2 < 8; ++k2) {
        u32x4 w; w.x = pk_bf16(s[2 * k2][0], s[2 * k2][1]); w.y = pk_bf16(s[2 * k2][2], s[2 * k2][3]); w.z = pk_bf16(s[2 * k2 + 1][0], s[2 * k2 + 1][1]); w.w = pk_bf16(s[2 * k2 + 1][2], s[2 * k2 + 1][3]);
        pb[k2] = __builtin_bit_cast(bf16x8, w);
    }
    __syncthreads();
#pragma unroll
    for (int i = 0; i < 16; ++i) { const int c = tid + 512 * i, r = c >> 5, c16 = c & 31; *(u32x4*)(img + r * KPITCH + c16 * 8) = vst[i]; }
    __syncthreads();
    bf16_t* Og = (bf16_t*)(ws_of(p) + WS_O) + (size_t)qrow * DM + h * 256 + kq * 4;
#pragma unroll 2
    for (int db = 0; db < 16; db += 2) {
        f32x4 o0 = (f32x4){0.f, 0.f, 0.f, 0.f}, o1 = (f32x4){0.f, 0.f, 0.f, 0.f};
        bf16x8 vf0[8], vf1[8];
#pragma unroll
        for (int k2 = 0; k2 < 8; ++k2) {
            const bf16_t* vp = img + (db * 16 + fr) * KPITCH + k2 * 32 + kq * 4;
            const s16x4 lo = *(const s16x4*)vp, hi = *(const s16x4*)(vp + 16), lo1 = *(const s16x4*)(vp + 16 * KPITCH), hi1 = *(const s16x4*)(vp + 16 * KPITCH + 16);
            vf0[k2] = (bf16x8){lo[0], lo[1], lo[2], lo[3], hi[0], hi[1], hi[2], hi[3]};
            vf1[k2] = (bf16x8){lo1[0], lo1[1], lo1[2], lo1[3], hi1[0], hi1[1], hi1[2], hi1[3]};
        }
#pragma unroll
        for (int k2 = 0; k2 < 8; ++k2) {
            o0 = __builtin_amdgcn_mfma_f32_16x16x32_bf16(vf0[k2], pb[k2], o0, 0, 0, 0);
            o1 = __builtin_amdgcn_mfma_f32_16x16x32_bf16(vf1[k2], pb[k2], o1, 0, 0, 0);
        }
        u32x2 w; w.x = pk_bf16(o0[0] * inv, o0[1] * inv); w.y = pk_bf16(o0[2] * inv, o0[3] * inv);
        *(u32x2*)(Og + db * 16) = w;
        w.x = pk_bf16(o1[0] * inv, o1[1] * inv); w.y = pk_bf16(o1[2] * inv, o1[3] * inv);
        *(u32x2*)(Og + db * 16 + 16) = w;
    }
    __syncthreads();
}

DI void attn_sample_item(const Params& p, int l, int it, unsigned char* lds) {
    const int tid = opaque_tid(), lane = tid & 63, wave = tid >> 6, fr = lane & 15, kq = lane >> 4;
    const int b = it >> 2, h = it & 3;
    const float* Kc = p.in[5] + (((size_t)l * NSB + b) * 256) * 1024 + h * 256;
    const float* Vc = p.in[6] + (((size_t)l * NSB + b) * 256) * 1024 + h * 256;
    float* sS = (float*)lds;
    float* red = (float*)(lds + 8192);
    const int qrow = MP + b * NSQ + (fr & 7);
    const bf16_t* Qg = (const bf16_t*)(ws_of(p) + WS_Q) + (size_t)qrow * DM + h * 256 + kq * 8;
    bf16x8 qf[8];
#pragma unroll
    for (int ks = 0; ks < 8; ++ks) { qf[ks] = *(const bf16x8*)(Qg + ks * 32); if (fr >= 8) qf[ks] = (bf16x8){0, 0, 0, 0, 0, 0, 0, 0}; }
    {
        f32x4 ka[2][8], kbv[2][8];
#pragma unroll
        for (int kb = 0; kb < 2; ++kb) {
            const float* kp = Kc + (size_t)(wave * 32 + kb * 16 + fr) * 1024 + kq * 8;
#pragma unroll
            for (int ks = 0; ks < 8; ++ks) { ka[kb][ks] = *(const f32x4*)(kp + ks * 32); kbv[kb][ks] = *(const f32x4*)(kp + ks * 32 + 4); }
        }
#pragma unroll
        for (int kb = 0; kb < 2; ++kb) {
            f32x4 s = (f32x4){0.f, 0.f, 0.f, 0.f};
#pragma unroll
            for (int ks = 0; ks < 8; ++ks) {
                u32x4 w; w.x = pk_bf16(ka[kb][ks][0], ka[kb][ks][1]); w.y = pk_bf16(ka[kb][ks][2], ka[kb][ks][3]); w.z = pk_bf16(kbv[kb][ks][0], kbv[kb][ks][1]); w.w = pk_bf16(kbv[kb][ks][2], kbv[kb][ks][3]);
                s = __builtin_amdgcn_mfma_f32_16x16x32_bf16(__builtin_bit_cast(bf16x8, w), qf[ks], s, 0, 0, 0);
            }
            if (fr < 8) {
#pragma unroll
                for (int j = 0; j < 4; ++j) sS[(wave * 32 + kb * 16 + kq * 4 + j) * 8 + fr] = s[j];
            }
        }
    }
    f32x4 vr[32];
    {
        const float* vp = Vc + (size_t)(wave * 32) * 1024 + lane * 4;
#pragma unroll
        for (int k = 0; k < 32; ++k) vr[k] = *(const f32x4*)(vp + (size_t)k * 1024);
    }
    __syncthreads();
    {
        float v[4]; float mx = -INFINITY;
#pragma unroll
        for (int i = 0; i < 4; ++i) { v[i] = sS[(lane + 64 * i) * 8 + wave]; mx = fmaxf(mx, v[i]); }
        mx = wave_max(mx); float sum = 0.f;
#pragma unroll
        for (int i = 0; i < 4; ++i) { v[i] = __builtin_amdgcn_exp2f(v[i] - mx); sum += v[i]; }
        sum = wave_sum(sum); const float inv = 1.f / sum;
#pragma unroll
        for (int i = 0; i < 4; ++i) sS[(lane + 64 * i) * 8 + wave] = v[i] * inv;
    }
    __syncthreads();
    {
        f32x4 o[8];
#pragma unroll
        for (int q = 0; q < 8; ++q) o[q] = (f32x4){0.f, 0.f, 0.f, 0.f};
#pragma unroll
        for (int k = 0; k < 32; ++k) {
            const f32x4 v = vr[k];
            const f32x4 p0 = *(const f32x4*)(sS + (wave * 32 + k) * 8), p1 = *(const f32x4*)(sS + (wave * 32 + k) * 8 + 4);
            o[0] += v * p0[0]; o[1] += v * p0[1]; o[2] += v * p0[2]; o[3] += v * p0[3];
            o[4] += v * p1[0]; o[5] += v * p1[1]; o[6] += v * p1[2]; o[7] += v * p1[3];
        }
#pragma unroll
        for (int q = 0; q < 8; ++q) *(f32x4*)(red + ((wave * 8 + q) * 256) + lane * 4) = o[q];
    }
    __syncthreads();
    {
        const int q = tid >> 6; f32x4 a = (f32x4){0.f, 0.f, 0.f, 0.f};
#pragma unroll
        for (int w = 0; w < 8; ++w) a += *(const f32x4*)(red + ((w * 8 + q) * 256) + lane * 4);
        bf16_t* Og = (bf16_t*)(ws_of(p) + WS_O) + (size_t)(MP + b * NSQ + q) * DM + h * 256 + lane * 4;
        u32x2 w; w.x = pk_bf16(a[0], a[1]); w.y = pk_bf16(a[2], a[3]); *(u32x2*)Og = w;
    }
    __syncthreads();
}

DI void attn_phase(const Params& p, int l, unsigned char* lds, int G, int mask) {
    const int bid = opaque_bid(); const bool sample_first = ((bid >> 3) & 1) != 0;
    for (int pass = 0; pass < 2; ++pass) {
        const bool do_sample = (pass == 0) == sample_first;
        if (do_sample) { if (mask & 2) for (int it = bid; it < 512; it += G) attn_sample_item(p, l, it, lds); }
        else if (mask & 1) for (int it = bid; it < 512; it += G) {
            int u = it;
            if (G == 256) { const int c = it & 255; u = (it & 256) + (c & 7) * 32 + (c >> 3); }
            attn_prompt_unit(p, l, u, lds);
        }
    }
}

DI void final_phase(const Params& p, int G) {
    const int tid = opaque_tid(), lane = tid & 63, wave = tid >> 6;
    const bf16_t* XBf = (const bf16_t*)(ws_of(p) + WS_XB); const float* SS = (const float*)(ws_of(p) + WS_SS); const float* g = p.in[33];
    f32x4 gv[4];
#pragma unroll
    for (int j = 0; j < 4; ++j) gv[j] = ((const f32x4*)g)[lane + 64 * j];
    const int NW = G * 8;
    for (int m0 = opaque_bid() * 8 + wave; m0 < MT; m0 += 4 * NW) {
        u32x2 xv[4][4]; float sv[4];
#pragma unroll
        for (int r = 0; r < 4; ++r) {
            const int m = m0 + r * NW; const bool ok = m < MT; const int mm = ok ? m : m0;
            sv[r] = (lane < 16) ? SS[(size_t)mm * 16 + lane] : 0.f;
            const u32x2* xr = (const u32x2*)(XBf + (size_t)mm * DM) + lane;
#pragma unroll
            for (int j = 0; j < 4; ++j) xv[r][j] = xr[64 * j];
        }
#pragma unroll
        for (int r = 0; r < 4; ++r) {
            const int m = m0 + r * NW; if (m >= MT) break;
            const float rs = __builtin_amdgcn_rsqf(wave_sum(sv[r]) * (1.f / 1024.f) + EPS);
            f32x4* o = (f32x4*)(out_of(p) + (size_t)m * DM) + lane;
#pragma unroll
            for (int j = 0; j < 4; ++j) { const u32x2 v = xv[r][j]; o[64 * j] = (f32x4){bf_lo(v.x), bf_hi(v.x), bf_lo(v.y), bf_hi(v.y)} * rs * gv[j]; }
        }
    }
}

constexpr int MPITCH = 264, MOPB = 64 * MPITCH * 2;
DI void mini_unit(const Params& p, unsigned char* lds, int kind, const bf16_t* A, const bf16_t* Bt, int Kfull, int mu, int nct, float scale, const float* xin_s) {
    const int tid = opaque_tid(), lane = tid & 63, wave = __builtin_amdgcn_readfirstlane(tid >> 6), fr = lane & 15, kq = lane >> 4, rb = wave & 3, kh = wave >> 2;
    const int rt = mu / nct, ct = mu % nct, r0 = rt * 64 + rb * 16;
    unsigned char* ws = ws_of(p);
    f32x4 tot[4], acc[4];
#pragma unroll
    for (int cb = 0; cb < 4; ++cb) { tot[cb] = (f32x4){0.f, 0.f, 0.f, 0.f}; acc[cb] = (f32x4){0.f, 0.f, 0.f, 0.f}; }
    const int pitch = Kfull, nch = Kfull >> 8;
    const bf16_t* Ag = A + (size_t)(rt * 64 + (tid >> 5)) * pitch + (tid & 31) * 8;
    const bf16_t* Bg = Bt + (size_t)(ct * 64 + (tid >> 5)) * pitch + (tid & 31) * 8;
    const int sto = (tid >> 5) * MPITCH + (tid & 31) * 8;
    u32x4 ra[4], rbv[4];
#pragma unroll
    for (int i = 0; i < 4; ++i) { ra[i] = *(const u32x4*)(Ag + (size_t)(16 * i) * pitch); rbv[i] = *(const u32x4*)(Bg + (size_t)(16 * i) * pitch); }
    __syncthreads();
    {
        bf16_t* sa = (bf16_t*)lds; bf16_t* sb = (bf16_t*)(lds + MOPB);
#pragma unroll
        for (int i = 0; i < 4; ++i) { *(u32x4*)(sa + sto + 16 * i * MPITCH) = ra[i]; *(u32x4*)(sb + sto + 16 * i * MPITCH) = rbv[i]; }
    }
    __syncthreads();
    for (int c = 0; c < nch; ++c) {
        const bool more = (c + 1 < nch);
        if (more) {
#pragma unroll
            for (int i = 0; i < 4; ++i) { ra[i] = *(const u32x4*)(Ag + (size_t)(16 * i) * pitch + (c + 1) * 256); rbv[i] = *(const u32x4*)(Bg + (size_t)(16 * i) * pitch + (c + 1) * 256); }
        }
        const bf16_t* sa = (const bf16_t*)(lds + (c & 1) * 2 * MOPB) + (rb * 16 + fr) * MPITCH + kh * 128 + kq * 8;
        const bf16_t* sb = (const bf16_t*)(lds + (c & 1) * 2 * MOPB + MOPB) + fr * MPITCH + kh * 128 + kq * 8;
#pragma unroll
        for (int ks = 0; ks < 4; ++ks) {
            const bf16x8 a = *(const bf16x8*)(sa + ks * 32);
#pragma unroll
            for (int cb = 0; cb < 4; ++cb) { const bf16x8 bfr = *(const bf16x8*)(sb + cb * 16 * MPITCH + ks * 32); acc[cb] = __builtin_amdgcn_mfma_f32_16x16x32_bf16(bfr, a, acc[cb], 0, 0, 0); }
        }
        if (kind == 9) {
            if (c & 1) {
                const int sg = c >> 1;
                const bf16_t* gp = (const bf16_t*)(ws + WS_Z) + (size_t)(MP + r0 + fr) * ZP + 3072 + 1024 * sg + ct * 64 + 4 * kq;
#pragma unroll
                for (int cb = 0; cb < 4; ++cb) { const u32x2 g = *(const u32x2*)(gp + cb * 16);
                    tot[cb][0] += bf_lo(g.x) * acc[cb][0]; tot[cb][1] += bf_hi(g.x) * acc[cb][1]; tot[cb][2] += bf_lo(g.y) * acc[cb][2]; tot[cb][3] += bf_hi(g.y) * acc[cb][3];
                    acc[cb] = (f32x4){0.f, 0.f, 0.f, 0.f}; }
            }
        }
        if (more) {
            bf16_t* sa2 = (bf16_t*)(lds + ((c + 1) & 1) * 2 * MOPB); bf16_t* sb2 = (bf16_t*)(lds + ((c + 1) & 1) * 2 * MOPB + MOPB);
#pragma unroll
            for (int i = 0; i < 4; ++i) { *(u32x4*)(sa2 + sto + 16 * i * MPITCH) = ra[i]; *(u32x4*)(sb2 + sto + 16 * i * MPITCH) = rbv[i]; }
        }
        __syncthreads();
    }
    if (kind != 9) {
#pragma unroll
        for (int cb = 0; cb < 4; ++cb) tot[cb] = acc[cb];
    }
    float* red = (float*)lds;
    if (kh == 1) {
#pragma unroll
        for (int cb = 0; cb < 4; ++cb) *(f32x4*)(red + ((rb * 64 + lane) * 4 + cb) * 4) = tot[cb];
    }
    __syncthreads();
    if (kh == 0) {
#pragma unroll
        for (int cb = 0; cb < 4; ++cb) tot[cb] += *(const f32x4*)(red + ((rb * 64 + lane) * 4 + cb) * 4);
        const int row = MP + r0 + fr, col0 = ct * 64 + 4 * kq;
        if (kind == 8) {
            bf16_t* XB = (bf16_t*)(ws + WS_XB) + (size_t)row * DM + col0; const float* xi = xin_s ? xin_s + (size_t)(r0 + fr) * DM + col0 : nullptr;
            float ss = 0.f;
#pragma unroll
            for (int cb = 0; cb < 4; ++cb) {
                f32x4 x;
                if (xin_s) x = *(const f32x4*)(xi + cb * 16); else { const u32x2 v = *(const u32x2*)(XB + cb * 16); x = (f32x4){bf_lo(v.x), bf_hi(v.x), bf_lo(v.y), bf_hi(v.y)}; }
                x += tot[cb];
                u32x2 w; w.x = pk_bf16(x[0], x[1]); w.y = pk_bf16(x[2], x[3]); *(u32x2*)(XB + cb * 16) = w;
                const f32x4 y = (f32x4){bf_lo(w.x), bf_hi(w.x), bf_lo(w.y), bf_hi(w.y)};
                ss += (y[0] * y[0] + y[1] * y[1]) + (y[2] * y[2] + y[3] * y[3]);
            }
            ss += __shfl_xor(ss, 16); ss += __shfl_xor(ss, 32);
            if (kq == 0) ((float*)(ws + WS_SS))[(size_t)row * 16 + ct] = ss;
        } else if (kind == 0 || kind == 7) {
            const f32x4 s4 = *(const f32x4*)((const float*)(ws + WS_SS) + (size_t)row * 16 + kq * 4);
            float t = (s4[0] + s4[1]) + (s4[2] + s4[3]); t += __shfl_xor(t, 16); t += __shfl_xor(t, 32);
            const float r = __builtin_amdgcn_rsqf(t * (1.f / 1024.f) + EPS) * scale;
            bf16_t* Q = (kind == 0) ? (bf16_t*)(ws + WS_Q) + (size_t)row * DM + col0 : (bf16_t*)(ws + WS_Z) + (size_t)row * DFF + col0;
#pragma unroll
            for (int cb = 0; cb < 4; ++cb) {
                f32x4 v = tot[cb] * r;
                if (kind == 7) { v[0] = fmaxf(v[0], 0.f); v[1] = fmaxf(v[1], 0.f); v[2] = fmaxf(v[2], 0.f); v[3] = fmaxf(v[3], 0.f); v = v * v; }
                u32x2 w; w.x = pk_bf16(v[0], v[1]); w.y = pk_bf16(v[2], v[3]); *(u32x2*)(Q + cb * 16) = w; }
        } else {
            bf16_t* MG = (bf16_t*)(ws + WS_MG) + (size_t)row * DM + col0;
#pragma unroll
            for (int cb = 0; cb < 4; ++cb) { u32x2 w; w.x = pk_bf16(tot[cb][0], tot[cb][1]); w.y = pk_bf16(tot[cb][2], tot[cb][3]); *(u32x2*)(MG + cb * 16) = w; }
        }
    }
    __syncthreads();
}

#define XB_TMO      128
#define XB_XCNT(j)  (256  + 64 * (j))
#define XB_XSUB(j)  (1280 + 64 * (j))
#define XB_XGEN(j)  (2304 + 64 * (j))
#define XB_TOP      3328
#define XB_TOPGEN   3392
#define XCD_BAR_WORDS 3456
#define XB_SPIN_CAP (1u << 22)
DI unsigned xb_ld(unsigned* p)              { return __hip_atomic_load(p, __ATOMIC_RELAXED, __HIP_MEMORY_SCOPE_AGENT); }
DI unsigned xb_add(unsigned* p, unsigned v) { return __hip_atomic_fetch_add(p, v, __ATOMIC_RELAXED, __HIP_MEMORY_SCOPE_AGENT); }
DI unsigned xb_xcc_id() { return (unsigned)__builtin_amdgcn_s_getreg((3 << 11) | 20) & 0xFu; }
#define XB_SPIN(cond, bar) do { unsigned _sp = 0; while (cond) { __builtin_amdgcn_s_sleep(1); \
    if ((++_sp & 255u) == 0u) { if (xb_ld(&(bar)[XB_TMO])) break; if (_sp > XB_SPIN_CAP) { atomicAdd(&(bar)[XB_TMO], 1u); break; } } } } while (0)
struct XcdBarrier { unsigned* bar; unsigned x; volatile LAS unsigned* st; };
DI XcdBarrier xcd_barrier_post(unsigned* bar, volatile LAS unsigned* st) {
    XcdBarrier b; b.bar = bar; b.x = xb_xcc_id(); b.st = st;
    if (threadIdx.x == 0) (void)xb_add(&bar[XB_XCNT(b.x)], 1u);
    return b;
}
DI void xcd_barrier_complete(unsigned* bar, unsigned x, unsigned& nloc, unsigned& nx) {
    const unsigned G = gridDim.x * gridDim.y * gridDim.z;
    unsigned sum, cnt, mine, sp = 0u;
    for (;;) {
        sum = 0u; cnt = 0u; mine = 0u;
#pragma unroll
        for (unsigned j = 0; j < 16; ++j) { const unsigned c = xb_ld(&bar[XB_XCNT(j)]); sum += c; cnt += (c > 0u) ? 1u : 0u; mine = (j == x) ? c : mine; }
        if (sum == G) break;
        __builtin_amdgcn_s_sleep(1);
        if ((++sp & 255u) == 0u) { if (xb_ld(&bar[XB_TMO])) break; if (sp > XB_SPIN_CAP) { atomicAdd(&bar[XB_TMO], 1u); break; } }
    }
    nloc = mine > 0u ? mine : 1u; nx = cnt > 0u ? cnt : 1u;
}
DI void xcd_barrier(const XcdBarrier& b) {
    asm volatile("s_waitcnt vmcnt(0)" ::: "memory");
    __syncthreads();
    if (threadIdx.x == 0) {
        unsigned* bar = b.bar;
        __builtin_amdgcn_s_waitcnt(0);
        unsigned nloc = b.st[0], nx = b.st[1];
        if (nloc == 0u) { xcd_barrier_complete(bar, b.x, nloc, nx); b.st[0] = nloc; b.st[1] = nx; }
        const unsigned old = xb_add(&bar[XB_XSUB(b.x)], 1u);
        const unsigned gen = old / nloc;
        if (old + 1u == (gen + 1u) * nloc) {
            __builtin_amdgcn_fence(__ATOMIC_RELEASE, "agent");
            asm volatile("s_waitcnt vmcnt(0)" ::: "memory");
            const unsigned og = xb_add(&bar[XB_TOP], 1u);
            const unsigned tg = og / nx;
            if (og + 1u == (tg + 1u) * nx) xb_add(&bar[XB_TOPGEN], 1u);
            else XB_SPIN(xb_ld(&bar[XB_TOPGEN]) == tg, bar);
            __builtin_amdgcn_fence(__ATOMIC_ACQUIRE, "agent");
            xb_add(&bar[XB_XGEN(b.x)], 1u);
            asm volatile("s_waitcnt vmcnt(0)" ::: "memory");
        } else {
            XB_SPIN(xb_ld(&bar[XB_XGEN(b.x)]) == gen, bar);
            __builtin_amdgcn_fence(__ATOMIC_ACQUIRE, "agent");
            asm volatile("s_waitcnt vmcnt(0)" ::: "memory");
        }
    }
    __syncthreads();
}

__global__ void __launch_bounds__(512, 2) fwd_megakernel(Params p) {
    extern __shared__ __attribute__((aligned(16))) unsigned char lds[];
    cg::grid_group grid = cg::this_grid();
    const int G = gridDim.x;
    volatile LAS int* dsc = (volatile LAS int*)((LAS unsigned char*)lds + LDS_MISC + 2048);
    volatile LAS unsigned* bst = (volatile LAS unsigned*)((LAS unsigned char*)lds + LDS_MISC + 4096);
    if (threadIdx.x < 2) bst[threadIdx.x] = 0u;
    __syncthreads();
    const bool multi = (p.ph_hi - p.ph_lo) > 1;
    XcdBarrier xbar; xbar.bar = (unsigned*)(p.ws + WS_CTL); xbar.x = 0; xbar.st = bst;
    if (multi) xbar = xcd_barrier_post((unsigned*)(p.ws + WS_CTL), bst);
    for (int ph = p.ph_lo; ph < p.ph_hi; ++ph) {
        int is_gemm = 0, K = 1024;
        if (ph == 0) { int reps = PROBE_A ? 2 : 1; asm volatile("" : "+s"(reps)); for (int r = 0; r < reps; ++r) { if (EN_PRO) prologue(p, lds, G, r == 0 ? 7 : PROBE_A); __syncthreads(); } }
        else if (ph == NPH - 1) final_phase(p, G);
        else {
            const int l = (ph - 1) / 9, s = (ph - 1) % 9;
            if (s == 1) { int reps = PROBE_B ? 2 : 1; asm volatile("" : "+s"(reps)); for (int r = 0; r < reps; ++r) { if (EN_BR) branch_phase(p, l, lds, G, r == 0 ? 3 : PROBE_B); __syncthreads(); } }
            else if (s == 5) { int reps = PROBE_C ? 2 : 1; asm volatile("" : "+s"(reps)); for (int r = 0; r < reps; ++r) { if (EN_AT) attn_phase(p, l, lds, G, r == 0 ? 3 : PROBE_C); __syncthreads(); } }
            else {
                is_gemm = 1; K = (s == 2) ? 2048 : (s == 8) ? 4096 : 1024;
                if (threadIdx.x == 0) {
                    const float* X = (const float*)(ws_of(p) + WS_X);
                    int mode = 1, nN = 4, kind = 0, nkv = 0, ldz = 0; float scale = 1.f;
                    const void *A = nullptr, *B = nullptr, *xin_p = X, *xin_s = X + (size_t)MP * DM, *bias = nullptr, *Zout = nullptr;
                    switch (s) {
                        case 0: mode = 0; A = ws_of(p) + WS_XB; B = ws_of(p) + WS_WIN + (size_t)l * 16 * MiB; nkv = (l == 0) ? 128 : 0; Zout = ws_of(p) + WS_Z; ldz = ZP; bias = p.in[22] + (size_t)l * 4096; break;
                        case 2: mode = 2; A = ws_of(p) + WS_BR; B = ws_of(p) + WS_WB + (size_t)l * 4 * MiB; break;
                        case 3: kind = 8; A = ws_of(p) + WS_MG; B = ws_of(p) + WS_WMIX + (size_t)l * 2 * MiB; if (l == 0) { xin_p = p.in[0]; xin_s = p.in[1]; } break;
                        case 4: kind = 0; A = ws_of(p) + WS_XB; B = ws_of(p) + WS_WQ + (size_t)l * 2 * MiB; Zout = ws_of(p) + WS_Q; ldz = DM; scale = 0.0625f * LOG2E; break;
                        case 6: kind = 8; A = ws_of(p) + WS_O; B = ws_of(p) + WS_WO + (size_t)l * 2 * MiB; break;
                        case 7: kind = 7; nN = 16; A = ws_of(p) + WS_XB; B = ws_of(p) + WS_W1 + (size_t)l * 8 * MiB; Zout = ws_of(p) + WS_Z; ldz = DFF; break;
                        default: kind = 8; A = ws_of(p) + WS_Z; B = ws_of(p) + WS_W2 + (size_t)l * 8 * MiB; break;
                    }
                    dsc[0] = mode; dsc[1] = nN; dsc[2] = K; dsc[3] = kind; dsc[4] = nkv; dsc[5] = ldz; dsc[6] = __float_as_int(scale); dsc[7] = (s == 3 && l == 0) ? 1 : 0;
                    const unsigned long long pa[8] = {(unsigned long long)A, (unsigned long long)B, (unsigned long long)(ws_of(p) + WS_MB), (unsigned long long)(ws_of(p) + WS_WKV), (unsigned long long)xin_p, (unsigned long long)xin_s, (unsigned long long)bias, (unsigned long long)Zout};
#pragma unroll
                    for (int i = 0; i < 8; ++i) { dsc[8 + 2 * i] = (int)(unsigned)pa[i]; dsc[9 + 2 * i] = (int)(unsigned)(pa[i] >> 32); }
                }
                __syncthreads();
            }
        }
        int greps = 1; if (PROBE_G >= 0 && is_gemm && ((ph - 1) % 9) == PROBE_G) greps = 2; asm volatile("" : "+s"(greps));
        for (int gr = 0; gr < greps; ++gr)
        if (EN_GEMM && is_gemm) {
            pg8::SchedU S; S.d = (pg8::DescP)dsc; S.G = G; S.c = opaque_bid();
            pg8::EpiU E; E.d = (pg8::DescP)dsc; E.ws = ws_of(p); E.out = out_of(p);
            pg8::gemm_phase((LAS unsigned char*)lds, K, (ph - 1) % 9 == 2, S, E);
            const int l = (ph - 1) / 9, s = (ph - 1) % 9;
            if (s == 2 || s == 3 || s == 4 || s == 6 || s == 7 || s == 8) {
                unsigned char* ws = ws_of(p);
                int kind = 8; const bf16_t* A; const bf16_t* B; float scale = 1.f;
                const float* xin_s = (l == 0 && s == 3) ? p.in[1] : nullptr;
                if (s == 2) { kind = 9; A = (const bf16_t*)(ws + WS_BR) + (size_t)MP * 2048; B = (const bf16_t*)(ws + WS_WB + (size_t)l * 4 * MiB); }
                else if (s == 3) { A = (const bf16_t*)(ws + WS_MG) + (size_t)MP * DM; B = (const bf16_t*)(ws + WS_WMIX + (size_t)l * 2 * MiB); }
                else if (s == 4) { kind = 0; A = (const bf16_t*)(ws + WS_XB) + (size_t)MP * DM; B = (const bf16_t*)(ws + WS_WQ + (size_t)l * 2 * MiB); scale = 0.0625f * LOG2E; }
                else if (s == 6) { A = (const bf16_t*)(ws + WS_O) + (size_t)MP * DM; B = (const bf16_t*)(ws + WS_WO + (size_t)l * 2 * MiB); }
                else if (s == 7) { kind = 7; A = (const bf16_t*)(ws + WS_XB) + (size_t)MP * DM; B = (const bf16_t*)(ws + WS_W1 + (size_t)l * 8 * MiB); }
                else { A = (const bf16_t*)(ws + WS_Z) + (size_t)MP * DFF; B = (const bf16_t*)(ws + WS_W2 + (size_t)l * 8 * MiB); }
                const int nct = (s == 7) ? 64 : 16;
                for (int mu = opaque_bid(); mu < 16 * nct; mu += G) mini_unit(p, lds, kind, A, B, K, mu, nct, scale, xin_s);
            }
        }
        if (ph + 1 < p.ph_hi) {
            if (p.ph_lo < 0) grid.sync();
            else { int reps = 1 + PROBE_S; asm volatile("" : "+s"(reps)); for (int r = 0; r < reps; ++r) xcd_barrier(xbar); }
        }
    }
}

#ifndef MK_PER_PHASE
#define MK_PER_PHASE 0
#endif
extern "C" void kernel_launch(void* const* d_in, const int* in_sizes, int n_in, void* d_out, int out_size, void* d_ws, size_t ws_size, hipStream_t stream) {
    static int grid = 0;
    if (grid == 0) {
        if (n_in != 34 || out_size != (int)O_END || ws_size < WS_END) { fprintf(stderr, "kernel_launch: unexpected shapes: n_in %d out %d ws %zu\n", n_in, out_size, ws_size); grid = -1; return; }
        int dev = 0, cus = 0, per_cu = 0;
        (void)hipGetDevice(&dev); (void)hipDeviceGetAttribute(&cus, hipDeviceAttributeMultiprocessorCount, dev);
        if (hipFuncSetAttribute((const void*)fwd_megakernel, hipFuncAttributeMaxDynamicSharedMemorySize, LDS_BYTES) != hipSuccess) { fprintf(stderr, "kernel_launch: hipFuncSetAttribute failed\n"); grid = -1; return; }
        if (hipOccupancyMaxActiveBlocksPerMultiprocessor(&per_cu, (const void*)fwd_megakernel, 512, LDS_BYTES) != hipSuccess || per_cu < 1) { fprintf(stderr, "kernel_launch: occupancy query gave %d\n", per_cu); per_cu = 1; }
        (void)hipGetLastError();
        grid = cus * per_cu; if (grid > 256) grid = 256;
        if (grid <= 0) grid = 256;
    }
    if (grid < 0) return;
    Params p{};
    for (int i = 0; i < 34; ++i) p.in[i] = (const float*)d_in[i];
    p.out = (float*)d_out; p.ws = (unsigned char*)d_ws;
#if MK_PER_PHASE
    for (int ph = 0; ph < NPH; ++ph) { p.ph_lo = ph; p.ph_hi = ph + 1; hipLaunchKernelGGL(fwd_megakernel, dim3(grid), dim3(512), LDS_BYTES, stream, p); }
#else
    p.ph_lo = 0; p.ph_hi = NPH;
    (void)hipMemsetAsync((char*)d_ws + WS_CTL, 0, 65536, stream);
    void* args[] = {&p};
    hipError_t e = hipLaunchCooperativeKernel((const void*)fwd_megakernel, dim3(grid), dim3(512), args, LDS_BYTES, stream);
    if (e != hipSuccess) fprintf(stderr, "kernel_launch: cooperative launch failed: %s (grid %d)\n", hipGetErrorString(e), grid);
#endif
}
```
